# Optimizing an MI355X kernel written in HIP

```python
import jax
import jax.numpy as jnp
from jax import lax
import numpy as np

D_MODEL = 1024
BATCH = 2
SEQ = 8192
DEPTH = 4

HEAD_DIM = 64
ROPE_THETA = 10000.0
NORM_EPS = 1e-6
Q_BLOCK = 128
D_FF = 2816
A_HEADS = 4
IDX_HEADS = 4
IDX_DIM = 64
DSA_TOPK_MAX = 256
B_HEADS = 4
MOBA_BLOCK = 256
MOBA_TOPK = 3
C_HEADS = 8
C_GROUPS = 2
C_REP = C_HEADS // C_GROUPS
CMP_BLOCK = 32
CMP_STRIDE = 16
CMP_HIDDEN = 128
SLC_BLOCK = 64
SLC_TOPN = 16
WINDOW = 512
FORCE_SCORE = 1e30
N_BRANCH = 3
A_WIDTH = A_HEADS * HEAD_DIM
B_WIDTH = B_HEADS * HEAD_DIM
C_WIDTH = C_HEADS * HEAD_DIM
IN_SIZES = (A_WIDTH, 2 * HEAD_DIM, IDX_HEADS * IDX_DIM, IDX_DIM, IDX_HEADS, 3 * B_WIDTH, C_WIDTH, 6 * C_GROUPS * HEAD_DIM, 3 * C_HEADS, N_BRANCH * D_MODEL)
IN_COLS = sum(IN_SIZES)

kernel_name = 'hybrid_dsa_moba_nsa_macaron'


def _rmsnorm(x, g):
    xf = x.astype(jnp.float32)
    y = xf * lax.rsqrt(jnp.mean(xf * xf, axis=-1, keepdims=True) + NORM_EPS)
    return (y * g.astype(jnp.float32)).astype(x.dtype)


def _swiglu(x, w_gate, w_up, w_down):
    return (jax.nn.silu(x @ w_gate) * (x @ w_up)) @ w_down


def _rope(x, pos):
    half = x.shape[-1] // 2
    inv = ROPE_THETA ** (-jnp.arange(half, dtype=jnp.float32) / half)
    ang = pos.astype(jnp.float32)[:, None] * inv[None, :]
    cos = jnp.cos(ang)[:, None, :]
    sin = jnp.sin(ang)[:, None, :]
    xf = x.astype(jnp.float32)
    x1, x2 = xf[..., :half], xf[..., half:]
    return jnp.concatenate([x1 * cos - x2 * sin, x1 * sin + x2 * cos], axis=-1).astype(x.dtype)


def _masked_softmax(s, mask):
    s = jnp.where(mask, s.astype(jnp.float32), -jnp.inf)
    m = jnp.max(s, axis=-1, keepdims=True)
    m = jnp.where(jnp.isfinite(m), m, 0.0)
    p = jnp.exp(s - m)
    den = jnp.sum(p, axis=-1, keepdims=True)
    return p / jnp.where(den > 0, den, 1.0)


def _qslice(a, q0):
    return lax.dynamic_slice_in_dim(a, q0, Q_BLOCK, axis=1)


def _sweep(fn, T):
    out = lax.map(fn, jnp.arange(T // Q_BLOCK))
    nC, B, Qb, H, dh = out.shape
    return jnp.transpose(out, (1, 0, 2, 3, 4)).reshape(B, nC * Qb, H * dh)


def _dsa_attention(q, k, v, iq, ik, iw):
    T = q.shape[1]
    topk = min(DSA_TOPK_MAX, T // 4)
    kpos = jnp.arange(T)
    idx_scale = (IDX_HEADS * IDX_DIM) ** -0.5
    scale = HEAD_DIM ** -0.5
    gather = jax.vmap(lambda a, i: a[i])

    def block(c):
        q0 = c * Q_BLOCK
        tq = q0 + jnp.arange(Q_BLOCK)
        logits = jnp.einsum('bqhe,bse->bqhs', _qslice(iq, q0), ik)
        score = jnp.einsum('bqh,bqhs->bqs', _qslice(iw, q0).astype(jnp.float32), jax.nn.relu(logits).astype(jnp.float32)) * idx_scale
        score = jnp.where(kpos[None, None, :] <= tq[None, :, None], score, -jnp.inf)
        _, sel = lax.top_k(score, topk)
        k_sel = gather(k, sel)
        v_sel = gather(v, sel)
        s = jnp.einsum('bqhd,bqkd->bqhk', _qslice(q, q0), k_sel) * scale
        p = _masked_softmax(s, (sel <= tq[None, :, None])[:, :, None, :])
        return jnp.einsum('bqhk,bqkd->bqhd', p.astype(v.dtype), v_sel)

    return _sweep(block, T)


def _moba_attention(q, k, v):
    B, T, H, dh = q.shape
    scale = dh ** -0.5
    nb = max(-(-T // MOBA_BLOCK), MOBA_TOPK + 1)
    pad = ((0, 0), (0, nb * MOBA_BLOCK - T), (0, 0), (0, 0))
    kp = jnp.pad(k, pad)
    vp = jnp.pad(v, pad)
    kb = kp.reshape(B, nb, MOBA_BLOCK, H, dh)
    kmean = jnp.mean(kb.astype(jnp.float32), axis=2)
    kbh = jnp.transpose(kb, (0, 3, 1, 2, 4))
    vbh = jnp.transpose(vp.reshape(B, nb, MOBA_BLOCK, H, dh), (0, 3, 1, 2, 4))
    bi = jnp.arange(B)[:, None, None, None]
    hi = jnp.arange(H)[None, None, :, None]
    blk = jnp.arange(nb)

    def block(c):
        q0 = c * Q_BLOCK
        tq = q0 + jnp.arange(Q_BLOCK)
        own = q0 // MOBA_BLOCK
        qc = _qslice(q, q0)
        gate = jnp.einsum('bqhd,bnhd->bqhn', qc.astype(jnp.float32), kmean)
        gate = jnp.where(blk < own, gate, -jnp.inf)
        _, sel = lax.top_k(gate, MOBA_TOPK)
        k_sel = kbh[bi, hi, sel]
        v_sel = vbh[bi, hi, sel].reshape(B, Q_BLOCK, H, MOBA_TOPK * MOBA_BLOCK, dh)
        s_sel = jnp.einsum('bqhd,bqhjsd->bqhjs', qc, k_sel).reshape(B, Q_BLOCK, H, MOBA_TOPK * MOBA_BLOCK)
        m_sel = jnp.repeat(sel < own, MOBA_BLOCK, axis=-1)
        k_own = lax.dynamic_slice_in_dim(kp, own * MOBA_BLOCK, MOBA_BLOCK, axis=1)
        v_own = lax.dynamic_slice_in_dim(vp, own * MOBA_BLOCK, MOBA_BLOCK, axis=1)
        s_own = jnp.einsum('bqhd,bshd->bqhs', qc, k_own)
        m_own = (own * MOBA_BLOCK + jnp.arange(MOBA_BLOCK))[None, :] <= tq[:, None]
        s = jnp.concatenate([s_sel, s_own], axis=-1) * scale
        mask = jnp.concatenate([m_sel, jnp.broadcast_to(m_own[None, :, None, :], (B, Q_BLOCK, H, MOBA_BLOCK))], axis=-1)
        p = _masked_softmax(s, mask).astype(v.dtype)
        n_sel_keys = MOBA_TOPK * MOBA_BLOCK
        return (jnp.einsum('bqhm,bqhmd->bqhd', p[..., :n_sel_keys], v_sel)
                + jnp.einsum('bqhs,bshd->bqhd', p[..., n_sel_keys:], v_own))

    return _sweep(block, T)


def _compress(kv, pos_emb, w1, w2):
    B, T, G, dh = kv.shape
    nc = (T - CMP_BLOCK) // CMP_STRIDE + 1
    idx = jnp.arange(nc)[:, None] * CMP_STRIDE + jnp.arange(CMP_BLOCK)[None, :]
    blk = kv[:, idx] + pos_emb[:, None, :]
    flat = jnp.transpose(blk, (0, 1, 3, 2, 4)).reshape(B, nc, G, CMP_BLOCK * dh)
    return jax.nn.gelu(flat @ w1) @ w2


def _nsa_attention(q_raw, q_rot, k_cmp, v_cmp, k_slc, v_slc, k_win, v_win, gates):
    B, T = q_raw.shape[0], q_raw.shape[1]
    G, R, dh = C_GROUPS, C_REP, HEAD_DIM
    scale = dh ** -0.5
    nc = k_cmp.shape[1]
    ns = T // SLC_BLOCK
    n_sel = min(SLC_TOPN, ns)
    cmp_start = jnp.arange(nc) * CMP_STRIDE
    cmp_last = cmp_start + CMP_BLOCK - 1
    slc_start = jnp.arange(ns) * SLC_BLOCK
    overlap = ((cmp_start[:, None] < slc_start[None, :] + SLC_BLOCK) & (slc_start[None, :] <= cmp_last[:, None])).astype(jnp.float32)
    blk = jnp.arange(ns)
    k_sb = jnp.transpose(k_slc.reshape(B, ns, SLC_BLOCK, G, dh), (0, 3, 1, 2, 4))
    v_sb = jnp.transpose(v_slc.reshape(B, ns, SLC_BLOCK, G, dh), (0, 3, 1, 2, 4))
    wpad = ((0, 0), (WINDOW, 0), (0, 0), (0, 0))
    k_wp = jnp.pad(k_win, wpad)
    v_wp = jnp.pad(v_win, wpad)
    win_off = jnp.arange(WINDOW + Q_BLOCK) - WINDOW
    bi = jnp.arange(B)[:, None, None, None]
    gi = jnp.arange(G)[None, None, :, None]

    def block(c):
        q0 = c * Q_BLOCK
        tq = q0 + jnp.arange(Q_BLOCK)
        qn = _qslice(q_raw, q0).reshape(B, Q_BLOCK, G, R, dh)
        qr = _qslice(q_rot, q0).reshape(B, Q_BLOCK, G, R, dh)
        s_c = jnp.einsum('bqgrd,bngd->bqgrn', qn, k_cmp) * scale
        p_c = _masked_softmax(s_c, (cmp_last[None, :] <= tq[:, None])[None, :, None, None, :])
        o_c = jnp.einsum('bqgrn,bngd->bqgrd', p_c.astype(v_cmp.dtype), v_cmp)
        imp = jnp.einsum('bqgrn,nj->bqgj', p_c, overlap)
        jq = tq // SLC_BLOCK
        adm = blk[None, :] <= jq[:, None]
        forced = (blk[None, :] == 0) | (blk[None, :] == jq[:, None]) | (blk[None, :] == jq[:, None] - 1)
        score = jnp.where(adm[None, :, None, :], imp, -jnp.inf)
        score = jnp.where((adm & forced)[None, :, None, :], FORCE_SCORE, score)
        _, sel = lax.top_k(score, n_sel)
        k_sel = k_sb[bi, gi, sel]
        v_sel = v_sb[bi, gi, sel].reshape(B, Q_BLOCK, G, n_sel * SLC_BLOCK, dh)
        s_s = jnp.einsum('bqgrd,bqgjsd->bqgrjs', qr, k_sel).reshape(B, Q_BLOCK, G, R, n_sel * SLC_BLOCK) * scale
        kpos = (sel[..., None] * SLC_BLOCK + jnp.arange(SLC_BLOCK)).reshape(B, Q_BLOCK, G, n_sel * SLC_BLOCK)
        p_s = _masked_softmax(s_s, (kpos <= tq[None, :, None, None])[:, :, :, None, :])
        o_s = jnp.einsum('bqgrm,bqgmd->bqgrd', p_s.astype(v_slc.dtype), v_sel)
        k_wc = lax.dynamic_slice_in_dim(k_wp, q0, WINDOW + Q_BLOCK, axis=1)
        v_wc = lax.dynamic_slice_in_dim(v_wp, q0, WINDOW + Q_BLOCK, axis=1)
        kpos_w = q0 + win_off
        diff = tq[:, None] - kpos_w[None, :]
        mask_w = (diff >= 0) & (diff < WINDOW) & (kpos_w[None, :] >= 0)
        s_w = jnp.einsum('bqgrd,bkgd->bqgrk', qr, k_wc) * scale
        p_w = _masked_softmax(s_w, mask_w[None, :, None, None, :])
        o_w = jnp.einsum('bqgrk,bkgd->bqgrd', p_w.astype(v_win.dtype), v_wc)
        g = _qslice(gates, q0).reshape(B, Q_BLOCK, G, R, 3)
        o = g[..., 0:1] * o_c + g[..., 1:2] * o_s + g[..., 2:3] * o_w
        return o.reshape(B, Q_BLOCK, C_HEADS, dh)

    return _sweep(block, T)


def setup_inputs(seed: int = 0) -> dict:
    key = jax.random.key(seed)
    k = jax.random.split(key, 22)
    L, D = DEPTH, D_MODEL

    def nrm(kk, shape, fan_in):
        return jax.random.normal(kk, shape, jnp.float32) * (fan_in ** -0.5)

    def gain(kk, shape):
        return 1.0 + 0.05 * jax.random.normal(kk, shape, jnp.float32)

    cmp_in = CMP_BLOCK * HEAD_DIM
    return {
        'x': jax.random.normal(k[0], (BATCH, SEQ, D), jnp.float32),
        'ffn1_norm': gain(k[1], (L, D)),
        'ffn1_w_gate': nrm(k[2], (L, D, D_FF), D),
        'ffn1_w_up': nrm(k[3], (L, D, D_FF), D),
        'ffn1_w_down': nrm(k[4], (L, D_FF, D), D_FF),
        'mix_norm': gain(k[5], (L, D)),
        'w_in': nrm(k[6], (L, D, IN_COLS), D),
        'cmp_pos_k': 0.1 * jax.random.normal(k[7], (L, CMP_BLOCK, HEAD_DIM), jnp.float32),
        'cmp_w1_k': nrm(k[8], (L, cmp_in, CMP_HIDDEN), cmp_in),
        'cmp_w2_k': nrm(k[9], (L, CMP_HIDDEN, HEAD_DIM), CMP_HIDDEN),
        'cmp_pos_v': 0.1 * jax.random.normal(k[10], (L, CMP_BLOCK, HEAD_DIM), jnp.float32),
        'cmp_w1_v': nrm(k[11], (L, cmp_in, CMP_HIDDEN), cmp_in),
        'cmp_w2_v': nrm(k[12], (L, CMP_HIDDEN, HEAD_DIM), CMP_HIDDEN),
        'w_branch_a': nrm(k[13], (L, A_WIDTH, D), A_WIDTH),
        'w_branch_b': nrm(k[14], (L, B_WIDTH, D), B_WIDTH),
        'w_branch_c': nrm(k[15], (L, C_WIDTH, D), C_WIDTH),
        'w_out': nrm(k[16], (L, D, D), D),
        'ffn2_norm': gain(k[17], (L, D)),
        'ffn2_w_gate': nrm(k[18], (L, D, D_FF), D),
        'ffn2_w_up': nrm(k[19], (L, D, D_FF), D),
        'ffn2_w_down': nrm(k[20], (L, D_FF, D), D_FF),
        'final_norm': gain(k[21], (D,)),
    }


def reference(x, ffn1_norm, ffn1_w_gate, ffn1_w_up, ffn1_w_down, mix_norm, w_in,
              cmp_pos_k, cmp_w1_k, cmp_w2_k, cmp_pos_v, cmp_w1_v, cmp_w2_v,
              w_branch_a, w_branch_b, w_branch_c, w_out,
              ffn2_norm, ffn2_w_gate, ffn2_w_up, ffn2_w_down, final_norm):
    B, T, D = x.shape
    pos = jnp.arange(T)
    cuts = np.cumsum(IN_SIZES)[:-1].tolist()
    for l in range(DEPTH):
        x = x + 0.5 * _swiglu(_rmsnorm(x, ffn1_norm[l]), ffn1_w_gate[l], ffn1_w_up[l], ffn1_w_down[l])
        h = _rmsnorm(x, mix_norm[l])
        a_q, a_kv, i_q, i_k, i_w, b_qkv, c_q, c_kv, c_g, m_g = jnp.split(h @ w_in[l], cuts, axis=-1)
        a_q = _rope(a_q.reshape(B, T, A_HEADS, HEAD_DIM), pos)
        a_k = _rope(a_kv[..., None, :HEAD_DIM], pos)[:, :, 0]
        a_v = a_kv[..., HEAD_DIM:]
        i_q = _rope(i_q.reshape(B, T, IDX_HEADS, IDX_DIM), pos)
        i_k = _rope(i_k[:, :, None, :], pos)[:, :, 0]
        y_a = _dsa_attention(a_q, a_k, a_v, i_q, i_k, i_w) @ w_branch_a[l]
        b_qkv = b_qkv.reshape(B, T, 3, B_HEADS, HEAD_DIM)
        y_b = _moba_attention(_rope(b_qkv[:, :, 0], pos), _rope(b_qkv[:, :, 1], pos), b_qkv[:, :, 2]) @ w_branch_b[l]
        c_q = c_q.reshape(B, T, C_HEADS, HEAD_DIM)
        c_kv = c_kv.reshape(B, T, 6, C_GROUPS, HEAD_DIM)
        k_cmp = _compress(c_kv[:, :, 0], cmp_pos_k[l], cmp_w1_k[l], cmp_w2_k[l])
        v_cmp = _compress(c_kv[:, :, 1], cmp_pos_v[l], cmp_w1_v[l], cmp_w2_v[l])
        c_gates = jax.nn.sigmoid(c_g.reshape(B, T, C_HEADS, 3))
        y_c = _nsa_attention(c_q, _rope(c_q, pos), k_cmp, v_cmp,
                             _rope(c_kv[:, :, 2], pos), c_kv[:, :, 3],
                             _rope(c_kv[:, :, 4], pos), c_kv[:, :, 5], c_gates) @ w_branch_c[l]
        g = jax.nn.sigmoid(m_g.reshape(B, T, N_BRANCH, D))
        x = x + (g[:, :, 0] * y_a + g[:, :, 1] * y_b + g[:, :, 2] * y_c) @ w_out[l]
        x = x + 0.5 * _swiglu(_rmsnorm(x, ffn2_norm[l]), ffn2_w_gate[l], ffn2_w_up[l], ffn2_w_down[l])
    return _rmsnorm(x, final_norm)
```

```cpp
#include <hip/hip_runtime.h>
#include <cstdio>
#include <cstdint>

constexpr int BATCH = 2, T = 8192, D = 1024, DEPTH = 4, DFF = 2816, M = BATCH * T;
constexpr int IN_COLS = 5852;
constexpr float NORM_EPS = 1e-6f;
constexpr int ZLD = 2816;
constexpr int Z_AQ = 0, Z_AK = 256, Z_IQ = 320, Z_IK = 576, Z_BQ = 640, Z_BK = 896, Z_CQ = 1152, Z_KS = 1664, Z_KW = 1792, Z_ROPE_END = 1920;
constexpr int Z_AV = 1920, Z_BV = 1984, Z_KC = 2240, Z_VC = 2368, Z_VS = 2496, Z_VW = 2624, Z_IW = 2752, Z_CG = 2756, Z_END = 2780;
constexpr int O_A = 0, O_B = 256, O_C = 512;

namespace pg8 {
#define PG8_LAS __attribute__((address_space(3)))
typedef unsigned short bf16_t;
typedef short bf16x8 __attribute__((ext_vector_type(8)));
typedef float f32x4 __attribute__((ext_vector_type(4)));
typedef unsigned u32x4 __attribute__((ext_vector_type(4)));
constexpr int BM = 256, BK = 64, HALF = 128, HTB = HALF * BK * 2  , STAGE_BYTES = 8 * HTB, NXCD = 8, WGM = 8;

__host__ __device__ __forceinline__ int lds_byte(int r, int c) { const int st = (r >> 4) * 2 + (c >> 5), rr = r & 15, cc = c & 31, ob = rr * 64 + cc * 2; return st * 1024 + (ob ^ (((ob >> 9) & 1) << 5)); }
__host__ __device__ __forceinline__ void stage_rc(int b, int& R, int& C) { const int st = b / 1024, sb = b % 1024, swz = sb ^ (((sb >> 9) & 1) << 5); R = (st >> 1) * 16 + swz / 64; C = (st & 1) * 32 + (swz % 64) / 2; }
__host__ __device__ __forceinline__ int perm32(int rho) { const int n = rho >> 4, i = rho & 15; return 8 * (i >> 2) + 4 * n + (i & 3); }

struct Unit { int pm, pn; };
struct Gemm { const bf16_t* A; const bf16_t* Bt; int M, N, K; };

struct StaticOrder {
    int nM, nN, nwg, G, c;
    __host__ __device__ void init(int M, int N, int G_, int c_) { nM = M / BM; nN = N / BM; nwg = nM * nN; G = G_; c = c_; }
    __host__ __device__ bool next(int i, Unit& u) const {
        const long L = (long)i * G + c; if (L >= nwg) return false;
        int wgid = (int)L; { const int q = nwg / NXCD, r = nwg % NXCD, xcd = wgid % NXCD, off = wgid / NXCD; wgid = (xcd < r ? xcd * (q + 1) : r * (q + 1) + (xcd - r) * q) + off; }
        const int nig = WGM * nN, gid = wgid / nig, fm = gid * WGM, gsz = (nM - fm) < WGM ? (nM - fm) : WGM;
        u.pm = fm + ((wgid % nig) % gsz); u.pn = (wgid % nig) / gsz; return true;
    }
    __device__ __forceinline__ void a_ready(const Unit&) const {}
    __device__ __forceinline__ void done(const Unit&) const {}
};

typedef float f32x2_ __attribute__((ext_vector_type(2)));
typedef __bf16 bf16x2_ __attribute__((ext_vector_type(2)));
__device__ __forceinline__ unsigned cvt_pk_bf16(float lo, float hi) { f32x2_ v = {lo, hi}; bf16x2_ b = __builtin_convertvector(v, bf16x2_); return __builtin_bit_cast(unsigned, b); }
__device__ __forceinline__ float bf_lo(unsigned u) { return __builtin_bit_cast(float, u << 16); }
__device__ __forceinline__ float bf_hi(unsigned u) { return __builtin_bit_cast(float, u & 0xffff0000u); }
__device__ __forceinline__ float fast_sigmoid(float v) { return __builtin_amdgcn_rcpf(1.f + __builtin_amdgcn_exp2f(-1.4426950408889634f * v)); }
typedef unsigned u32x2 __attribute__((ext_vector_type(2)));

__device__ __forceinline__ void row_rinv8(const float* ss, const PG8_LAS float* rl, int row0, int fq, int lane, float (&rinv)[8]) {
    if (rl) {
#pragma unroll
        for (int ri = 0; ri < 8; ++ri) rinv[ri] = rl[(row0 + (ri >> 2) * HALF + (ri & 3) * 16) & 2047];
        return; }
    float mine[2];
#pragma unroll
    for (int t = 0; t < 2; ++t) { const int row = row0 + (fq >> 1) * HALF + (2 * (fq & 1) + t) * 16; const f32x4* p = (const f32x4*)(ss + (size_t)row * 16);
        const f32x4 s4 = (p[0] + p[1]) + (p[2] + p[3]); mine[t] = __builtin_amdgcn_rsqf(((s4[0] + s4[1]) + (s4[2] + s4[3])) * (1.f / D) + NORM_EPS); }
#pragma unroll
    for (int ri = 0; ri < 8; ++ri) rinv[ri] = __shfl(mine[ri & 1], (lane & 15) + 16 * (ri >> 1));
}
struct EpiSwiGLU {
    static constexpr bool PERM = true, AFTER_DRAIN = false;
    bf16_t* H; int ldh; const float* ss; const PG8_LAS float* rl;
    __device__ __forceinline__ void operator()(const f32x4 (&acc)[2][2][4][2], const Unit& u, int wr, int wc, int fr, int fq) const {
        const int row0 = u.pm * BM + wr * 64 + fr, col0 = u.pn * BM + wc * 32 + 8 * fq;
        float rinv[8]; row_rinv8(ss, rl, row0, fq, fq * 16 + fr, rinv);
#pragma unroll
        for (int ai = 0; ai < 2; ++ai)
#pragma unroll
            for (int m = 0; m < 4; ++m) { const unsigned rowb = (unsigned)(row0 + ai * HALF + m * 16) * (unsigned)ldh * 2u; const float ri = rinv[ai * 4 + m];
#pragma unroll
                for (int bj = 0; bj < 2; ++bj) { const f32x4 v0 = acc[ai][bj][m][0] * ri, v1 = acc[ai][bj][m][1] * ri;
                    const float h0 = v0[0] * fast_sigmoid(v0[0]) * v0[1], h1 = v0[2] * fast_sigmoid(v0[2]) * v0[3];
                    const float h2 = v1[0] * fast_sigmoid(v1[0]) * v1[1], h3 = v1[2] * fast_sigmoid(v1[2]) * v1[3];
                    u32x2 o; o.x = cvt_pk_bf16(h0, h1); o.y = cvt_pk_bf16(h2, h3);
                    *(u32x2*)((char*)H + rowb + (unsigned)((col0 + bj * HALF) >> 1) * 2u) = o; } }
    }
};
struct EpiResid {
    static constexpr bool PERM = true, AFTER_DRAIN = false;
    const bf16_t* src; bf16_t* dst; float scale; float* ss;
    __device__ __forceinline__ void operator()(const f32x4 (&acc)[2][2][4][2], const Unit& u, int wr, int wc, int fr, int fq) const {
        const int row0 = u.pm * BM + wr * 64 + fr, col0 = u.pn * BM + wc * 32 + 8 * fq;
#pragma unroll
        for (int ai = 0; ai < 2; ++ai)
#pragma unroll
            for (int m = 0; m < 4; ++m) { const int row = row0 + ai * HALF + m * 16; const unsigned ro = ((unsigned)row * (unsigned)D + (unsigned)col0) * 2u; float sq = 0.f;
#pragma unroll
                for (int bj = 0; bj < 2; ++bj) { const unsigned o = ro + (unsigned)(bj * HALF) * 2u; f32x4 v0 = acc[ai][bj][m][0] * scale, v1 = acc[ai][bj][m][1] * scale;
                    const u32x4 so = *(const u32x4*)((const char*)src + o);
                    v0[0] += bf_lo(so.x); v0[1] += bf_hi(so.x); v0[2] += bf_lo(so.y); v0[3] += bf_hi(so.y); v1[0] += bf_lo(so.z); v1[1] += bf_hi(so.z); v1[2] += bf_lo(so.w); v1[3] += bf_hi(so.w);
                    sq += ((v0[0] * v0[0] + v0[1] * v0[1]) + (v0[2] * v0[2] + v0[3] * v0[3])) + ((v1[0] * v1[0] + v1[1] * v1[1]) + (v1[2] * v1[2] + v1[3] * v1[3]));
                    u32x4 r; r.x = cvt_pk_bf16(v0[0], v0[1]); r.y = cvt_pk_bf16(v0[2], v0[3]); r.z = cvt_pk_bf16(v1[0], v1[1]); r.w = cvt_pk_bf16(v1[2], v1[3]);
                    *(u32x4*)((char*)dst + o) = r; }
                sq += __shfl_xor(sq, 16); sq += __shfl_xor(sq, 32);
                if (fq == 0) ss[(size_t)row * 16 + u.pn * 4 + wc] = sq; }
    }
};
struct EpiZin {
    static constexpr bool PERM = true, AFTER_DRAIN = false;
    bf16_t* Z; bf16_t* CQN; const float* cosT; const float* sinT; const float* ss; const PG8_LAS float* rl;
    __device__ __forceinline__ void operator()(const f32x4 (&acc)[2][2][4][2], const Unit& u, int wr, int wc, int fr, int fq) const {
        const int row0 = u.pm * BM + wr * 64 + fr, col0 = u.pn * BM + wc * 32 + 8 * fq;
        float rinv[8]; row_rinv8(ss, rl, row0, fq, fq * 16 + fr, rinv);
#pragma unroll
        for (int ai = 0; ai < 2; ++ai)
#pragma unroll
            for (int m = 0; m < 4; ++m) { const int row = row0 + ai * HALF + m * 16; const int pos = row & (T - 1); const float ri = rinv[ai * 4 + m];
#pragma unroll
                for (int bj = 0; bj < 2; ++bj) { const int col = col0 + bj * HALF; f32x4 v0 = acc[ai][bj][m][0] * ri, v1 = acc[ai][bj][m][1] * ri;
                    if (col < Z_ROPE_END) {
                        if (col >= Z_CQ && col < Z_KS) { u32x4 r; r.x = cvt_pk_bf16(v0[0], v0[1]); r.y = cvt_pk_bf16(v0[2], v0[3]); r.z = cvt_pk_bf16(v1[0], v1[1]); r.w = cvt_pk_bf16(v1[2], v1[3]);
                            *(u32x4*)((char*)CQN + ((unsigned)row * 512u + (unsigned)(col - Z_CQ)) * 2u) = r; }
                        const int i0 = (col & 63) >> 1;
                        const f32x4 c = *(const f32x4*)(cosT + pos * 32 + i0), s = *(const f32x4*)(sinT + pos * 32 + i0);
                        f32x4 w0, w1;
                        w0[0] = v0[0] * c[0] - v0[1] * s[0]; w0[1] = v0[0] * s[0] + v0[1] * c[0];
                        w0[2] = v0[2] * c[1] - v0[3] * s[1]; w0[3] = v0[2] * s[1] + v0[3] * c[1];
                        w1[0] = v1[0] * c[2] - v1[1] * s[2]; w1[1] = v1[0] * s[2] + v1[1] * c[2];
                        w1[2] = v1[2] * c[3] - v1[3] * s[3]; w1[3] = v1[2] * s[3] + v1[3] * c[3];
                        v0 = w0; v1 = w1;
                    } else if (col >= Z_IW) {
#pragma unroll
                        for (int e = 0; e < 4; ++e) { if (col + e >= Z_CG) v0[e] = fast_sigmoid(v0[e]); if (col + 4 + e >= Z_CG) v1[e] = fast_sigmoid(v1[e]); }
                    }
                    u32x4 r; r.x = cvt_pk_bf16(v0[0], v0[1]); r.y = cvt_pk_bf16(v0[2], v0[3]); r.z = cvt_pk_bf16(v1[0], v1[1]); r.w = cvt_pk_bf16(v1[2], v1[3]);
                    *(u32x4*)((char*)Z + ((unsigned)row * (unsigned)ZLD + (unsigned)col) * 2u) = r; } asm volatile("" ::: "memory"); }
    }
};
template <int MODE> struct EpiMerge {
    static constexpr bool PERM = true, AFTER_DRAIN = false;
    bf16_t* Gb; float* Mf; const float* ss; const PG8_LAS float* rl;
    __device__ __forceinline__ void operator()(const f32x4 (&acc)[2][2][4][2], const Unit& u, int wr, int wc, int fr, int fq) const {
        const int row0 = u.pm * BM + wr * 64 + fr, col0 = u.pn * BM + wc * 32 + 8 * fq;
        float rinv[8];
        if constexpr (MODE == 0) row_rinv8(ss, rl, row0, fq, fq * 16 + fr, rinv);
#pragma unroll
        for (int ai = 0; ai < 2; ++ai)
#pragma unroll
            for (int m = 0; m < 4; ++m) { const unsigned ro = ((unsigned)(row0 + ai * HALF + m * 16) * (unsigned)D + (unsigned)col0) * 2u;
#pragma unroll
                for (int bj = 0; bj < 2; ++bj) { const unsigned o = ro + (unsigned)(bj * HALF) * 2u; f32x4 v0 = acc[ai][bj][m][0], v1 = acc[ai][bj][m][1];
                    if constexpr (MODE == 0) {
#pragma unroll
                        for (int e = 0; e < 4; ++e) { v0[e] = fast_sigmoid(v0[e] * rinv[ai * 4 + m]); v1[e] = fast_sigmoid(v1[e] * rinv[ai * 4 + m]); }
                        u32x4 r; r.x = cvt_pk_bf16(v0[0], v0[1]); r.y = cvt_pk_bf16(v0[2], v0[3]); r.z = cvt_pk_bf16(v1[0], v1[1]); r.w = cvt_pk_bf16(v1[2], v1[3]);
                        *(u32x4*)((char*)Gb + o) = r;
                    } else {
                        const u32x4 g = *(const u32x4*)((const char*)Gb + o);
                        v0[0] *= bf_lo(g.x); v0[1] *= bf_hi(g.x); v0[2] *= bf_lo(g.y); v0[3] *= bf_hi(g.y);
                        v1[0] *= bf_lo(g.z); v1[1] *= bf_hi(g.z); v1[2] *= bf_lo(g.w); v1[3] *= bf_hi(g.w);
                        bf16_t* Mb = (bf16_t*)Mf;
                        if constexpr (MODE >= 2) { const u32x4 mo = *(const u32x4*)((const char*)Mb + o);
                            v0[0] += bf_lo(mo.x); v0[1] += bf_hi(mo.x); v0[2] += bf_lo(mo.y); v0[3] += bf_hi(mo.y); v1[0] += bf_lo(mo.z); v1[1] += bf_hi(mo.z); v1[2] += bf_lo(mo.w); v1[3] += bf_hi(mo.w); }
                        u32x4 r; r.x = cvt_pk_bf16(v0[0], v0[1]); r.y = cvt_pk_bf16(v0[2], v0[3]); r.z = cvt_pk_bf16(v1[0], v1[1]); r.w = cvt_pk_bf16(v1[2], v1[3]);
                        if constexpr (MODE == 3) *(u32x4*)((char*)Gb + o) = r; else *(u32x4*)((char*)Mb + o) = r;
                    } } }
    }
};

template <class Epi, class Sched, bool ALIGN_EPI = false, bool SP2 = false>
__device__ __forceinline__ void gemm_phase(PG8_LAS unsigned char* lds, const Gemm g, const Sched& S, const Epi& E) {
    int tid_o = threadIdx.x; asm volatile("" : "+v"(tid_o)); const int tid = tid_o, wid = __builtin_amdgcn_readfirstlane(tid >> 6), lane = tid & 63, wr = wid >> 2, wc = wid & 3, fr = lane & 15, fq = lane >> 4;
    const int K = g.K, nt = K / BK;
    unsigned voffA[2], voffB[2];
#pragma unroll
    for (int i = 0; i < 2; ++i) { int R, C; stage_rc(tid * 16 + i * 8192, R, C); const int Rb = Epi::PERM ? ((R & ~31) + perm32(R & 31)) : R;
        voffA[i] = (unsigned)(R * K + C) * 2u; voffB[i] = (unsigned)(Rb * K + C) * 2u; }
    const size_t kstep = (size_t)(BK * 2);
    const size_t hstep = (size_t)HALF * K * 2;
    const size_t tstep = 2 * hstep;
    const unsigned ldsw = (unsigned)wid * 1024u;
    const int aoff = lds_byte(wr * 64 + fr, fq * 8), boff = lds_byte(wc * 32 + fr, fq * 8);
#define PG8_SA(b, h) (((b) * 2 + (h)) * HTB)
#define PG8_SB(b, h) ((4 + (b) * 2 + (h)) * HTB)
#define PG8_STAGE(bufoff, gbase, voff) do { _Pragma("unroll") for (int _i = 0; _i < 2; ++_i) \
        __builtin_amdgcn_global_load_lds((const unsigned*)((const char*)(gbase) + (voff)[_i]), (PG8_LAS unsigned*)(lds + (bufoff) + ldsw + _i * 8192), 16, 0, 0); } while (0)
#define PG8_LDA(dst, b, h) do { _Pragma("unroll") for (int m = 0; m < 4; ++m) _Pragma("unroll") for (int k = 0; k < 2; ++k) dst[m][k] = *(const PG8_LAS bf16x8*)(lds + PG8_SA(b, h) + aoff + m * 2048 + k * 1024); } while (0)
#define PG8_LDB(dst, b, h) do { _Pragma("unroll") for (int n = 0; n < 2; ++n) _Pragma("unroll") for (int k = 0; k < 2; ++k) dst[n][k] = *(const PG8_LAS bf16x8*)(lds + PG8_SB(b, h) + boff + n * 2048 + k * 1024); } while (0)
#define PG8_MMA(ai, bj, At, Bt) do { __builtin_amdgcn_s_setprio(1); _Pragma("unroll") for (int m = 0; m < 4; ++m) _Pragma("unroll") for (int n = 0; n < 2; ++n) _Pragma("unroll") for (int k = 0; k < 2; ++k) \
        acc[ai][bj][m][n] = __builtin_amdgcn_mfma_f32_16x16x32_bf16(Bt[n][k], At[m][k], acc[ai][bj][m][n], 0, 0, 0); __builtin_amdgcn_s_setprio(0); } while (0)
#define PG8_WAIT_V(n) asm volatile("s_waitcnt vmcnt(" #n ")" ::: "memory")
#define PG8_WAIT_L(n) asm volatile("s_waitcnt lgkmcnt(" #n ")" ::: "memory")
#define PG8_BAR __builtin_amdgcn_s_barrier()
#define PG8_SCHED __builtin_amdgcn_sched_barrier(0)
    Unit cur, nxt; int ui = 0;
    if (!S.next(0, cur)) return;
    f32x4 acc[2][2][4][2];
#pragma unroll
    for (int a = 0; a < 2; ++a)
#pragma unroll
        for (int b = 0; b < 2; ++b)
#pragma unroll
            for (int m = 0; m < 4; ++m)
#pragma unroll
                for (int n = 0; n < 2; ++n) acc[a][b][m][n] = (f32x4){0.f, 0.f, 0.f, 0.f};
    bf16x8 At[4][2], B0[2][2], B1[2][2];
    const char* cA = (const char*)g.A + (size_t)cur.pm * tstep; const char* cB = (const char*)g.Bt + (size_t)cur.pn * tstep;
    S.a_ready(cur);
    if constexpr (SP2) {
        PG8_STAGE(PG8_SB(0, 0), cB, voffB); PG8_STAGE(PG8_SB(0, 1), cB + hstep, voffB); PG8_STAGE(PG8_SA(0, 0), cA, voffA); PG8_STAGE(PG8_SA(0, 1), cA + hstep, voffA);
        if (wr == 1) PG8_BAR;
        PG8_WAIT_V(2); PG8_BAR;
        PG8_STAGE(PG8_SB(1, 0), cB + kstep, voffB); PG8_STAGE(PG8_SA(1, 0), cA + kstep, voffA); PG8_STAGE(PG8_SB(1, 1), cB + hstep + kstep, voffB);
        PG8_WAIT_V(6); PG8_BAR;
    } else {
        PG8_STAGE(PG8_SB(0, 0), cB, voffB); PG8_STAGE(PG8_SA(0, 0), cA, voffA); PG8_STAGE(PG8_SB(0, 1), cB + hstep, voffB); PG8_STAGE(PG8_SA(0, 1), cA + hstep, voffA);
        if (wr == 1) PG8_BAR;
        PG8_WAIT_V(4); PG8_BAR;
        PG8_STAGE(PG8_SB(1, 0), cB + kstep, voffB); PG8_STAGE(PG8_SA(1, 0), cA + kstep, voffA); PG8_STAGE(PG8_SB(1, 1), cB + hstep + kstep, voffB);
        PG8_WAIT_V(6); PG8_BAR;
    }
    for (;;) {
        const bool has_next = S.next(ui + 1, nxt);
        const char* nA = has_next ? (const char*)g.A + (size_t)nxt.pm * tstep : cA; const char* nB = has_next ? (const char*)g.Bt + (size_t)nxt.pn * tstep : cB;
        for (int t = 0; t < nt; t += 2) {
            const bool last = (t == nt - 2);
            const char* a1 = cA + (size_t)(t + 1) * kstep;
            const char* a2 = last ? nA : cA + (size_t)(t + 2) * kstep; const char* b2 = last ? nB : cB + (size_t)(t + 2) * kstep;
            const char* a3 = a2 + kstep; const char* b3 = b2 + kstep;
            if (last && has_next) S.a_ready(nxt);
            if constexpr (SP2) {
            PG8_LDB(B0, 0, 0); PG8_LDB(B1, 0, 1); PG8_SCHED; PG8_LDA(At, 0, 0); PG8_STAGE(PG8_SA(1, 1), a1 + hstep, voffA);
            PG8_WAIT_V(8); PG8_WAIT_L(0); PG8_BAR; PG8_MMA(0, 0, At, B0); PG8_MMA(0, 1, At, B1); PG8_BAR; PG8_SCHED;
            PG8_LDA(At, 0, 1); PG8_STAGE(PG8_SB(0, 0), b2, voffB); PG8_STAGE(PG8_SB(0, 1), b2 + hstep, voffB); PG8_STAGE(PG8_SA(0, 0), a2, voffA);
            PG8_WAIT_V(8); PG8_WAIT_L(0); PG8_BAR; PG8_MMA(1, 0, At, B0); PG8_MMA(1, 1, At, B1); PG8_BAR; PG8_SCHED;
            PG8_LDB(B0, 1, 0); PG8_LDB(B1, 1, 1); PG8_SCHED; PG8_LDA(At, 1, 0); PG8_STAGE(PG8_SA(0, 1), a2 + hstep, voffA);
            PG8_WAIT_V(8); PG8_WAIT_L(0); PG8_BAR; PG8_MMA(0, 0, At, B0); PG8_MMA(0, 1, At, B1); PG8_BAR; PG8_SCHED;
            PG8_LDA(At, 1, 1); PG8_STAGE(PG8_SB(1, 0), b3, voffB); PG8_STAGE(PG8_SB(1, 1), b3 + hstep, voffB); PG8_STAGE(PG8_SA(1, 0), a3, voffA);
            PG8_WAIT_V(8); PG8_WAIT_L(0); PG8_BAR; PG8_MMA(1, 0, At, B0); PG8_MMA(1, 1, At, B1); PG8_BAR; PG8_SCHED;
            } else {
            PG8_LDB(B0, 0, 0); PG8_SCHED; PG8_LDA(At, 0, 0); PG8_STAGE(PG8_SA(1, 1), a1 + hstep, voffA);
            PG8_WAIT_L(8); PG8_BAR; PG8_WAIT_L(0); PG8_MMA(0, 0, At, B0); PG8_BAR; PG8_SCHED;
            PG8_LDB(B1, 0, 1); PG8_STAGE(PG8_SB(0, 0), b2, voffB);
            PG8_BAR; PG8_WAIT_L(0); PG8_MMA(0, 1, At, B1); PG8_BAR;
            PG8_LDA(At, 0, 1); PG8_STAGE(PG8_SA(0, 0), a2, voffA);
            PG8_BAR; PG8_WAIT_L(0); PG8_MMA(1, 0, At, B0); PG8_BAR; PG8_SCHED;
            PG8_STAGE(PG8_SB(0, 1), b2 + hstep, voffB);
            PG8_WAIT_V(6); PG8_BAR; PG8_MMA(1, 1, At, B1); PG8_BAR;
            PG8_LDB(B0, 1, 0); PG8_SCHED; PG8_LDA(At, 1, 0); PG8_STAGE(PG8_SA(0, 1), a2 + hstep, voffA);
            PG8_WAIT_L(8); PG8_BAR; PG8_WAIT_L(0); PG8_MMA(0, 0, At, B0); PG8_BAR; PG8_SCHED;
            PG8_LDB(B1, 1, 1); PG8_STAGE(PG8_SB(1, 0), b3, voffB);
            PG8_BAR; PG8_WAIT_L(0); PG8_MMA(0, 1, At, B1); PG8_BAR;
            PG8_LDA(At, 1, 1); PG8_STAGE(PG8_SA(1, 0), a3, voffA);
            PG8_BAR; PG8_WAIT_L(0); PG8_MMA(1, 0, At, B0); PG8_BAR; PG8_SCHED;
            PG8_STAGE(PG8_SB(1, 1), b3 + hstep, voffB);
            PG8_WAIT_V(6); PG8_BAR; PG8_MMA(1, 1, At, B1); PG8_BAR;
            }
        }
        if constexpr (ALIGN_EPI) { if (wr == 0) PG8_BAR; }
        if constexpr (!Epi::AFTER_DRAIN) { E(acc, cur, wr, wc, fr, fq); S.done(cur); }
        if (!has_next) break;
#pragma unroll
        for (int a = 0; a < 2; ++a)
#pragma unroll
            for (int b = 0; b < 2; ++b)
#pragma unroll
                for (int m = 0; m < 4; ++m)
#pragma unroll
                    for (int n = 0; n < 2; ++n) acc[a][b][m][n] = (f32x4){0.f, 0.f, 0.f, 0.f};
        cur = nxt; cA = nA; cB = nB; ++ui;
        if constexpr (ALIGN_EPI) { if (wr == 1) PG8_BAR; }
    }
    PG8_WAIT_V(0);
    if constexpr (!ALIGN_EPI) { if (wr == 0) PG8_BAR; }
    PG8_BAR;
    if constexpr (Epi::AFTER_DRAIN) { E.fused(acc, cur, wr, wc, fr, fq, lds, wid, lane); S.done(cur); }
#undef PG8_SA
#undef PG8_SB
#undef PG8_STAGE
#undef PG8_LDA
#undef PG8_LDB
#undef PG8_MMA
#undef PG8_WAIT_V
#undef PG8_WAIT_L
#undef PG8_BAR
#undef PG8_SCHED
}
}

#define LAS __attribute__((address_space(3)))
#define DI __device__ __forceinline__
typedef unsigned short bf16;
typedef short bf16x8 __attribute__((ext_vector_type(8)));
typedef short s16x4 __attribute__((ext_vector_type(4)));
typedef float f32x2 __attribute__((ext_vector_type(2)));
typedef float f32x4 __attribute__((ext_vector_type(4)));
typedef float f32x16 __attribute__((ext_vector_type(16)));
typedef unsigned u32x2 __attribute__((ext_vector_type(2)));
typedef unsigned u32x4 __attribute__((ext_vector_type(4)));
typedef __bf16 bf16x2_t __attribute__((ext_vector_type(2)));
typedef __attribute__((address_space(1))) unsigned gu32;
#define RLX_AGENT __ATOMIC_RELAXED, __HIP_MEMORY_SCOPE_AGENT
#define LDS_WAIT() asm volatile("s_waitcnt lgkmcnt(0)" ::: "memory")
#define VM_WAIT() asm volatile("s_waitcnt vmcnt(0)" ::: "memory")
#define MFMA32(a, b, c) __builtin_amdgcn_mfma_f32_32x32x16_bf16((a), (b), (c), 0, 0, 0)
#define MFMA16(a, b, c) __builtin_amdgcn_mfma_f32_16x16x32_bf16((a), (b), (c), 0, 0, 0)
constexpr float LOG2E = 1.4426950408889634f;
constexpr float NEG_INF = -__builtin_inff();
DI unsigned f2bf(float f) { unsigned u = __builtin_bit_cast(unsigned, f); return (u + 0x7fffu + ((u >> 16) & 1u)) >> 16; }
DI unsigned pk2(float lo, float hi) { f32x2 v = {lo, hi}; bf16x2_t b = __builtin_convertvector(v, bf16x2_t); return __builtin_bit_cast(unsigned, b); }
DI float bflo(unsigned u) { return __builtin_bit_cast(float, u << 16); }
DI float bfhi(unsigned u) { return __builtin_bit_cast(float, u & 0xffff0000u); }
DI float bf2f(bf16 v) { return __builtin_bit_cast(float, (unsigned)v << 16); }
DI float ex2(float x) { return __builtin_amdgcn_exp2f(x); }
DI int crow(int reg, int h) { return (reg & 3) + 8 * (reg >> 2) + 4 * h; }
DI float wave_sum(float v) {
#pragma unroll
    for (int o = 1; o < 64; o <<= 1) v += __shfl_xor(v, o);
    return v;
}
DI float wave_max(float v) {
#pragma unroll
    for (int o = 1; o < 64; o <<= 1) v = fmaxf(v, __shfl_xor(v, o));
    return v;
}

constexpr size_t MiB = 1u << 20;
constexpr size_t WS_CTL = 0, CTL_ZERO_BYTES = 64 * 1024;
constexpr size_t WS_COS = 1 * MiB, WS_SIN = 2 * MiB;
constexpr size_t WS_KMEAN = 3 * MiB, WS_KCMP = 3 * MiB + 128 * 1024, WS_VCMP = 3 * MiB + 384 * 1024, WS_BIAS1 = 3 * MiB + 640 * 1024;
constexpr size_t WS_W = 4 * MiB, WS_H = 60 * MiB, WS_O = 92 * MiB, WS_Z = 124 * MiB, WS_HID = WS_Z, WS_GB = WS_Z, WS_MF = 156 * MiB, WS_CQN = 220 * MiB, WS_PART = 240 * MiB, WS_XB = 320 * MiB, WS_SS = 352 * MiB, WS_END = 353 * MiB;
constexpr size_t W_UP1 = 0, W_DN1 = W_UP1 + (size_t)2 * DFF * D, W_UP2 = W_DN1 + (size_t)D * DFF, W_DN2 = W_UP2 + (size_t)2 * DFF * D, W_IN = W_DN2 + (size_t)D * DFF,
                 W_G = W_IN + (size_t)ZLD * D, W_A = W_G + (size_t)3 * D * D, W_B = W_A + (size_t)D * 256, W_C = W_B + (size_t)D * 256, W_O = W_C + (size_t)D * 512,
                 W_1K = W_O + (size_t)D * D, W_1V = W_1K + (size_t)128 * 2048, W_2K = W_1V + (size_t)128 * 2048, W_2V = W_2K + (size_t)64 * 128, W_END = W_2V + (size_t)64 * 128;
static_assert(W_END * 2 <= 56 * MiB, "weights region");
constexpr int CW_BAR = 1024;

constexpr int RING_BYTES = 131072;
constexpr int LDSCTL_OFF = RING_BYTES, MISC_OFF = LDSCTL_OFF + 320;
constexpr int LDS_BYTES = 147456;
constexpr int NWAVES = 8;

#define XB_TMO      128
#define XB_XCNT(j)  (256  + 64 * (j))
#define XB_XSUB(j)  (1280 + 64 * (j))
#define XB_XGEN(j)  (2304 + 64 * (j))
#define XB_TOP      3328
#define XB_TOPGEN   3392
#define XCD_BAR_WORDS 3456
#define XB_SPIN_CAP (1u << 18)

__device__ __forceinline__ unsigned xb_ld(unsigned* p)              { return __hip_atomic_load(p, __ATOMIC_RELAXED, __HIP_MEMORY_SCOPE_AGENT); }
__device__ __forceinline__ unsigned xb_add(unsigned* p, unsigned v) { return __hip_atomic_fetch_add(p, v, __ATOMIC_RELAXED, __HIP_MEMORY_SCOPE_AGENT); }
__device__ __forceinline__ unsigned xb_xcc_id() { return (unsigned)__builtin_amdgcn_s_getreg((3 << 11) | 20) & 0xFu; }
#define XB_SPIN(cond, bar) do { unsigned _sp = 0; while (cond) { __builtin_amdgcn_s_sleep(1); \
    if ((++_sp & 255u) == 0u) { if (xb_ld(&(bar)[XB_TMO])) break; if (_sp > XB_SPIN_CAP) { atomicAdd(&(bar)[XB_TMO], 1u); break; } } } } while (0)

struct XcdBarrier {
    unsigned* bar; unsigned x;
    volatile LAS unsigned* st;
};

__device__ __forceinline__ XcdBarrier xcd_barrier_post(unsigned* bar, volatile LAS unsigned* st) {
    XcdBarrier b; b.bar = bar; b.x = xb_xcc_id(); b.st = st;
    if (threadIdx.x == 0) (void)xb_add(&bar[XB_XCNT(b.x)], 1u);
    return b;
}
__device__ __forceinline__ void xcd_barrier_complete(unsigned* bar, unsigned x, unsigned& nloc, unsigned& nx) {
    const unsigned G = gridDim.x * gridDim.y * gridDim.z;
    unsigned sum, cnt, mine, sp = 0u;
    for (;;) {
        sum = 0u; cnt = 0u; mine = 0u;
#pragma unroll
        for (unsigned j = 0; j < 16; ++j) { const unsigned c = xb_ld(&bar[XB_XCNT(j)]); sum += c; cnt += (c > 0u) ? 1u : 0u; mine = (j == x) ? c : mine; }
        if (sum == G) break;
        __builtin_amdgcn_s_sleep(1);
        if ((++sp & 255u) == 0u) { if (xb_ld(&bar[XB_TMO])) break; if (sp > XB_SPIN_CAP) { atomicAdd(&bar[XB_TMO], 1u); break; } }
    }
    nloc = mine > 0u ? mine : 1u; nx = cnt > 0u ? cnt : 1u;
}

__device__ __forceinline__ void xcd_barrier(const XcdBarrier& b) {
    asm volatile("s_waitcnt vmcnt(0)" ::: "memory");
    __syncthreads();
    if (threadIdx.x == 0) {
        unsigned* bar = b.bar;
        __builtin_amdgcn_s_waitcnt(0);
        unsigned nloc = b.st[0], nx = b.st[1];
        if (nloc == 0u) { xcd_barrier_complete(bar, b.x, nloc, nx); b.st[0] = nloc; b.st[1] = nx; }
        const unsigned old = xb_add(&bar[XB_XSUB(b.x)], 1u);
        const unsigned gen = old / nloc;
        if (old + 1u == (gen + 1u) * nloc) {
            __builtin_amdgcn_fence(__ATOMIC_RELEASE, "agent");
            asm volatile("s_waitcnt vmcnt(0)" ::: "memory");
            const unsigned og = xb_add(&bar[XB_TOP], 1u);
            const unsigned tg = og / nx;
            if (og + 1u == (tg + 1u) * nx) xb_add(&bar[XB_TOPGEN], 1u);
            else XB_SPIN(xb_ld(&bar[XB_TOPGEN]) == tg, bar);
            __builtin_amdgcn_fence(__ATOMIC_ACQUIRE, "agent");
            xb_add(&bar[XB_XGEN(b.x)], 1u);
            asm volatile("s_waitcnt vmcnt(0)" ::: "memory");
        } else {
            XB_SPIN(xb_ld(&bar[XB_XGEN(b.x)]) == gen, bar);
            __builtin_amdgcn_fence(__ATOMIC_ACQUIRE, "agent");
            asm volatile("s_waitcnt vmcnt(0)" ::: "memory");
        }
    }
    __syncthreads();
}


DI int zcol_to_orig(int n) {
    if (n < Z_ROPE_END) { const int hh = n >> 6, w = n & 63, e = (w >> 1) + 32 * (w & 1); int base;
        if (hh < 4) base = hh * 64; else if (hh == 4) base = 256; else if (hh < 9) base = 384 + (hh - 5) * 64; else if (hh == 9) base = 640;
        else if (hh < 14) base = 708 + (hh - 10) * 64; else if (hh < 18) base = 964 + (hh - 14) * 64; else if (hh < 26) base = 1476 + (hh - 18) * 64;
        else if (hh < 28) base = 2244 + (hh - 26) * 64; else base = 2500 + (hh - 28) * 64;
        return base + e; }
    if (n < Z_BV) return 320 + (n - Z_AV);
    if (n < Z_KC) return 1220 + (n - Z_BV);
    if (n < Z_VC) return 1988 + (n - Z_KC);
    if (n < Z_VS) return 2116 + (n - Z_VC);
    if (n < Z_VW) return 2372 + (n - Z_VS);
    if (n < Z_IW) return 2628 + (n - Z_VW);
    if (n < Z_CG) return 704 + (n - Z_IW);
    if (n < Z_END) return 2756 + (n - Z_CG);
    return -1;
}
struct MapPlain { const float* W; DI const float* operator()(int n) const { return W + n; } };
struct MapGateUp { const float* Wg; const float* Wu; DI const float* operator()(int n) const { return ((n & 1) ? Wu : Wg) + (n >> 1); } };
struct MapZin { const float* W; DI const float* operator()(int n) const { const int oc = zcol_to_orig(n); return oc < 0 ? nullptr : W + oc; } };
struct MapW2K { const float* W; DI const float* operator()(int n) const { return W + (n >> 1) + 32 * (n & 1); } };
template <class Map>
DI void tr_item(const Map& mp, int ld, int K, int nblk, bf16* WT, LAS float* scr, int item, int lane) {
    const int kb = item / nblk, nb = item % nblk, k0 = 64 * kb, n0 = 32 * nb;
    if (mp.kind <= 1) {
        const int rr = lane >> 3, c4 = lane & 7;
        const float* src = (mp.kind == 0) ? mp.W0 + n0 + 4 * c4 : ((c4 < 4) ? mp.W0 : mp.W1) + (n0 >> 1) + 4 * (c4 & 3);
        f32x4 v[8];
#pragma unroll
        for (int i = 0; i < 8; ++i) v[i] = *(const f32x4*)(src + (size_t)(k0 + 8 * i + rr) * ld);
#pragma unroll
        for (int i = 0; i < 8; ++i) { LAS float* d = scr + (8 * i + rr) * 33;
            if (mp.kind == 0) { d[4 * c4] = v[i].x; d[4 * c4 + 1] = v[i].y; d[4 * c4 + 2] = v[i].z; d[4 * c4 + 3] = v[i].w; }
            else { const int nl = 8 * (c4 & 3) + (c4 >> 2); d[nl] = v[i].x; d[nl + 2] = v[i].y; d[nl + 4] = v[i].z; d[nl + 6] = v[i].w; } }
    } else {
        const float* colp = mp(n0 + (lane & 31));
#pragma unroll 8
        for (int i = 0; i < 32; ++i) { const int kk = 2 * i + (lane >> 5); scr[kk * 33 + (lane & 31)] = colp ? colp[(size_t)(k0 + kk) * ld] : 0.f; }
    }
    LDS_WAIT(); asm volatile("" ::: "memory");
    const int c = lane & 7;
    f32x4 ga = {1.f, 1.f, 1.f, 1.f}, gb = {1.f, 1.f, 1.f, 1.f};
    if (mp.gk) { ga = *(const f32x4*)(mp.gk + k0 + 8 * c); gb = *(const f32x4*)(mp.gk + k0 + 8 * c + 4); }
#pragma unroll
    for (int j = 0; j < 4; ++j) { const int n = (lane >> 3) + 8 * j; const LAS float* s = scr + (8 * c) * 33 + n;
        u32x4 o; o.x = pk2(s[0 * 33] * ga.x, s[1 * 33] * ga.y); o.y = pk2(s[2 * 33] * ga.z, s[3 * 33] * ga.w); o.z = pk2(s[4 * 33] * gb.x, s[5 * 33] * gb.y); o.w = pk2(s[6 * 33] * gb.z, s[7 * 33] * gb.w);
        *(u32x4*)(WT + (size_t)(n0 + n) * K + k0 + 8 * c) = o; }
    LDS_WAIT(); asm volatile("" ::: "memory");
}
DI void rms_row_bf16(const float* xrow, const float* g, bf16* orow, bf16* xbrow, int lane) {
    const f32x4* xr = (const f32x4*)xrow + lane; const f32x4* gr = (const f32x4*)g + lane;
    f32x4 v[4]; float s = 0.f;
#pragma unroll
    for (int j = 0; j < 4; ++j) { v[j] = xr[64 * j]; s += (v[j].x * v[j].x + v[j].y * v[j].y) + (v[j].z * v[j].z + v[j].w * v[j].w); }
    const float rstd = 1.f / sqrtf(wave_sum(s) * (1.f / D) + NORM_EPS);
    unsigned long long* o8 = (unsigned long long*)orow + lane; unsigned long long* x8 = (unsigned long long*)xbrow + lane;
#pragma unroll
    for (int j = 0; j < 4; ++j) { const f32x4 gg = gr[64 * j];
        x8[64 * j] = (unsigned long long)pk2(v[j].x, v[j].y) | ((unsigned long long)pk2(v[j].z, v[j].w) << 32);
        o8[64 * j] = (unsigned long long)pk2(v[j].x * rstd * gg.x, v[j].y * rstd * gg.y) | ((unsigned long long)pk2(v[j].z * rstd * gg.z, v[j].w * rstd * gg.w) << 32); }
}
DI void rms_rows4_bf16(const float* x, const float* g, bf16* o, bf16* xb, size_t m0, size_t stride, int lane) {
    f32x4 v[4][4]; float ss[4];
#pragma unroll
    for (int q = 0; q < 4; ++q) { const f32x4* xr = (const f32x4*)(x + (m0 + q * stride) * D) + lane;
#pragma unroll
        for (int j = 0; j < 4; ++j) v[q][j] = xr[64 * j]; }
#pragma unroll
    for (int q = 0; q < 4; ++q) { float a = 0.f;
#pragma unroll
        for (int j = 0; j < 4; ++j) a += (v[q][j].x * v[q][j].x + v[q][j].y * v[q][j].y) + (v[q][j].z * v[q][j].z + v[q][j].w * v[q][j].w);
        ss[q] = a; }
#pragma unroll
    for (int of = 1; of < 64; of <<= 1) {
#pragma unroll
        for (int q = 0; q < 4; ++q) ss[q] += __shfl_xor(ss[q], of); }
    const f32x4* gr = (const f32x4*)g + lane;
#pragma unroll
    for (int q = 0; q < 4; ++q) { const float rstd = 1.f / sqrtf(ss[q] * (1.f / D) + NORM_EPS);
        unsigned long long* o8 = (unsigned long long*)(o + (m0 + q * stride) * D) + lane; unsigned long long* x8 = (unsigned long long*)(xb + (m0 + q * stride) * D) + lane;
#pragma unroll
        for (int j = 0; j < 4; ++j) { const f32x4 gg = gr[64 * j];
            x8[64 * j] = (unsigned long long)pk2(v[q][j].x, v[q][j].y) | ((unsigned long long)pk2(v[q][j].z, v[q][j].w) << 32);
            o8[64 * j] = (unsigned long long)pk2(v[q][j].x * rstd * gg.x, v[q][j].y * rstd * gg.y) | ((unsigned long long)pk2(v[q][j].z * rstd * gg.z, v[q][j].w * rstd * gg.w) << 32); } }
}
DI void xb_init_rows4(const float* x, bf16* xb, float* ss, size_t m0, size_t stride, int lane) {
    f32x4 v[4][4]; float sq[4];
#pragma unroll
    for (int q = 0; q < 4; ++q) { const f32x4* xr = (const f32x4*)(x + (m0 + q * stride) * D) + lane;
#pragma unroll
        for (int j = 0; j < 4; ++j) v[q][j] = xr[64 * j]; }
#pragma unroll
    for (int q = 0; q < 4; ++q) { float a = 0.f;
#pragma unroll
        for (int j = 0; j < 4; ++j) a += (v[q][j].x * v[q][j].x + v[q][j].y * v[q][j].y) + (v[q][j].z * v[q][j].z + v[q][j].w * v[q][j].w);
        sq[q] = a; }
#pragma unroll
    for (int of = 1; of < 64; of <<= 1) {
#pragma unroll
        for (int q = 0; q < 4; ++q) sq[q] += __shfl_xor(sq[q], of); }
#pragma unroll
    for (int q = 0; q < 4; ++q) { unsigned long long* x8 = (unsigned long long*)(xb + (m0 + q * stride) * D) + lane;
#pragma unroll
        for (int j = 0; j < 4; ++j) x8[64 * j] = (unsigned long long)pk2(v[q][j].x, v[q][j].y) | ((unsigned long long)pk2(v[q][j].z, v[q][j].w) << 32);
        if (lane < 16) ss[(m0 + q * stride) * 16 + lane] = lane == 0 ? sq[q] : 0.f; }
}
template <int NR>
DI void rms_rows_b2b(const bf16* x, const float* g, bf16* o, size_t m0, size_t stride, int lane) {
    u32x4 v[NR][2]; float ss[NR];
#pragma unroll
    for (int q = 0; q < NR; ++q) { const u32x4* xr = (const u32x4*)(x + (m0 + q * stride) * D) + lane;
#pragma unroll
        for (int j = 0; j < 2; ++j) v[q][j] = xr[64 * j]; }
#pragma unroll
    for (int q = 0; q < NR; ++q) { float a = 0.f;
#pragma unroll
        for (int j = 0; j < 2; ++j) { const u32x4 t = v[q][j];
            a += (bflo(t.x) * bflo(t.x) + bfhi(t.x) * bfhi(t.x)) + (bflo(t.y) * bflo(t.y) + bfhi(t.y) * bfhi(t.y)) + (bflo(t.z) * bflo(t.z) + bfhi(t.z) * bfhi(t.z)) + (bflo(t.w) * bflo(t.w) + bfhi(t.w) * bfhi(t.w)); }
        ss[q] = a; }
#pragma unroll
    for (int of = 1; of < 64; of <<= 1) {
#pragma unroll
        for (int q = 0; q < NR; ++q) ss[q] += __shfl_xor(ss[q], of); }
#pragma unroll
    for (int q = 0; q < NR; ++q) { const float rstd = 1.f / sqrtf(ss[q] * (1.f / D) + NORM_EPS);
        u32x4* o16 = (u32x4*)(o + (m0 + q * stride) * D) + lane;
#pragma unroll
        for (int j = 0; j < 2; ++j) { const f32x4 g0 = ((const f32x4*)g)[2 * (lane + 64 * j)], g1 = ((const f32x4*)g)[2 * (lane + 64 * j) + 1]; const u32x4 t = v[q][j];
            u32x4 r; r.x = pk2(bflo(t.x) * rstd * g0.x, bfhi(t.x) * rstd * g0.y); r.y = pk2(bflo(t.y) * rstd * g0.z, bfhi(t.y) * rstd * g0.w);
            r.z = pk2(bflo(t.z) * rstd * g1.x, bfhi(t.z) * rstd * g1.y); r.w = pk2(bflo(t.w) * rstd * g1.z, bfhi(t.w) * rstd * g1.w);
            o16[64 * j] = r; } }
}
DI void rms_row_b2f(const bf16* xrow, const float* g, float* orow, int lane) {
    u32x4 v[2]; float s = 0.f;
#pragma unroll
    for (int j = 0; j < 2; ++j) { v[j] = ((const u32x4*)xrow)[lane + 64 * j]; const u32x4 t = v[j];
        s += (bflo(t.x) * bflo(t.x) + bfhi(t.x) * bfhi(t.x)) + (bflo(t.y) * bflo(t.y) + bfhi(t.y) * bfhi(t.y)) + (bflo(t.z) * bflo(t.z) + bfhi(t.z) * bfhi(t.z)) + (bflo(t.w) * bflo(t.w) + bfhi(t.w) * bfhi(t.w)); }
    const float rstd = 1.f / sqrtf(wave_sum(s) * (1.f / D) + NORM_EPS);
#pragma unroll
    for (int j = 0; j < 2; ++j) { const f32x4 g0 = ((const f32x4*)g)[2 * (lane + 64 * j)], g1 = ((const f32x4*)g)[2 * (lane + 64 * j) + 1]; const u32x4 t = v[j];
        f32x4 r0, r1; r0.x = bflo(t.x) * rstd * g0.x; r0.y = bfhi(t.x) * rstd * g0.y; r0.z = bflo(t.y) * rstd * g0.z; r0.w = bfhi(t.y) * rstd * g0.w;
        r1.x = bflo(t.z) * rstd * g1.x; r1.y = bfhi(t.z) * rstd * g1.y; r1.z = bflo(t.w) * rstd * g1.z; r1.w = bfhi(t.w) * rstd * g1.w;
        ((f32x4*)orow)[2 * (lane + 64 * j)] = r0; ((f32x4*)orow)[2 * (lane + 64 * j) + 1] = r1; }
}

struct Args { const float* in[22]; float* out; unsigned char* ws; int ph_lo, ph_hi; };
struct MapGen { int kind; const float* W0; const float* W1; const float* gk;
    DI const float* operator()(int n) const {
        if (kind == 0) return W0 + n;
        if (kind == 1) return ((n & 1) ? W1 : W0) + (n >> 1);
        if (kind == 2) { const int oc = zcol_to_orig(n); return oc < 0 ? nullptr : W0 + oc; }
        return W0 + (n >> 1) + 32 * (n & 1);
    } };
DI void convert_weights(const Args& A, int l, bf16* Wb, float* bias1p, LAS unsigned char* lds, int gw, int NGW, int wave, int lane, int tid) {
    LAS float* scr = (LAS float*)(lds + wave * 16384);
    constexpr int I_UP = 16 * 176, I_DN = 44 * 32, I_IN = 16 * 88, I_G = 16 * 96, I_A = 4 * 32, I_C = 8 * 32, I_O = 16 * 32, I_1 = 32 * 4, I_2 = 2 * 2;
    constexpr int NIT = 2 * I_UP + 2 * I_DN + I_IN + I_G + 2 * I_A + I_C + I_O + 2 * I_1 + 2 * I_2;
    for (int it = gw; it < NIT; it += NGW) {
        int r = it; MapGen mp; mp.kind = 0; mp.W0 = nullptr; mp.W1 = nullptr; mp.gk = nullptr; int ld, K, nblk; size_t dst;
        if (r < I_UP) { mp.kind = 1; mp.W0 = A.in[2] + (size_t)l * D * DFF; mp.W1 = A.in[3] + (size_t)l * D * DFF; mp.gk = A.in[1] + (size_t)l * D; ld = DFF; K = D; nblk = 176; dst = W_UP1; }
        else if ((r -= I_UP) < I_DN) { mp.W0 = A.in[4] + (size_t)l * DFF * D; ld = D; K = DFF; nblk = 32; dst = W_DN1; }
        else if ((r -= I_DN) < I_UP) { mp.kind = 1; mp.W0 = A.in[18] + (size_t)l * D * DFF; mp.W1 = A.in[19] + (size_t)l * D * DFF; mp.gk = A.in[17] + (size_t)l * D; ld = DFF; K = D; nblk = 176; dst = W_UP2; }
        else if ((r -= I_UP) < I_DN) { mp.W0 = A.in[20] + (size_t)l * DFF * D; ld = D; K = DFF; nblk = 32; dst = W_DN2; }
        else if ((r -= I_DN) < I_IN) { mp.kind = 2; mp.W0 = A.in[6] + (size_t)l * D * IN_COLS; mp.gk = A.in[5] + (size_t)l * D; ld = IN_COLS; K = D; nblk = 88; dst = W_IN; }
        else if ((r -= I_IN) < I_G) { mp.W0 = A.in[6] + (size_t)l * D * IN_COLS + Z_END; mp.gk = A.in[5] + (size_t)l * D; ld = IN_COLS; K = D; nblk = 96; dst = W_G; }
        else if ((r -= I_G) < I_A) { mp.W0 = A.in[13] + (size_t)l * 256 * D; ld = D; K = 256; nblk = 32; dst = W_A; }
        else if ((r -= I_A) < I_A) { mp.W0 = A.in[14] + (size_t)l * 256 * D; ld = D; K = 256; nblk = 32; dst = W_B; }
        else if ((r -= I_A) < I_C) { mp.W0 = A.in[15] + (size_t)l * 512 * D; ld = D; K = 512; nblk = 32; dst = W_C; }
        else if ((r -= I_C) < I_O) { mp.W0 = A.in[16] + (size_t)l * D * D; ld = D; K = D; nblk = 32; dst = W_O; }
        else if ((r -= I_O) < I_1) { mp.W0 = A.in[8] + (size_t)l * 2048 * 128; ld = 128; K = 2048; nblk = 4; dst = W_1K; }
        else if ((r -= I_1) < I_1) { mp.W0 = A.in[11] + (size_t)l * 2048 * 128; ld = 128; K = 2048; nblk = 4; dst = W_1V; }
        else if ((r -= I_1) < I_2) { mp.kind = 3; mp.W0 = A.in[9] + (size_t)l * 128 * 64; ld = 64; K = 128; nblk = 2; dst = W_2K; }
        else { r -= I_2; mp.W0 = A.in[12] + (size_t)l * 128 * 64; ld = 64; K = 128; nblk = 2; dst = W_2V; }
        tr_item(mp, ld, K, nblk, Wb + dst, scr, r, lane);
    }
    if (blockIdx.x < 16) {
        LDS_WAIT(); __syncthreads();
        const int kv = blockIdx.x >> 3, kc = blockIdx.x & 7, u = tid & 127, ks = tid >> 7;
        const float* pos = (kv ? A.in[10] : A.in[7]) + (size_t)l * 2048; const float* w1 = (kv ? A.in[11] : A.in[8]) + (size_t)l * 2048 * 128;
        float a = 0.f;
        for (int i = 0; i < 64; ++i) { const int k = kc * 256 + ks * 64 + i; a += pos[k] * w1[(size_t)k * 128 + u]; }
        LAS float* red = (LAS float*)lds;
        red[ks * 128 + u] = a;
        __syncthreads();
        if (tid < 128) bias1p[(kv * 8 + kc) * 128 + tid] = (red[tid] + red[128 + tid]) + (red[256 + tid] + red[384 + tid]);
        __syncthreads();
    }
}
DI void rope_table(float* cosT, float* sinT, int gtid, int gthreads) {
    for (int e = gtid; e < T * 32; e += gthreads) {
        const int pos = e >> 5, i = e & 31;
        double iv = 1.0;
        for (int k = 0; k < i; ++k) iv *= 0.74989420933245582;
        const float inv = (float)iv;
        const float ang = (float)pos * inv;
        const double x = (double)ang; const double n = rint(x * 0.15915494309189535);
        const float rr = (float)(x - n * 6.283185307179586);
        cosT[e] = __cosf(rr); sinT[e] = __sinf(rr);
    }
}

constexpr int VROWB = 192, VT_BYTES = 32 * VROWB;
DI void load_v_tile(const bf16* vbase, size_t vstride, LAS unsigned char* vt, int lane) {
#pragma unroll
    for (int it = 0; it < 4; ++it) { const int c = lane + 64 * it, key = c >> 3, ch = c & 7;
        const u32x4 v = *(const u32x4*)(vbase + (size_t)key * vstride + ch * 8);
        *(LAS u32x4*)(vt + key * VROWB + ch * 16) = v; }
}
DI f32x16 qk_tile(const bf16* kbase, size_t kstride, const bf16x8 (&qf)[4], int r, int h) {
    bf16x8 kf[4];
#pragma unroll
    for (int ks = 0; ks < 4; ++ks) kf[ks] = *(const bf16x8*)(kbase + (size_t)r * kstride + 16 * ks + 8 * h);
    f32x16 s;
#pragma unroll
    for (int i = 0; i < 16; ++i) s[i] = 0.f;
#pragma unroll
    for (int ks = 0; ks < 4; ++ks) s = MFMA32(kf[ks], qf[ks], s);
    return s;
}
DI s16x4 vtr(const LAS unsigned char* p) { return __builtin_bit_cast(s16x4, __builtin_amdgcn_ds_read_tr16_b64_v4i16((LAS s16x4*)p)); }
constexpr float SM_TAU = 8.f;
DI void softmax_pv(f32x16& s, float mx, float mref, f32x16& o0, f32x16& o1, float& m, float& l, const LAS unsigned char* vt, int lane) {
    mx = fmaxf(mx, __shfl_xor(mx, 32));
    const bool upd = (mx > SM_TAU) || (m < -1e29f && mx > -1e30f);
    if (__any(upd)) {
        const float d = upd ? mx : 0.f;
        const float alpha = (m < -1e29f) ? 1.f : ex2(-d);
        if (upd) m = mref + d;
        l *= alpha;
#pragma unroll
        for (int i = 0; i < 16; ++i) { o0[i] *= alpha; o1[i] *= alpha; s[i] -= d; }
    }
    float rs = 0.f;
#pragma unroll
    for (int i = 0; i < 16; ++i) { s[i] = ex2(s[i]); rs += s[i]; }
    l += rs;
    u32x4 pa, pb;
    pa.x = pk2(s[0], s[1]); pa.y = pk2(s[2], s[3]); pa.z = pk2(s[4], s[5]); pa.w = pk2(s[6], s[7]);
    pb.x = pk2(s[8], s[9]); pb.y = pk2(s[10], s[11]); pb.z = pk2(s[12], s[13]); pb.w = pk2(s[14], s[15]);
    const bf16x8 p0 = __builtin_bit_cast(bf16x8, pa), p1 = __builtin_bit_cast(bf16x8, pb);
    const int h = lane >> 5, blk = (lane >> 4) & 1, q = (lane & 15) >> 2, p = lane & 3;
    const LAS unsigned char* tb = vt + (4 * h + q) * VROWB + (16 * blk + 4 * p) * 2;
    s16x4 lo[2][2], hi[2][2];
#pragma unroll
    for (int dt = 0; dt < 2; ++dt)
#pragma unroll
        for (int ss = 0; ss < 2; ++ss) { lo[dt][ss] = vtr(tb + (16 * ss) * VROWB + 64 * dt); hi[dt][ss] = vtr(tb + (16 * ss + 8) * VROWB + 64 * dt); }
    asm volatile("" ::: "memory");
#pragma unroll
    for (int dt = 0; dt < 2; ++dt) {
#pragma unroll
        for (int ss = 0; ss < 2; ++ss) {
            const bf16x8 vf = __builtin_shufflevector(lo[dt][ss], hi[dt][ss], 0, 1, 2, 3, 4, 5, 6, 7);
            if (dt == 0) o0 = MFMA32(vf, ss ? p1 : p0, o0); else o1 = MFMA32(vf, ss ? p1 : p0, o1);
        }
    }
}
#define ZERO16(v) do { _Pragma("unroll") for (int _i = 0; _i < 16; ++_i) (v)[_i] = 0.f; } while (0)

struct KVPre { bf16x8 k[4]; u32x4 v[4]; };
DI void kv_issue(KVPre& p, const bf16* kb, size_t kstride, const bf16* vb, size_t vstride, int r, int h, int lane) {
#pragma unroll
    for (int ks = 0; ks < 4; ++ks) p.k[ks] = *(const bf16x8*)(kb + (size_t)r * kstride + 16 * ks + 8 * h);
#pragma unroll
    for (int it = 0; it < 4; ++it) { const int c = lane + 64 * it, key = c >> 3, ch = c & 7; p.v[it] = *(const u32x4*)(vb + (size_t)key * vstride + ch * 8); }
}
DI void k_issue(KVPre& p, const bf16* kb, size_t kstride, int r, int h) {
#pragma unroll
    for (int ks = 0; ks < 4; ++ks) p.k[ks] = *(const bf16x8*)(kb + (size_t)r * kstride + 16 * ks + 8 * h);
}
DI f32x16 qk_pre(const KVPre& p, const bf16x8 (&qf)[4]) {
    f32x16 s;
#pragma unroll
    for (int i = 0; i < 16; ++i) s[i] = 0.f;
#pragma unroll
    for (int ks = 0; ks < 4; ++ks) s = MFMA32(p.k[ks], qf[ks], s);
    return s;
}
DI void v_store(const KVPre& p, LAS unsigned char* vt, int lane) {
#pragma unroll
    for (int it = 0; it < 4; ++it) { const int c = lane + 64 * it, key = c >> 3, ch = c & 7; *(LAS u32x4*)(vt + key * VROWB + ch * 16) = p.v[it]; }
}
template <class It, class Mk>
DI void attn_loop(It& it, const Mk& mk, const bf16* kbase, size_t kstride, const bf16* vbase, size_t vstride, const bf16x8 (&qf)[4], float cs,
                  f32x16& o0, f32x16& o1, float& m, float& l, LAS unsigned char* vt0, LAS unsigned char* vt1, int lane) {
    const int r = lane & 31, h = lane >> 5;
    KVPre A, B;
    int kbA = -1, kbB = -1;
    bool hA = it.next(kbA), hB = false;
    if (!hA) return;
    kv_issue(A, kbase + (size_t)kbA * kstride, kstride, vbase + (size_t)kbA * vstride, vstride, r, h, lane);
    v_store(A, vt0, lane);
    for (;;) {
        kbB = kbA; hB = it.next(kbB);
        if (hB) { k_issue(B, kbase + (size_t)kbB * kstride, kstride, r, h);
            const bf16* vb = vbase + (size_t)kbB * vstride;
#pragma unroll
            for (int t4 = 0; t4 < 4; ++t4) { const int c = lane + 64 * t4, key = c >> 3, ch = c & 7; A.v[t4] = *(const u32x4*)(vb + (size_t)key * vstride + ch * 8); } }
        { f32x16 s = qk_pre(A, qf); const bool rw = mk.row(kbA); float mx; const float mref = (m < -1e29f) ? 0.f : m; const float biasm = (rw ? 0.f : NEG_INF) - mref;
          if (mk.full(kbA)) { const float bias = biasm;
#pragma unroll
            for (int i = 0; i < 16; ++i) s[i] = s[i] * cs + bias;
            mx = s[0];
#pragma unroll
            for (int i = 1; i < 16; ++i) mx = fmaxf(mx, s[i]);
          } else {
#pragma unroll
            for (int i = 0; i < 16; ++i) { const int key = kbA + crow(i, h); s[i] = mk.elem(key) ? s[i] * cs + biasm : NEG_INF; }
            mx = s[0];
#pragma unroll
            for (int i = 1; i < 16; ++i) mx = fmaxf(mx, s[i]); }
          softmax_pv(s, mx, mref, o0, o1, m, l, vt0, lane); }
        if (!hB) break;
        v_store(A, vt1, lane);
        kbA = kbB; hA = it.next(kbA);
        if (hA) { k_issue(A, kbase + (size_t)kbA * kstride, kstride, r, h);
            const bf16* vb = vbase + (size_t)kbA * vstride;
#pragma unroll
            for (int t4 = 0; t4 < 4; ++t4) { const int c = lane + 64 * t4, key = c >> 3, ch = c & 7; A.v[t4] = *(const u32x4*)(vb + (size_t)key * vstride + ch * 8); } }
        { f32x16 s = qk_pre(B, qf); const bool rw = mk.row(kbB); float mx; const float mref = (m < -1e29f) ? 0.f : m; const float biasm = (rw ? 0.f : NEG_INF) - mref;
          if (mk.full(kbB)) { const float bias = biasm;
#pragma unroll
            for (int i = 0; i < 16; ++i) s[i] = s[i] * cs + bias;
            mx = s[0];
#pragma unroll
            for (int i = 1; i < 16; ++i) mx = fmaxf(mx, s[i]);
          } else {
#pragma unroll
            for (int i = 0; i < 16; ++i) { const int key = kbB + crow(i, h); s[i] = mk.elem(key) ? s[i] * cs + biasm : NEG_INF; }
            mx = s[0];
#pragma unroll
            for (int i = 1; i < 16; ++i) mx = fmaxf(mx, s[i]); }
          softmax_pv(s, mx, mref, o0, o1, m, l, vt1, lane); }
        if (!hA) break;
        v_store(A, vt0, lane);
    }
}
struct ItRange { int kb0, kb_last; DI bool next(int& kb) const { const int nk = kb < 0 ? kb0 : kb + 32; if (nk > kb_last) return false; kb = nk; return true; } };
struct ItMoba { unsigned nm; int tmax; DI bool next(int& kb) const {
        if (kb >= 0) { const int nk = kb + 32; if ((nk & 255) && nk <= tmax) { kb = nk; return true; } }
        const int n = kb < 0 ? 0 : (kb >> 8) + 1; if (n > 31) return false; const unsigned mm = nm >> n; if (!mm) return false;
        kb = (n + __builtin_ctz(mm)) * 256; return true; } };
struct ItSlc { unsigned long long lo, hi; int tmax; DI bool next(int& kb) const {
        if (kb >= 0 && !(kb & 32) && kb + 32 <= tmax) { kb += 32; return true; }
        int j = kb < 0 ? 0 : (kb >> 6) + 1; if (j > 127) return false;
        if (j < 64) { const unsigned long long mm = lo >> j; if (mm) { kb = (j + __builtin_ctzll(mm)) * 64; return true; } j = 64; }
        const unsigned long long mh = hi >> (j - 64); if (!mh) return false; kb = (j + __builtin_ctzll(mh)) * 64; return true; } };

constexpr int KROWB = 144, KT2_BYTES = 64 * KROWB, VT2_BYTES = 64 * VROWB, BT_BYTES = KT2_BYTES + VT2_BYTES;
DI void softmax_pv2(f32x16& sa, f32x16& sb, float mx, float mref, f32x16& o0, f32x16& o1, float& m, float& l, const LAS unsigned char* vta, int lane) {
    mx = fmaxf(mx, __shfl_xor(mx, 32));
    const bool upd = (mx > SM_TAU) || (m < -1e29f && mx > -1e30f);
    if (__any(upd)) {
        const float d = upd ? mx : 0.f;
        const float alpha = (m < -1e29f) ? 1.f : ex2(-d);
        if (upd) m = mref + d;
        l *= alpha;
#pragma unroll
        for (int i = 0; i < 16; ++i) { o0[i] *= alpha; o1[i] *= alpha; sa[i] -= d; sb[i] -= d; }
    }
    float rs = 0.f;
#pragma unroll
    for (int i = 0; i < 16; i += 2) { sa[i] = ex2(sa[i]); sa[i + 1] = ex2(sa[i + 1]); sb[i] = ex2(sb[i]); sb[i + 1] = ex2(sb[i + 1]); rs += (sa[i] + sb[i]) + (sa[i + 1] + sb[i + 1]); }
    l += rs;
    u32x4 pa, pb, pc, pd;
    pa.x = pk2(sa[0], sa[1]); pa.y = pk2(sa[2], sa[3]); pa.z = pk2(sa[4], sa[5]); pa.w = pk2(sa[6], sa[7]);
    pb.x = pk2(sa[8], sa[9]); pb.y = pk2(sa[10], sa[11]); pb.z = pk2(sa[12], sa[13]); pb.w = pk2(sa[14], sa[15]);
    pc.x = pk2(sb[0], sb[1]); pc.y = pk2(sb[2], sb[3]); pc.z = pk2(sb[4], sb[5]); pc.w = pk2(sb[6], sb[7]);
    pd.x = pk2(sb[8], sb[9]); pd.y = pk2(sb[10], sb[11]); pd.z = pk2(sb[12], sb[13]); pd.w = pk2(sb[14], sb[15]);
    const bf16x8 p0 = __builtin_bit_cast(bf16x8, pa), p1 = __builtin_bit_cast(bf16x8, pb), p2 = __builtin_bit_cast(bf16x8, pc), p3 = __builtin_bit_cast(bf16x8, pd);
    const int h = lane >> 5, blk = (lane >> 4) & 1, q = (lane & 15) >> 2, p = lane & 3;
    const LAS unsigned char* tb = vta + (4 * h + q) * VROWB + (16 * blk + 4 * p) * 2;
#pragma unroll
    for (int dt = 0; dt < 2; ++dt) {
        s16x4 lo[4], hi[4];
#pragma unroll
        for (int ss = 0; ss < 4; ++ss) { lo[ss] = vtr(tb + (16 * ss) * VROWB + 64 * dt); hi[ss] = vtr(tb + (16 * ss + 8) * VROWB + 64 * dt); }
        asm volatile("" ::: "memory");
#pragma unroll
        for (int ss = 0; ss < 4; ++ss) {
            const bf16x8 vf = __builtin_shufflevector(lo[ss], hi[ss], 0, 1, 2, 3, 4, 5, 6, 7);
            const bf16x8 pp = ss == 0 ? p0 : ss == 1 ? p1 : ss == 2 ? p2 : p3;
            if (dt == 0) o0 = MFMA32(vf, pp, o0); else o1 = MFMA32(vf, pp, o1);
        }
    }
}
#define BLK_ISSUE(kbn) do { regk = *(const u32x4*)(kbase + (size_t)((kbn) + lk) * kstride + lc * 8); if (vbase) regv = *(const u32x4*)(vbase + (size_t)((kbn) + lk) * vstride + lc * 8); } while (0)
#define BLK_STORE(buf) do { *(LAS u32x4*)(tb + (buf) * BT_BYTES + lk * KROWB + lc * 16) = regk; if (vbase) *(LAS u32x4*)(tb + (buf) * BT_BYTES + KT2_BYTES + lk * VROWB + lc * 16) = regv; } while (0)
template <class It, class Mk>
DI void attn_loop_blk(It& it, const Mk& mk, const bf16* kbase, size_t kstride, const bf16* vbase, size_t vstride, const bf16x8 (&qf)[4], float cs,
                      f32x16& o0, f32x16& o1, float& m, float& l, LAS unsigned char* tb, int tid, int lane) {
    const int r = lane & 31, h = lane >> 5;
    const int lk = tid >> 3, lc = tid & 7;
    int kb = -1; bool has = it.next(kb);
    if (has) {
        u32x4 regk = {0u, 0u, 0u, 0u}, regv = {0u, 0u, 0u, 0u};
        BLK_ISSUE(kb); BLK_STORE(0);
        __syncthreads();
        int cur = 0;
        for (;;) {
            int kbn = kb; const bool hn = it.next(kbn);
            if (hn) BLK_ISSUE(kbn);
            if (mk.needs(kb)) {
                const LAS unsigned char* kt = tb + cur * BT_BYTES;
                f32x16 sa, sb;
#pragma unroll
                for (int i = 0; i < 16; ++i) { sa[i] = 0.f; sb[i] = 0.f; }
#pragma unroll
                for (int ks = 0; ks < 4; ++ks) { const bf16x8 ka = *(const LAS bf16x8*)(kt + r * KROWB + (16 * ks + 8 * h) * 2), kc = *(const LAS bf16x8*)(kt + (32 + r) * KROWB + (16 * ks + 8 * h) * 2);
                    sa = MFMA32(ka, qf[ks], sa); sb = MFMA32(kc, qf[ks], sb); }
                const bool rw = mk.row(kb); float mx; const float mref = (m < -1e29f) ? 0.f : m; const float biasm = (rw ? 0.f : NEG_INF) - mref;
                if (mk.full(kb)) { const float bias = biasm;
#pragma unroll
                    for (int i = 0; i < 16; ++i) { sa[i] = sa[i] * cs + bias; sb[i] = sb[i] * cs + bias; }
                    mx = fmaxf(sa[0], sb[0]);
#pragma unroll
                    for (int i = 1; i < 16; ++i) mx = fmaxf(mx, fmaxf(sa[i], sb[i]));
                } else {
#pragma unroll
                    for (int i = 0; i < 16; ++i) { const int key = kb + crow(i, h); sa[i] = mk.elem(key) ? sa[i] * cs + biasm : NEG_INF; sb[i] = mk.elem(key + 32) ? sb[i] * cs + biasm : NEG_INF; }
                    mx = fmaxf(sa[0], sb[0]);
#pragma unroll
                    for (int i = 1; i < 16; ++i) mx = fmaxf(mx, fmaxf(sa[i], sb[i])); }
                softmax_pv2(sa, sb, mx, mref, o0, o1, m, l, kt + KT2_BYTES, lane);
            }
            if (!hn) break;
            BLK_STORE(cur ^ 1);
            __syncthreads();
            cur ^= 1; kb = kbn;
        }
    }
    __syncthreads();
}
struct ItRange64 { int kb0, kb_last; DI bool next(int& kb) const { const int nk = kb < 0 ? kb0 : kb + 64; if (nk > kb_last) return false; kb = nk; return true; } };
struct ItSlc64 { unsigned long long lo, hi; DI bool next(int& kb) const {
        int j = kb < 0 ? 0 : (kb >> 6) + 1; if (j > 127) return false;
        if (j < 64) { const unsigned long long mm = lo >> j; if (mm) { kb = (j + __builtin_ctzll(mm)) * 64; return true; } j = 64; }
        const unsigned long long mh = hi >> (j - 64); if (!mh) return false; kb = (j + __builtin_ctzll(mh)) * 64; return true; } };

constexpr int NSA_WLDS = 2 * VT_BYTES;
constexpr int NSAB_IMP = 2 * BT_BYTES, NSAB_XCH = NSAB_IMP + 8 * 8192, NSAB_END = NSAB_XCH + 128;
DI void nsa_block_unit(int b, int g, int Q0, const bf16* z, const bf16* cqn, const bf16* kcmp, const bf16* vcmp, bf16* O, LAS unsigned char* lds, int tid) {
    const int lane = tid & 63, wave = __builtin_amdgcn_readfirstlane(tid >> 6), tq0 = Q0 + 8 * wave, tmaxb = Q0 + 63;
    LAS unsigned char* tb = lds;
    const int r = lane & 31, h = lane >> 5, qi = r >> 2, hh = r & 3, head = 4 * g + hh, t_row = tq0 + qi, tmax = tq0 + 7;
    const size_t row = (size_t)b * T + t_row;
    LAS float* impA = (LAS float*)(lds + NSAB_IMP + wave * 8192); LAS float* impB = impA + 1024;
    bf16x8 qn[4];
    { const bf16* qnp = cqn + row * 512 + head * 64 + 8 * h;
#pragma unroll
      for (int ks = 0; ks < 4; ++ks) qn[ks] = *(const bf16x8*)(qnp + 16 * ks); }
    const float cs = 0.125f * LOG2E;
    const bf16* gp = z + row * ZLD + Z_CG + head * 3;
    const float gate_c = bf2f(gp[0]), gate_s = bf2f(gp[1]), gate_w = bf2f(gp[2]);
    f32x16 tot0, tot1, o0, o1; ZERO16(tot0); ZERO16(tot1);
    float m, l;
    const bf16* zb = z + (size_t)b * T * ZLD;
    const int ncmp = (tmax >= 31) ? ((tmax - 31) >> 4) + 1 : 0, ntc = (ncmp + 31) >> 5;
    const bf16* kcb = kcmp + (size_t)((b * 2 + g) * 512) * 64; const bf16* vcb = vcmp + (size_t)((b * 2 + g) * 512) * 64;
    ZERO16(o0); ZERO16(o1); m = -1e30f; l = 0.f;
    const int ncmpb = (tmaxb >= 31) ? ((tmaxb - 31) >> 4) + 1 : 0, nscb = (ncmpb + 63) >> 6;
    { struct MkCmp { int t_row, tq0, ncmp; DI bool needs(int nb) const { return nb < ncmp; } DI bool row(int) const { return true; } DI bool elem(int n) const { return 16 * n + 31 <= t_row; } DI bool full(int nb) const { return 16 * (nb + 63) + 31 <= tq0; } } mk{t_row, tq0, ncmp};
      ItRange64 itc{0, 64 * (nscb - 1)};
      attn_loop_blk(itc, mk, kcb, 64, vcb, 64, qn, cs, o0, o1, m, l, tb, tid, lane); }
    float ltot = l + __shfl_xor(l, 32);
    const float inv_c = ltot > 0.f ? 1.f / ltot : 0.f;
    { const float f = gate_c * inv_c;
#pragma unroll
      for (int i = 0; i < 16; ++i) { tot0[i] = o0[i] * f; tot1[i] = o1[i] * f; } }
#pragma unroll
    for (int i = 0; i < 16; ++i) { impA[lane + 64 * i] = 0.f; impB[lane + 64 * i] = 0.f; }
    {
        const int lk = tid >> 3, lc = tid & 7;
        const bf16* kbase = kcb; const size_t kstride = 64; const bf16* vbase = nullptr; const size_t vstride = 0;
        if (nscb > 0) {
            u32x4 regk = {0u, 0u, 0u, 0u}, regv = {0u, 0u, 0u, 0u};
            BLK_ISSUE(0); BLK_STORE(0);
            __syncthreads();
            int cur = 0;
            for (int st = 0; st < nscb; ++st) {
                const int nb0 = 64 * st; const bool hn = st + 1 < nscb;
                if (hn) BLK_ISSUE(nb0 + 64);
                if (nb0 < ncmp) {
                    const LAS unsigned char* ktile = tb + cur * BT_BYTES;
#pragma unroll
                    for (int hf = 0; hf < 2; ++hf) {
                        const int nb = nb0 + 32 * hf, kt = 2 * st + hf;
                        f32x16 s; ZERO16(s);
#pragma unroll
                        for (int ks = 0; ks < 4; ++ks) { const bf16x8 kf = *(const LAS bf16x8*)(ktile + (32 * hf + r) * KROWB + (16 * ks + 8 * h) * 2); s = MFMA32(kf, qn[ks], s); }
#pragma unroll
                        for (int g4 = 0; g4 < 4; ++g4) {
                            float pp[4];
#pragma unroll
                            for (int i = 0; i < 4; ++i) { const int n = nb + 8 * g4 + 4 * h + i; pp[i] = (16 * n + 31 <= t_row) ? ex2(s[4 * g4 + i] * cs - m) * inv_c : 0.f; }
                            float s4 = (pp[0] + pp[1]) + (pp[2] + pp[3]), p3 = pp[3];
                            s4 += __shfl_xor(s4, 1); p3 += __shfl_xor(p3, 1);
                            s4 += __shfl_xor(s4, 2); p3 += __shfl_xor(p3, 2);
                            if (hh == 0) { const int j0 = 8 * kt + 2 * g4 + h; impA[qi * 128 + j0] = s4; impB[qi * 128 + j0] = p3; }
                        }
                    }
                }
                if (!hn) break;
                BLK_STORE(cur ^ 1);
                __syncthreads();
                cur ^= 1;
            }
        }
        __syncthreads();
    }
    const int jq = tmax >> 6;
    unsigned mk0 = 0, mk1 = 0, mk2 = 0, mk3 = 0;
    unsigned long long ulo = 0ull, uhi = 0ull;
    for (int q8 = 0; q8 < 8; ++q8) {
        const int j0 = lane, j1 = lane + 64;
        bool sel0, sel1;
        if (jq + 1 <= 16) { sel0 = j0 <= jq; sel1 = false; }
        else {
            const float i0 = impA[q8 * 128 + j0] + (j0 >= 1 ? impB[q8 * 128 + j0 - 1] : 0.f);
            const float i1 = impA[q8 * 128 + j1] + impB[q8 * 128 + j1 - 1];
            const bool fr0 = (j0 >= 1 && j0 <= jq - 2), fr1 = (j1 <= jq - 2);
            const bool fo0 = (j0 == 0 || j0 == jq || j0 == jq - 1), fo1 = (j1 == jq || j1 == jq - 1);
            const unsigned long long k0 = fr0 ? (((unsigned long long)__builtin_bit_cast(unsigned, i0) << 7) | (unsigned)(127 - j0)) : 0ull;
            const unsigned long long k1 = fr1 ? (((unsigned long long)__builtin_bit_cast(unsigned, i1) << 7) | (unsigned)(127 - j1)) : 0ull;
            unsigned long long Tk = 0ull;
            for (int bit = 38; bit >= 0; --bit) {
                const unsigned long long cand = Tk | (1ull << bit);
                const int cnt = __builtin_popcountll(__ballot(k0 >= cand)) + __builtin_popcountll(__ballot(k1 >= cand));
                if (cnt >= 13) Tk = cand;
            }
            sel0 = fo0 || (fr0 && k0 >= Tk); sel1 = fo1 || (fr1 && k1 >= Tk);
        }
        const unsigned long long mlo = __ballot(sel0), mhi = __ballot(sel1);
        ulo |= mlo; uhi |= mhi;
        if (qi == q8) { mk0 = (unsigned)mlo; mk1 = (unsigned)(mlo >> 32); mk2 = (unsigned)mhi; mk3 = (unsigned)(mhi >> 32); }
    }
#pragma unroll
    for (int i = 0; i < 16; ++i) { impA[i * 64 + lane] = tot0[i]; impA[(16 + i) * 64 + lane] = tot1[i]; }
    bf16x8 qr[4];
    { const bf16* qrp = z + row * ZLD + Z_CQ + head * 64 + 8 * h;
#pragma unroll
      for (int ks = 0; ks < 4; ++ks) qr[ks] = *(const bf16x8*)(qrp + 16 * ks); }
    ZERO16(o0); ZERO16(o1); m = -1e30f; l = 0.f;
    { struct MkSlc { unsigned m0, m1, m2, m3; int t_row; DI bool row(int kb) const { const int j = kb >> 6; const unsigned mw = (j < 32) ? m0 : (j < 64) ? m1 : (j < 96) ? m2 : m3; return (mw >> (j & 31)) & 1u; }
                      DI bool elem(int key) const { return key <= t_row; } DI bool full(int kb) const { return kb + 63 <= tq0; } int tq0; unsigned long long wlo, whi; DI bool needs(int kb) const { const int j = kb >> 6; return kb <= tq0 + 7 && ((j < 64) ? ((wlo >> j) & 1ull) : ((whi >> (j - 64)) & 1ull)); } } mk{mk0, mk1, mk2, mk3, t_row, tq0, ulo, uhi};
      LAS unsigned long long* xch = (LAS unsigned long long*)(lds + NSAB_XCH);
      if (lane == 0) { xch[2 * wave] = ulo; xch[2 * wave + 1] = uhi; }
      __syncthreads();
      unsigned long long blo = 0ull, bhi = 0ull;
#pragma unroll
      for (int ww = 0; ww < 8; ++ww) { blo |= xch[2 * ww]; bhi |= xch[2 * ww + 1]; }
      ItSlc64 its{blo, bhi};
      attn_loop_blk(its, mk, zb + Z_KS + g * 64, ZLD, zb + Z_VS + g * 64, ZLD, qr, cs, o0, o1, m, l, tb, tid, lane); }
    ltot = l + __shfl_xor(l, 32);
    { const float f = gate_s * (ltot > 0.f ? 1.f / ltot : 0.f);
#pragma unroll
      for (int i = 0; i < 16; ++i) { impA[i * 64 + lane] += o0[i] * f; impA[(16 + i) * 64 + lane] += o1[i] * f; } }
    ZERO16(o0); ZERO16(o1); m = -1e30f; l = 0.f;
    { const int klo = tq0 - 511 > 0 ? tq0 - 511 : 0;
      struct MkWin { int t_row, tq0, klo; DI bool needs(int kb) const { return kb <= tq0 + 7 && kb + 63 >= klo; } DI bool row(int) const { return true; } DI bool elem(int key) const { return key <= t_row && t_row - key < 512; } DI bool full(int kb) const { return kb + 63 <= tq0 && (tq0 + 7) - kb < 512; } } mk{t_row, tq0, klo};
      const int klob = Q0 - 511 > 0 ? Q0 - 511 : 0;
      ItRange64 itw{klob & ~63, tmaxb & ~63};
      attn_loop_blk(itw, mk, zb + Z_KW + g * 64, ZLD, zb + Z_VW + g * 64, ZLD, qr, cs, o0, o1, m, l, tb, tid, lane); }
    ltot = l + __shfl_xor(l, 32);
    { const float f = gate_w * (ltot > 0.f ? 1.f / ltot : 0.f);
#pragma unroll
      for (int i = 0; i < 16; ++i) { tot0[i] = impA[i * 64 + lane] + o0[i] * f; tot1[i] = impA[(16 + i) * 64 + lane] + o1[i] * f; } }
    bf16* op = O + row * 512 + head * 64 + 4 * h;
#pragma unroll
    for (int g4 = 0; g4 < 4; ++g4) {
        u32x2 a, c2; a.x = pk2(tot0[4 * g4], tot0[4 * g4 + 1]); a.y = pk2(tot0[4 * g4 + 2], tot0[4 * g4 + 3]);
        c2.x = pk2(tot1[4 * g4], tot1[4 * g4 + 1]); c2.y = pk2(tot1[4 * g4 + 2], tot1[4 * g4 + 3]);
        *(u32x2*)(op + 8 * g4) = a; *(u32x2*)(op + 32 + 8 * g4) = c2;
    }
}

constexpr int MB_SEL = 8 * 12288, MB_LIST = MB_SEL + 1024, MB_KM = MB_LIST + 8 * 512, MB_END = MB_KM + 8192;
constexpr int PART_F = 36;
DI void moba_write_partial(float* pp, bool active, int h, const f32x16& o0, const f32x16& o1, float m, float ltot) {
    if (active) {
#pragma unroll
        for (int g4 = 0; g4 < 4; ++g4) { u32x2 a, c; a.x = pk2(o0[4 * g4], o0[4 * g4 + 1]); a.y = pk2(o0[4 * g4 + 2], o0[4 * g4 + 3]); c.x = pk2(o1[4 * g4], o1[4 * g4 + 1]); c.y = pk2(o1[4 * g4 + 2], o1[4 * g4 + 3]);
            *(u32x2*)((bf16*)pp + 8 * g4 + 4 * h) = a; *(u32x2*)((bf16*)pp + 32 + 8 * g4 + 4 * h) = c; }
        if (h == 0) { pp[32] = m; pp[33] = ltot; }
    }
}
DI void moba_block_item(int b, int head, int own, int item, const bf16* z, const float* kmean, bf16* O, float* part, LAS unsigned char* lds, int tid) {
    const int lane = tid & 63, wave = __builtin_amdgcn_readfirstlane(tid >> 6), r = lane & 31, h = lane >> 5;
    const int Q0 = 256 * own, tq0 = Q0 + 32 * wave, t_row = tq0 + r, tmax = tq0 + 31;
    const size_t row = (size_t)b * T + t_row;
    LAS unsigned char* vt = lds + wave * NSA_WLDS;
    LAS unsigned* selb = (LAS unsigned*)(lds + MB_SEL);
    LAS unsigned short* rlist = (LAS unsigned short*)(lds + MB_LIST + wave * 512);
    const bf16* zb = z + (size_t)b * T * ZLD;
    float* pbase = part + (size_t)item * 256 * 4 * PART_F;
    const float cs = 0.125f * LOG2E;
    LAS float* kml = (LAS float*)(lds + MB_KM);
    __syncthreads();
    { const int e = tid * 4, n = e >> 6, d = e & 63; *(LAS f32x4*)(kml + e) = *(const f32x4*)(kmean + (size_t)((b * 32 + n) * 256 + head * 64 + d)); }
    __syncthreads();
    int i0 = -1, i1 = -1, i2 = -1;
    {
        u32x4 qrow[8];
        { const u32x4* qp = (const u32x4*)(z + row * ZLD + Z_BQ + head * 64);
#pragma unroll
          for (int c = 0; c < 8; ++c) qrow[c] = qp[c]; }
        float v0 = NEG_INF, v1 = NEG_INF, v2 = NEG_INF;
        for (int n = 0; n < own; ++n) {
            const LAS f32x4* km = (const LAS f32x4*)(kml + n * 64);
            float gsum = 0.f;
#pragma unroll
            for (int c = 0; c < 8; ++c) { const f32x4 ka = km[2 * c], kb2 = km[2 * c + 1]; const u32x4 qq = qrow[c];
                gsum += bflo(qq.x) * ka.x + bfhi(qq.x) * ka.y + bflo(qq.y) * ka.z + bfhi(qq.y) * ka.w + bflo(qq.z) * kb2.x + bfhi(qq.z) * kb2.y + bflo(qq.w) * kb2.z + bfhi(qq.w) * kb2.w; }
            if (gsum > v0) { v2 = v1; i2 = i1; v1 = v0; i1 = i0; v0 = gsum; i0 = n; }
            else if (gsum > v1) { v2 = v1; i2 = i1; v1 = gsum; i1 = n; }
            else if (gsum > v2) { v2 = gsum; i2 = n; }
        }
    }
    if (h == 0) selb[32 * wave + r] = (unsigned)(i0 & 0xff) | ((unsigned)(i1 & 0xff) << 8) | ((unsigned)(i2 & 0xff) << 16);
    {
        bf16x8 qf[4];
        { const bf16* qp = z + row * ZLD + Z_BQ + head * 64 + 8 * h;
#pragma unroll
          for (int ks = 0; ks < 4; ++ks) qf[ks] = *(const bf16x8*)(qp + 16 * ks); }
        f32x16 o0, o1; ZERO16(o0); ZERO16(o1); float m = -1e30f, l = 0.f;
        struct MkOwn { int t_row, tq0; DI bool row(int) const { return true; } DI bool elem(int key) const { return key <= t_row; } DI bool full(int kb) const { return kb + 31 <= tq0; } } mk{t_row, tq0};
        ItMoba itm{1u << own, tmax};
        attn_loop(itm, mk, zb + Z_BK + head * 64, ZLD, zb + Z_BV + head * 64, ZLD, qf, cs, o0, o1, m, l, vt, vt + VT_BYTES, lane);
        const float ltot = l + __shfl_xor(l, 32);
        moba_write_partial(pbase + ((size_t)(32 * wave + r) * 4 + 3) * PART_F, true, h, o0, o1, m, ltot);
    }
    __syncthreads();
#pragma unroll 1
    for (int n = 0; n < own; ++n) {
        int cnt = 0;
#pragma unroll
        for (int j = 0; j < 4; ++j) { const int q = lane + 64 * j; const unsigned sv = selb[q];
            const int slot = ((sv & 0xffu) == (unsigned)n) ? 0 : (((sv >> 8) & 0xffu) == (unsigned)n) ? 1 : (((sv >> 16) & 0xffu) == (unsigned)n) ? 2 : -1;
            const bool pr = slot >= 0; const unsigned long long mk_ = __ballot(pr);
            const int pos = cnt + (int)__builtin_amdgcn_mbcnt_hi((unsigned)(mk_ >> 32), __builtin_amdgcn_mbcnt_lo((unsigned)mk_, 0u));
            if (pr) rlist[pos] = (unsigned short)(q | (slot << 8));
            cnt += __builtin_popcountll(mk_); }
#pragma unroll 1
        for (int rt = (wave - n) & 7; rt * 32 < cnt; rt += 8) {
            const bool active = rt * 32 + r < cnt;
            const unsigned ent = rlist[active ? rt * 32 + r : 0];
            const int q = ent & 0xff, slot = (int)(ent >> 8);
            bf16x8 qf[4];
            { const bf16* qp = zb + (size_t)(Q0 + q) * ZLD + Z_BQ + head * 64 + 8 * h;
#pragma unroll
              for (int ks = 0; ks < 4; ++ks) qf[ks] = *(const bf16x8*)(qp + 16 * ks); }
            f32x16 o0, o1; ZERO16(o0); ZERO16(o1); float m = -1e30f, l = 0.f;
            struct MkAll { bool act; DI bool row(int) const { return act; } DI bool elem(int) const { return true; } DI bool full(int) const { return true; } } mk{active};
            ItMoba itm{1u << n, 0x7fffffff};
            attn_loop(itm, mk, zb + Z_BK + head * 64, ZLD, zb + Z_BV + head * 64, ZLD, qf, cs, o0, o1, m, l, vt, vt + VT_BYTES, lane);
            const float ltot = l + __shfl_xor(l, 32);
            moba_write_partial(pbase + ((size_t)q * 4 + slot) * PART_F, active, h, o0, o1, m, ltot);
        }
    }
    VM_WAIT();
    __syncthreads();
    {
        const float* pq = pbase + (size_t)(32 * wave + r) * 4 * PART_F;
        float mm[4], ll[4];
        { float mr[4], lr[4];
#pragma unroll
          for (int sl = 0; sl < 4; ++sl) { mr[sl] = pq[sl * PART_F + 32]; lr[sl] = pq[sl * PART_F + 33]; }
#pragma unroll
          for (int sl = 0; sl < 4; ++sl) { const bool valid = (sl == 3) || ((sl == 0 ? i0 : sl == 1 ? i1 : i2) >= 0);
              mm[sl] = valid ? mr[sl] : -1e30f; ll[sl] = valid ? lr[sl] : 0.f; } }
        const float M_ = fmaxf(fmaxf(mm[0], mm[1]), fmaxf(mm[2], mm[3]));
        float wgt[4], L = 0.f;
#pragma unroll
        for (int sl = 0; sl < 4; ++sl) { wgt[sl] = ex2(mm[sl] - M_); if (ll[sl] == 0.f) wgt[sl] = 0.f; L += ll[sl] * wgt[sl]; }
        const float inv = (L > 0.f ? 1.f / L : 0.f);
        bf16* op = O + row * 256 + head * 64 + 4 * h;
#pragma unroll
        for (int g4 = 0; g4 < 4; ++g4) {
            u32x2 pua[4], pub[4];
#pragma unroll
            for (int sl = 0; sl < 4; ++sl) { pua[sl] = *(const u32x2*)((const bf16*)(pq + sl * PART_F) + 8 * g4 + 4 * h); pub[sl] = *(const u32x2*)((const bf16*)(pq + sl * PART_F) + 32 + 8 * g4 + 4 * h); }
            f32x4 a = {0.f, 0.f, 0.f, 0.f}, c2 = {0.f, 0.f, 0.f, 0.f};
#pragma unroll
            for (int sl = 0; sl < 4; ++sl) { const bool use = wgt[sl] != 0.f;
                u32x2 ua_ = pua[sl], ub_ = pub[sl];
                ua_.x = use ? ua_.x : 0u; ua_.y = use ? ua_.y : 0u; ub_.x = use ? ub_.x : 0u; ub_.y = use ? ub_.y : 0u;
                const f32x4 pa = {bflo(ua_.x), bfhi(ua_.x), bflo(ua_.y), bfhi(ua_.y)}, pb = {bflo(ub_.x), bfhi(ub_.x), bflo(ub_.y), bfhi(ub_.y)};
                a = a + pa * wgt[sl]; c2 = c2 + pb * wgt[sl]; }
            u32x2 ua, uc; ua.x = pk2(a[0] * inv, a[1] * inv); ua.y = pk2(a[2] * inv, a[3] * inv); uc.x = pk2(c2[0] * inv, c2[1] * inv); uc.y = pk2(c2[2] * inv, c2[3] * inv);
            *(u32x2*)(op + 8 * g4) = ua; *(u32x2*)(op + 32 + 8 * g4) = uc;
        }
    }
}

DI void kmean_item(int it, const bf16* z, float* kmean, LAS unsigned char* lds, int tid) {
    const int b = it >> 5, n = it & 31, col = tid & 255, half = tid >> 8;
    const bf16* p = z + ((size_t)b * T + 256 * n + 128 * half) * ZLD + Z_BK + col;
    float a = 0.f;
#pragma unroll 8
    for (int k = 0; k < 128; ++k) a += bf2f(p[(size_t)k * ZLD]);
    LAS float* red = (LAS float*)lds;
    __syncthreads();
    if (half) red[col] = a;
    __syncthreads();
    if (!half) kmean[(size_t)(b * 32 + n) * 256 + col] = (a + red[col]) * (1.f / 256.f);
    __syncthreads();
}

DI float gelu_tanh(float x) { const float u = 0.7978845608028654f * (x + 0.044715f * x * x * x); const float e = ex2(2.f * LOG2E * u); const float th = 1.f - 2.f * __builtin_amdgcn_rcpf(e + 1.f); return 0.5f * x * (1.f + th); }
DI void compress_item(int it, const bf16* z, const bf16* Wb, const float* bias1p, bf16* kcmp, bf16* vcmp, LAS unsigned char* lds, int tid) {
    const int lane = tid & 63, wave = tid >> 6, r = lane & 31, h = lane >> 5;
    const int kv = it & 1, rtile = it >> 1, kh = wave >> 2, ut = wave & 3;
    const int R0 = 32 * rtile;
    const int bg = R0 >> 9, b = bg >> 1, g = bg & 1, n0 = R0 & 511;
    const bf16* w1t = Wb + (kv ? W_1V : W_1K); const bf16* w2t = Wb + (kv ? W_2V : W_2K);
    bf16* outp = kv ? vcmp : kcmp;
    int n = n0 + r; if (n > 510) n = 510;
    const bf16* ap = z + ((size_t)b * T + 16 * n) * ZLD + (kv ? Z_VC : Z_KC) + g * 64 + 8 * h;
    const bf16* bp = w1t + (size_t)(ut * 32 + r) * 2048 + 8 * h;
    f32x16 acc; ZERO16(acc);
#pragma unroll 8
    for (int kk = 0; kk < 64; ++kk) {
        const int ks = 64 * kh + kk, k0 = 16 * ks, ti = k0 >> 6, d = k0 & 63;
        const bf16x8 a = *(const bf16x8*)(ap + (size_t)ti * ZLD + d);
        const bf16x8 bb = *(const bf16x8*)(bp + k0);
        acc = MFMA32(a, bb, acc);
    }
    constexpr int HROW = 272, PSTR = 129, HID_OFF = 2 * 32 * PSTR * 4;
    LAS float* ps = (LAS float*)lds;
    __syncthreads();
#pragma unroll
    for (int i = 0; i < 16; ++i) ps[(kh * 32 + crow(i, h)) * PSTR + ut * 32 + r] = acc[i];
    __syncthreads();
    { const int u = tid & 127, rq = tid >> 7; float bias = 0.f;
#pragma unroll
      for (int c = 0; c < 8; ++c) bias += bias1p[(kv * 8 + c) * 128 + u];
#pragma unroll
      for (int i = 0; i < 8; ++i) { const int rowl = rq * 8 + i; const float v = ps[rowl * PSTR + u] + ps[(32 + rowl) * PSTR + u] + bias;
          *(LAS bf16*)(lds + HID_OFF + rowl * HROW + u * 2) = (bf16)f2bf(gelu_tanh(v)); } }
    __syncthreads();
    if (wave < 2) {
        const int ot = wave;
        f32x16 c2; ZERO16(c2);
#pragma unroll
        for (int ks = 0; ks < 8; ++ks) {
            const bf16x8 a = *(const LAS bf16x8*)(lds + HID_OFF + r * HROW + (16 * ks + 8 * h) * 2);
            const bf16x8 bb = *(const bf16x8*)(w2t + (size_t)(ot * 32 + r) * 128 + 16 * ks + 8 * h);
            c2 = MFMA32(a, bb, c2);
        }
#pragma unroll
        for (int i = 0; i < 16; ++i) { const int R = R0 + crow(i, h); const bool dead = (R & 511) == 511;
            outp[(size_t)R * 64 + ot * 32 + r] = dead ? (bf16)0 : (bf16)f2bf(c2[i]); }
    }
    __syncthreads();
}

constexpr int DS_S = 0, DS_SEL = 65536, DS_P = DS_SEL + 8 * 1024, DS_DMY = DS_P + 8 * 4096, DSA_LDS_END = DS_DMY + 8 * 256;
DI float relu_i(float x) { const int b = __builtin_bit_cast(int, x); return __builtin_bit_cast(float, b > 0 ? b : 0); }
DI unsigned orderkey(float s) { const unsigned u = __builtin_bit_cast(unsigned, s); return (u & 0x80000000u) ? ~u : (u | 0x80000000u); }
#define DPP_I(v, ctrl) __builtin_amdgcn_update_dpp(0, (v), (ctrl), 0xf, 0xf, false)
DI int row16_sum(int c) { c += DPP_I(c, 0x128); c += DPP_I(c, 0x124); c += DPP_I(c, 0x122); c += DPP_I(c, 0x121); return c; }
DI int wave_sum_i(int c) { c = row16_sum(c); return __builtin_amdgcn_readlane(c, 0) + __builtin_amdgcn_readlane(c, 16) + __builtin_amdgcn_readlane(c, 32) + __builtin_amdgcn_readlane(c, 48); }
#define DPP_F(v, ctrl) __builtin_bit_cast(float, DPP_I(__builtin_bit_cast(int, (v)), (ctrl)))
DI float row16_max(float v) { v = fmaxf(v, DPP_F(v, 0x128)); v = fmaxf(v, DPP_F(v, 0x124)); v = fmaxf(v, DPP_F(v, 0x122)); v = fmaxf(v, DPP_F(v, 0x121)); return v; }
DI float row16_sumf(float v) { v += DPP_F(v, 0x128); v += DPP_F(v, 0x124); v += DPP_F(v, 0x122); v += DPP_F(v, 0x121); return v; }
DI float oct_sumf(float v) {
    v += __builtin_bit_cast(float, DPP_I(__builtin_bit_cast(int, v), 0xB1));
    v += __builtin_bit_cast(float, DPP_I(__builtin_bit_cast(int, v), 0x4E));
    v += __builtin_bit_cast(float, DPP_I(__builtin_bit_cast(int, v), 0x141));
    return v; }
DI unsigned umin_(unsigned a, unsigned b) { return a < b ? a : b; }
DI unsigned umax_(unsigned a, unsigned b) { return a > b ? a : b; }
#define DPP_U(v, ctrl) ((unsigned)DPP_I((int)(v), (ctrl)))
DI unsigned wave_minu(unsigned v) { v = umin_(v, DPP_U(v, 0x128)); v = umin_(v, DPP_U(v, 0x124)); v = umin_(v, DPP_U(v, 0x122)); v = umin_(v, DPP_U(v, 0x121));
    return umin_(umin_((unsigned)__builtin_amdgcn_readlane((int)v, 0), (unsigned)__builtin_amdgcn_readlane((int)v, 16)), umin_((unsigned)__builtin_amdgcn_readlane((int)v, 32), (unsigned)__builtin_amdgcn_readlane((int)v, 48))); }
DI unsigned wave_maxu(unsigned v) { v = umax_(v, DPP_U(v, 0x128)); v = umax_(v, DPP_U(v, 0x124)); v = umax_(v, DPP_U(v, 0x122)); v = umax_(v, DPP_U(v, 0x121));
    return umax_(umax_((unsigned)__builtin_amdgcn_readlane((int)v, 0), (unsigned)__builtin_amdgcn_readlane((int)v, 16)), umax_((unsigned)__builtin_amdgcn_readlane((int)v, 32), (unsigned)__builtin_amdgcn_readlane((int)v, 48))); }
template <int NE>
DI void dsa_select(const unsigned (&ek)[NE], const int (&ei)[NE], unsigned& Tprev, LAS unsigned* selk, LAS int* selw, LAS unsigned* dmy, int& nsel, int lane, int nvalid) {
    unsigned L = Tprev, Kmax;
    { unsigned gm = 0u;
      if constexpr (NE == 36) {
          unsigned g4[4];
#pragma unroll
          for (int q = 0; q < 4; ++q) { unsigned g = ek[9 * q];
#pragma unroll
              for (int i = 1; i < 9; ++i) g = umax_(g, ek[9 * q + i]);
              g4[q] = g; }
          gm = umax_(umax_(g4[0], g4[1]), umax_(g4[2], g4[3]));
          const unsigned L2 = wave_minu(umin_(umin_(g4[0], g4[1]), umin_(g4[2], g4[3])));
          if (L2 > L) L = L2;
      } else {
#pragma unroll
          for (int i = 0; i < NE; ++i) gm = umax_(gm, ek[i]);
      }
      Kmax = wave_maxu(gm); }
    unsigned Tv = 0u; bool exact = false;
    int cHi = 0, cLo = nvalid, cBase = 0; bool compact = false; unsigned a0 = 0u, a1 = 0u, a2 = 0u, a3 = 0u;
    for (int bit = (nvalid > 256) ? 31 : -1; bit >= 0; --bit) {
        const unsigned cand = Tv | (1u << bit);
        if (cand <= L) { Tv = cand; continue; }
        if (cand > Kmax) continue;
        if constexpr (NE == 10) {
            if (bit >= 1) {
                const unsigned c1 = Tv | (1u << (bit - 1)), c3 = cand | (1u << (bit - 1));
                int l1 = 0, l2 = 0, l3 = 0, tmp; unsigned v1 = c1, v2 = cand, v3 = c3;
#define DSA_LT3(x) asm volatile("v_sub_co_u32_e32 %3, vcc, %4, %5\n\tv_addc_co_u32_e32 %0, vcc, 0, %0, vcc\n\tv_sub_co_u32_e32 %3, vcc, %4, %6\n\tv_addc_co_u32_e32 %1, vcc, 0, %1, vcc\n\t" \
                                "v_sub_co_u32_e32 %3, vcc, %4, %7\n\tv_addc_co_u32_e32 %2, vcc, 0, %2, vcc" : "+v"(l1), "+v"(l2), "+v"(l3), "=&v"(tmp) : "v"(x), "v"(v1), "v"(v2), "v"(v3) : "vcc");
#pragma unroll
                for (int i = 0; i < NE; ++i) { DSA_LT3(ek[i]) }
#undef DSA_LT3
                const int pk = wave_sum_i(l1 | (l2 << 10) | (l3 << 20));
                const int n1 = 64 * NE - (pk & 1023), n2 = 64 * NE - ((pk >> 10) & 1023), n3 = 64 * NE - (pk >> 20);
                int nsel_ = 0;
                if (n3 >= 256) { Tv = c3; nsel_ = n3; } else if (n2 >= 256) { Tv = cand; nsel_ = n2; } else if (n1 >= 256) { Tv = c1; nsel_ = n1; }
                --bit;
                if (nsel_ == 256) { exact = true; break; }
                continue;
            }
        }
        int tot;
        if (compact) {
            tot = cBase + __builtin_popcountll(__ballot(a0 >= cand)) + __builtin_popcountll(__ballot(a1 >= cand)) + __builtin_popcountll(__ballot(a2 >= cand)) + __builtin_popcountll(__ballot(a3 >= cand));
        } else {
            int lt0 = 0, lt1 = 0, tmp; unsigned cv = cand;
#define DSA_LT(acc, x) asm volatile("v_sub_co_u32_e32 %1, vcc, %2, %3\n\tv_addc_co_u32_e32 %0, vcc, 0, %0, vcc" : "+v"(acc), "=&v"(tmp) : "v"(x), "v"(cv) : "vcc");
#pragma unroll
            for (int i = 0; i < NE; i += 2) { DSA_LT(lt0, ek[i]) DSA_LT(lt1, ek[i + 1]) }
#undef DSA_LT
            tot = 64 * NE - wave_sum_i(lt0 + lt1);
        }
        if (tot >= 256) { Tv = cand; cLo = tot; if (tot == 256) { exact = true; break; } }
        else cHi = tot;
        if constexpr (NE == 36) {
            if (!compact && bit > 0 && cLo - cHi <= 256) {
                LAS unsigned* tk = selk + 256; const unsigned lo1 = Tv ? Tv : 1u, span = Tv + (1u << bit) - lo1; int ns = 0;
#pragma unroll
                for (int i = 0; i < NE; ++i) { const bool s_ = (ek[i] - lo1) < span; const unsigned long long mk_ = __ballot(s_);
                    const int pos_ = (int)__builtin_amdgcn_mbcnt_hi((unsigned)(mk_ >> 32), __builtin_amdgcn_mbcnt_lo((unsigned)mk_, (unsigned)ns));
                    *(s_ ? tk + pos_ : dmy) = ek[i]; ns += __builtin_popcountll(mk_); }
                { const unsigned r0 = tk[lane], r1 = tk[64 + lane], r2 = tk[128 + lane], r3 = tk[192 + lane];
                  a0 = (lane < ns) ? r0 : 0u; a1 = (64 + lane < ns) ? r1 : 0u; a2 = (128 + lane < ns) ? r2 : 0u; a3 = (192 + lane < ns) ? r3 : 0u; }
                compact = true; cBase = cHi;
            }
        }
    }
    int Xi = 0x7fffffff;
    if (!exact) {
        if (Tv == 0u) Tv = 1u;
        else {
            int cg = 0, ce = 0;
#pragma unroll
            for (int i = 0; i < NE; ++i) { cg += (ek[i] > Tv) ? 1 : 0; ce += (ek[i] == Tv) ? 1 : 0; }
            const int tg = wave_sum_i(cg), te = wave_sum_i(ce), need = 256 - tg;
            if (te != need) {
                int X = 0;
                for (int bit = 12; bit >= 0; --bit) {
                    const int cand = X | (1 << bit);
                    int cnt = 0;
#pragma unroll
                    for (int i = 0; i < NE; ++i) cnt += (ek[i] == Tv && ei[i] < cand) ? 1 : 0;
                    if (wave_sum_i(cnt) < need) X = cand;
                }
                Xi = X;
            }
        }
    }
    int run = 0;
#pragma unroll
    for (int i = 0; i < NE; ++i) { const bool s_ = (ek[i] > Tv) || (ek[i] == Tv && ei[i] <= Xi); const unsigned long long mk_ = __ballot(s_);
        const int pos_ = (int)__builtin_amdgcn_mbcnt_hi((unsigned)(mk_ >> 32), __builtin_amdgcn_mbcnt_lo((unsigned)mk_, (unsigned)run));
        const bool w_ = s_ && pos_ < 256;
        *(w_ ? selk + pos_ : dmy) = ek[i]; *(w_ ? selw + pos_ : (LAS int*)dmy) = ei[i]; run += __builtin_popcountll(mk_); }
    nsel = run > 256 ? 256 : run;
    Tprev = (run >= 256) ? Tv : 0u;
}
DI void dsa_item(int item, const bf16* z, bf16* O, LAS unsigned char* lds, int tid) {
    const int lane = tid & 63, w = __builtin_amdgcn_readfirstlane(tid >> 6);
    const int b = item & 1, tq0 = (item >> 1) * 8, tmax = tq0 + 7, tq = tq0 + w;
    const bf16* zb = z + (size_t)b * T * ZLD;
    const char* zbb = (const char*)zb;
    LAS unsigned* S = (LAS unsigned*)(lds + DS_S);
    LAS int* selw = (LAS int*)(lds + DS_SEL) + w * 256;
    LAS unsigned* selk = (LAS unsigned*)(lds + DS_P) + w * 1024;
    LAS float* pl = (LAS float*)(lds + DS_P) + w * 1024;
    LAS unsigned* dmy = (LAS unsigned*)(lds + DS_DMY) + w * 64 + lane;
    const int qq = lane >> 4, kq = lane >> 4, l15 = lane & 15;
    const int nchunk = (tmax >> 11) + 1;
    unsigned cs0 = 0u, cs1 = 0u, cs2 = 0u, cs3 = 0u; int ci0 = 0, ci1 = 0, ci2 = 0, ci3 = 0; int nsel = 0;
    unsigned Tprev = 0u;
    __syncthreads();
    bf16x8 af0, af1, ag0, ag1;
    { const int qa = l15 >> 2, ha = l15 & 3; const bf16* p = zb + (size_t)(tq0 + qa) * ZLD + Z_IQ + ha * 64 + 8 * kq;
      af0 = *(const bf16x8*)p; af1 = *(const bf16x8*)(p + 32); ag0 = *(const bf16x8*)(p + 4 * ZLD); ag1 = *(const bf16x8*)(p + 4 * ZLD + 32); }
#define DSA_KLOAD(b0, b1, c_, bt_) do { _Pragma("unroll") for (int i = 0; i < 8; ++i) { const int kl_ = (w + 8 * (8 * (bt_) + i)) * 16 + l15; \
        const unsigned ko_ = ((unsigned)((c_) * 2048 + kl_) * (unsigned)ZLD + (unsigned)(Z_IK + 8 * kq)) * 2u; b0[i] = *(const bf16x8*)(zbb + ko_); b1[i] = *(const bf16x8*)(zbb + ko_ + 64u); } } while (0)
#define DSA_KSCORE(b0, b1, c_, bt_) do { _Pragma("unroll") for (int i = 0; i < 8; ++i) { const int kl_ = (w + 8 * (8 * (bt_) + i)) * 16 + l15; \
        f32x4 cl = {0.f, 0.f, 0.f, 0.f}, ch = {0.f, 0.f, 0.f, 0.f}; \
        cl = MFMA16(af0, b0[i], cl); cl = MFMA16(af1, b1[i], cl); ch = MFMA16(ag0, b0[i], ch); ch = MFMA16(ag1, b1[i], ch); \
        const float sl = iwl0 * relu_i(cl[0]) + iwl1 * relu_i(cl[1]) + iwl2 * relu_i(cl[2]) + iwl3 * relu_i(cl[3]); \
        const float sh = iwh0 * relu_i(ch[0]) + iwh1 * relu_i(ch[1]) + iwh2 * relu_i(ch[2]) + iwh3 * relu_i(ch[3]); \
        S[qq * 2048 + kl_] = orderkey(sl); S[(4 + qq) * 2048 + kl_] = orderkey(sh); } } while (0)
    bf16x8 pb0[8], pb1[8];
    DSA_KLOAD(pb0, pb1, 0, 0);
#pragma unroll 1
    for (int c = 0; c < nchunk; ++c) {
        {
            float iwl0, iwl1, iwl2, iwl3, iwh0, iwh1, iwh2, iwh3;
            { const u32x2 a = *(const u32x2*)(zb + (size_t)(tq0 + qq) * ZLD + Z_IW), cc = *(const u32x2*)(zb + (size_t)(tq0 + 4 + qq) * ZLD + Z_IW);
              iwl0 = bflo(a.x); iwl1 = bfhi(a.x); iwl2 = bflo(a.y); iwl3 = bfhi(a.y); iwh0 = bflo(cc.x); iwh1 = bfhi(cc.x); iwh2 = bflo(cc.y); iwh3 = bfhi(cc.y); }
            bf16x8 qb0[8], qb1[8];
            const bool second = c * 2048 + 1024 <= tmax;
            if (second) { DSA_KLOAD(qb0, qb1, c, 1); DSA_KSCORE(pb0, pb1, c, 0); DSA_KSCORE(qb0, qb1, c, 1); }
            else DSA_KSCORE(pb0, pb1, c, 0);
        }
        if (c + 1 < nchunk) DSA_KLOAD(pb0, pb1, c + 1, 0);
        __syncthreads();
        unsigned sc[32];
        const int kbase = c * 2048 + lane * 4;
#pragma unroll
        for (int j = 0; j < 8; ++j) { const u32x4 v = *(const LAS u32x4*)(S + w * 2048 + j * 256 + lane * 4); const int key = kbase + j * 256;
            sc[j * 4 + 0] = (key + 0 <= tq) ? v.x : 0u; sc[j * 4 + 1] = (key + 1 <= tq) ? v.y : 0u;
            sc[j * 4 + 2] = (key + 2 <= tq) ? v.z : 0u; sc[j * 4 + 3] = (key + 3 <= tq) ? v.w : 0u; }
        __syncthreads();
        if (c * 2048 <= tq) {
            bool done = false;
            if (Tprev != 0u) {
                LAS unsigned* tk = selk + 256; LAS int* ti = (LAS int*)(selk + 640);
                int ns = 0;
#pragma unroll
                for (int i = 0; i < 32; ++i) { const bool s_ = sc[i] >= Tprev; const unsigned long long mk_ = __ballot(s_);
                    const int pos_ = (int)__builtin_amdgcn_mbcnt_hi((unsigned)(mk_ >> 32), __builtin_amdgcn_mbcnt_lo((unsigned)mk_, (unsigned)ns));
                    const bool w_ = s_ && pos_ < 384;
                    *(w_ ? tk + pos_ : dmy) = sc[i]; *(w_ ? ti + pos_ : (LAS int*)dmy) = kbase + (i >> 2) * 256 + (i & 3); ns += __builtin_popcountll(mk_); }
                if (ns <= 384) {
                    unsigned ek[10]; int ei[10];
                    ek[0] = cs0; ek[1] = cs1; ek[2] = cs2; ek[3] = cs3; ei[0] = ci0; ei[1] = ci1; ei[2] = ci2; ei[3] = ci3;
#pragma unroll
                    for (int j = 0; j < 6; ++j) { const int p_ = j * 64 + lane; const unsigned rk_ = tk[p_]; const int ri_ = ti[p_]; ek[4 + j] = (p_ < ns) ? rk_ : 0u; ei[4 + j] = (p_ < ns) ? ri_ : 0; }
                    dsa_select<10>(ek, ei, Tprev, selk, selw, dmy, nsel, lane, 640);
                    done = true;
                }
            }
            if (!done) {
                unsigned ek[36]; int ei[36];
                ek[0] = cs0; ek[1] = cs1; ek[2] = cs2; ek[3] = cs3; ei[0] = ci0; ei[1] = ci1; ei[2] = ci2; ei[3] = ci3;
#pragma unroll
                for (int i = 0; i < 32; ++i) { ek[4 + i] = sc[i]; ei[4 + i] = kbase + (i >> 2) * 256 + (i & 3); }
                dsa_select<36>(ek, ei, Tprev, selk, selw, dmy, nsel, lane, (c == 0) ? ((tq < 2047 ? tq : 2047) + 1) : 2304);
            }
            { const unsigned r0 = selk[lane], r1 = selk[64 + lane], r2 = selk[128 + lane], r3 = selk[192 + lane];
              cs0 = (lane < nsel) ? r0 : 0u; cs1 = (64 + lane < nsel) ? r1 : 0u; cs2 = (128 + lane < nsel) ? r2 : 0u; cs3 = (192 + lane < nsel) ? r3 : 0u; }
            ci0 = selw[lane]; ci1 = selw[64 + lane]; ci2 = selw[128 + lane]; ci3 = selw[192 + lane];
        }
    }
    {
        const float cs = 0.125f * LOG2E;
        bf16x8 qa0 = {0, 0, 0, 0, 0, 0, 0, 0}, qa1 = {0, 0, 0, 0, 0, 0, 0, 0};
        if (l15 < 4) { const bf16* p = zb + (size_t)tq * ZLD + Z_AQ + l15 * 64 + 8 * kq; qa0 = *(const bf16x8*)p; qa1 = *(const bf16x8*)(p + 32); }
        float mx0 = NEG_INF, mx1 = NEG_INF, mx2 = NEG_INF, mx3 = NEG_INF;
        const int kg = lane & 7, dc = lane >> 3;
#define DSA_AKLOAD(k0, k1, tg_) do { _Pragma("unroll") for (int t4 = 0; t4 < 4; ++t4) { const int jl_ = ((tg_) * 4 + t4) * 16 + l15; const int kraw_ = selw[jl_]; const int kidx_ = (jl_ < nsel) ? kraw_ : 0; \
        const unsigned ko_ = ((unsigned)kidx_ * (unsigned)ZLD + (unsigned)(Z_AK + 8 * kq)) * 2u; k0[t4] = *(const bf16x8*)(zbb + ko_); k1[t4] = *(const bf16x8*)(zbb + ko_ + 64u); } } while (0)
#define DSA_AKSCORE(k0, k1, tg_) do { _Pragma("unroll") for (int t4 = 0; t4 < 4; ++t4) { f32x4 c_ = {0.f, 0.f, 0.f, 0.f}; c_ = MFMA16(qa0, k0[t4], c_); c_ = MFMA16(qa1, k1[t4], c_); \
        const int jl_ = ((tg_) * 4 + t4) * 16 + l15; const bool valid_ = jl_ < nsel; \
        f32x4 sv_; sv_.x = valid_ ? c_[0] * cs : NEG_INF; sv_.y = valid_ ? c_[1] * cs : NEG_INF; sv_.z = valid_ ? c_[2] * cs : NEG_INF; sv_.w = valid_ ? c_[3] * cs : NEG_INF; \
        if (lane < 16) { *(LAS f32x4*)(pl + jl_ * 4) = sv_; mx0 = fmaxf(mx0, sv_.x); mx1 = fmaxf(mx1, sv_.y); mx2 = fmaxf(mx2, sv_.z); mx3 = fmaxf(mx3, sv_.w); } } } while (0)
#define DSA_VLOAD(vv, j0_) do { _Pragma("unroll") for (int i = 0; i < 8; ++i) { const int jl_ = (j0_) + 8 * i + kg; const int kraw_ = selw[jl_]; const int kidx_ = (jl_ < nsel) ? kraw_ : 0; \
        vv[i] = *(const u32x4*)(zbb + ((unsigned)kidx_ * (unsigned)ZLD + (unsigned)(Z_AV + 8 * dc)) * 2u); } } while (0)
        u32x4 va[8], vb[8];
        {
            bf16x8 ka0[4], ka1[4], kb0[4], kb1[4];
            DSA_AKLOAD(ka0, ka1, 0);
            if (64 < nsel) DSA_AKLOAD(kb0, kb1, 1);
            DSA_AKSCORE(ka0, ka1, 0);
            if (128 < nsel) DSA_AKLOAD(ka0, ka1, 2);
            if (64 < nsel) DSA_AKSCORE(kb0, kb1, 1);
            if (192 < nsel) DSA_AKLOAD(kb0, kb1, 3);
            DSA_VLOAD(va, 0);
            if (128 < nsel) DSA_AKSCORE(ka0, ka1, 2);
            if (64 < nsel) DSA_VLOAD(vb, 64);
            if (192 < nsel) DSA_AKSCORE(kb0, kb1, 3);
        }
        float mh[4], lh[4];
        mh[0] = fmaxf(__builtin_bit_cast(float, __builtin_amdgcn_readlane(__builtin_bit_cast(int, row16_max(mx0)), 0)), -1e30f);
        mh[1] = fmaxf(__builtin_bit_cast(float, __builtin_amdgcn_readlane(__builtin_bit_cast(int, row16_max(mx1)), 0)), -1e30f);
        mh[2] = fmaxf(__builtin_bit_cast(float, __builtin_amdgcn_readlane(__builtin_bit_cast(int, row16_max(mx2)), 0)), -1e30f);
        mh[3] = fmaxf(__builtin_bit_cast(float, __builtin_amdgcn_readlane(__builtin_bit_cast(int, row16_max(mx3)), 0)), -1e30f);
        LAS unsigned char* vtile = lds + DS_S + w * 8192;
        LAS unsigned short* pbl = (LAS unsigned short*)(vtile + 32 * VROWB);
        { float l0 = 0.f, l1 = 0.f, l2 = 0.f, l3 = 0.f;
#pragma unroll
          for (int rr = 0; rr < 4; ++rr) { const int jl = rr * 64 + lane; f32x4 sv = {0.f, 0.f, 0.f, 0.f};
              if (jl < nsel) { sv = *(const LAS f32x4*)(pl + jl * 4);
                  sv.x = ex2(sv.x - mh[0]); sv.y = ex2(sv.y - mh[1]); sv.z = ex2(sv.z - mh[2]); sv.w = ex2(sv.w - mh[3]);
                  l0 += sv.x; l1 += sv.y; l2 += sv.z; l3 += sv.w; }
              const unsigned p01 = pk2(sv.x, sv.y), p23 = pk2(sv.z, sv.w);
              pbl[jl] = (unsigned short)p01; pbl[256 + jl] = (unsigned short)(p01 >> 16); pbl[512 + jl] = (unsigned short)p23; pbl[768 + jl] = (unsigned short)(p23 >> 16); }
          l0 = row16_sumf(l0); l1 = row16_sumf(l1); l2 = row16_sumf(l2); l3 = row16_sumf(l3);
#define RL4(v) (__builtin_bit_cast(float, __builtin_amdgcn_readlane(__builtin_bit_cast(int, v), 0)) + __builtin_bit_cast(float, __builtin_amdgcn_readlane(__builtin_bit_cast(int, v), 16)) + \
                __builtin_bit_cast(float, __builtin_amdgcn_readlane(__builtin_bit_cast(int, v), 32)) + __builtin_bit_cast(float, __builtin_amdgcn_readlane(__builtin_bit_cast(int, v), 48)))
          lh[0] = RL4(l0); lh[1] = RL4(l1); lh[2] = RL4(l2); lh[3] = RL4(l3);
#undef RL4
        }
        f32x4 oacc[4];
#pragma unroll
        for (int dt = 0; dt < 4; ++dt) oacc[dt] = (f32x4){0.f, 0.f, 0.f, 0.f};
        const int pn = l15 < 4 ? l15 : 3, qd = l15 >> 2, pd = lane & 3;
#define DSA_PVHALF(vv, i0_, jb_) do { \
        _Pragma("unroll") for (int i = 0; i < 4; ++i) *(LAS u32x4*)(vtile + (8 * i + kg) * VROWB + dc * 16) = vv[(i0_) + i]; \
        u32x2 plo_ = *(const LAS u32x2*)(pbl + pn * 256 + (jb_) + 4 * kq), phi_ = *(const LAS u32x2*)(pbl + pn * 256 + (jb_) + 16 + 4 * kq); \
        u32x4 pw_; pw_.x = l15 < 4 ? plo_.x : 0u; pw_.y = l15 < 4 ? plo_.y : 0u; pw_.z = l15 < 4 ? phi_.x : 0u; pw_.w = l15 < 4 ? phi_.y : 0u; \
        const bf16x8 pf_ = __builtin_bit_cast(bf16x8, pw_); \
        _Pragma("unroll") for (int dt = 0; dt < 4; ++dt) { \
            const s16x4 lo_ = vtr(vtile + (4 * kq + qd) * VROWB + (16 * dt + 4 * pd) * 2), hi_ = vtr(vtile + (16 + 4 * kq + qd) * VROWB + (16 * dt + 4 * pd) * 2); \
            const bf16x8 vf_ = __builtin_shufflevector(lo_, hi_, 0, 1, 2, 3, 4, 5, 6, 7); \
            oacc[dt] = MFMA16(vf_, pf_, oacc[dt]); } } while (0)
#define DSA_VACC(vv, j0_) do { DSA_PVHALF(vv, 0, (j0_)); DSA_PVHALF(vv, 4, (j0_) + 32); } while (0)
        DSA_VACC(va, 0);
        if (128 < nsel) DSA_VLOAD(va, 128);
        if (64 < nsel) DSA_VACC(vb, 64);
        if (192 < nsel) DSA_VLOAD(vb, 192);
        if (128 < nsel) DSA_VACC(va, 128);
        if (192 < nsel) DSA_VACC(vb, 192);
        if (l15 < 4) {
            const float lsum = l15 == 0 ? lh[0] : l15 == 1 ? lh[1] : l15 == 2 ? lh[2] : lh[3];
            const float f = lsum > 0.f ? 1.f / lsum : 0.f;
            int l15o = l15; asm volatile("" : "+v"(l15o));
            bf16* op = O + ((size_t)b * T + tq) * 256 + l15o * 64 + 4 * kq;
#pragma unroll
            for (int dt = 0; dt < 4; ++dt) { u32x2 o; o.x = pk2(oacc[dt][0] * f, oacc[dt][1] * f); o.y = pk2(oacc[dt][2] * f, oacc[dt][3] * f); *(u32x2*)(op + 16 * dt) = o; }
        }
    }
    __syncthreads();
}


#ifndef N_LAUNCH_SPLIT
#define N_LAUNCH_SPLIT 0
#endif
constexpr int PH_PER_LAYER = 10, PH_TOTAL = DEPTH * PH_PER_LAYER + 1;

__global__ void __launch_bounds__(NWAVES * 64, 2) fwd_kernel(Args args) {
    extern __shared__ __attribute__((aligned(16))) unsigned char lds_raw[];
    LAS unsigned char* lds = (LAS unsigned char*)lds_raw;
    volatile LAS unsigned* MISC = (volatile LAS unsigned*)(lds + MISC_OFF);
#define G ((int)gridDim.x)
#define bx ((int)blockIdx.x)
#define gw ((int)blockIdx.x * NWAVES + wave)
#define NGW ((int)gridDim.x * NWAVES)
    for (int u = threadIdx.x; u < (LDS_BYTES - LDSCTL_OFF) / 4; u += NWAVES * 64) ((LAS unsigned*)(lds + LDSCTL_OFF))[u] = 0u;
    __syncthreads();
    XcdBarrier bar; bar.bar = (unsigned*)(args.ws + WS_CTL) + CW_BAR; bar.x = 0; bar.st = nullptr;
    if (!N_LAUNCH_SPLIT) bar = xcd_barrier_post((unsigned*)(args.ws + WS_CTL) + CW_BAR, MISC + 8);

#define x_in (args.in[0])
#define out (args.out)
#define cosT ((float*)(args.ws + WS_COS))
#define sinT ((float*)(args.ws + WS_SIN))
#define kmean ((float*)(args.ws + WS_KMEAN))
#define kcmp ((bf16*)(args.ws + WS_KCMP))
#define vcmp ((bf16*)(args.ws + WS_VCMP))
#define bias1p ((float*)(args.ws + WS_BIAS1))
#define Wb ((bf16*)(args.ws + WS_W))
#define H ((bf16*)(args.ws + WS_H))
#define Z ((bf16*)(args.ws + WS_Z))
#define HID ((bf16*)(args.ws + WS_HID))
#define GB ((bf16*)(args.ws + WS_GB))
#define MF ((float*)(args.ws + WS_MF))
#define XB ((bf16*)(args.ws + WS_XB))
#define SS ((float*)(args.ws + WS_SS))
#define RLP ((G == 256) ? (const LAS float*)(lds + LDSCTL_OFF + 2048) : (const LAS float*)nullptr)
#define RINV_FILL() do { if (G == 256) { LAS float* RL_ = (LAS float*)(lds + LDSCTL_OFF + 2048); const int rb_ = (bx & 7) * 2048; \
        for (int rr_ = tid; rr_ < 2048; rr_ += NWAVES * 64) { const f32x4* p_ = (const f32x4*)(SS + (size_t)(rb_ + rr_) * 16); const f32x4 s4_ = (p_[0] + p_[1]) + (p_[2] + p_[3]); \
            RL_[rr_] = __builtin_amdgcn_rsqf(((s4_[0] + s4_[1]) + (s4_[2] + s4_[3])) * (1.f / D) + NORM_EPS); } \
        __syncthreads(); } } while (0)
#define CQN ((bf16*)(args.ws + WS_CQN))
#define OA ((bf16*)(args.ws + WS_O))
#define OB ((bf16*)(args.ws + WS_O) + (size_t)M * 256)
#define OC ((bf16*)(args.ws + WS_O) + (size_t)M * 512)
    const int lo = args.ph_lo, hi = args.ph_hi;
    int seq = 0;
#define PH_ON (seq >= lo && seq < hi)
#define PH_END do { if (PH_ON && seq + 1 < hi) xcd_barrier(bar); ++seq; } while (0)

    if (lo == 0) rope_table(cosT, sinT, bx * (NWAVES * 64) + (int)threadIdx.x, G * NWAVES * 64);
#pragma unroll 1
    for (int l = 0; l < DEPTH; ++l) {
#pragma unroll 1
        for (int f = 0; f < 2; ++f) {
            if (f == 0) {
                if (PH_ON) { int tid = threadIdx.x; asm volatile("" : "+v"(tid)); const int lane = tid & 63, wave = __builtin_amdgcn_readfirstlane(tid >> 6); (void)lane; (void)wave;
                    convert_weights(args, l, Wb, bias1p, lds, gw, NGW, wave, lane, tid);
                    if (l == 0) { int m = gw; for (; m + 3 * NGW < M; m += 4 * NGW) xb_init_rows4(x_in, XB, SS, (size_t)m, (size_t)NGW, lane); for (; m < M; m += NGW) xb_init_rows4(x_in, XB, SS, (size_t)m, 0, lane); }
                }
                PH_END;
            }
            if (PH_ON) { int tid = threadIdx.x; asm volatile("" : "+v"(tid)); const int lane = tid & 63, wave = __builtin_amdgcn_readfirstlane(tid >> 6); (void)lane; (void)wave;
                pg8::Gemm g{XB, Wb + (f ? W_UP2 : W_UP1), M, 2 * DFF, D}; pg8::StaticOrder S; S.init(M, 2 * DFF, G, bx);
                RINV_FILL();
                pg8::EpiSwiGLU E{HID, DFF, SS, RLP};
                pg8::gemm_phase<pg8::EpiSwiGLU, pg8::StaticOrder, true, true>(lds, g, S, E);
            }
            PH_END;
            if (PH_ON) { int tid = threadIdx.x; asm volatile("" : "+v"(tid)); const int lane = tid & 63, wave = __builtin_amdgcn_readfirstlane(tid >> 6); (void)lane; (void)wave;
                pg8::Gemm g{HID, Wb + (f ? W_DN2 : W_DN1), M, D, DFF}; pg8::StaticOrder S; S.init(M, D, G, bx);
                pg8::EpiResid E{XB, XB, 0.5f, SS};
                pg8::gemm_phase<pg8::EpiResid, pg8::StaticOrder, true, true>(lds, g, S, E);
            }
            PH_END;
            if (f == 0) {
                if (PH_ON) { int tid = threadIdx.x; asm volatile("" : "+v"(tid)); const int lane = tid & 63, wave = __builtin_amdgcn_readfirstlane(tid >> 6); (void)lane; (void)wave;
                    pg8::Gemm g{XB, Wb + W_IN, M, ZLD, D}; pg8::StaticOrder S; S.init(M, ZLD, G, bx);
                    RINV_FILL();
                    pg8::EpiZin E{Z, CQN, cosT, sinT, SS, RLP};
                    pg8::gemm_phase<pg8::EpiZin, pg8::StaticOrder, true, true>(lds, g, S, E);
                }
                PH_END;
                if (PH_ON) { int tid = threadIdx.x; asm volatile("" : "+v"(tid)); const int lane = tid & 63, wave = __builtin_amdgcn_readfirstlane(tid >> 6); (void)lane; (void)wave;
                    constexpr int N_CMP = 128, N_KM = 64, N_DSA = M / 8, N_IT = N_CMP + N_KM + N_DSA;
                    {
                        const bool perx = (G == 256);
                        unsigned* qctr = (unsigned*)(args.ws + WS_CTL) + 8192 + (l * 8 + (perx ? (bx & 7) : 0)) * 16;
                        const int qlim = perx ? N_IT / 8 : N_IT;
                        unsigned nxt = 0u; if (tid == 0) nxt = atomicAdd(qctr, 1u);
                        for (;;) {
                            __syncthreads();
                            if (tid == 0) { MISC[16] = nxt; nxt = atomicAdd(qctr, 1u); }
                            __syncthreads();
                            const int U = (int)MISC[16];
                            if (U >= qlim) break;
                            const int x = perx ? (bx & 7) : U / (N_IT / 8), uu = perx ? U : U % (N_IT / 8);
                            const int it = (uu < (N_CMP + N_KM) / 8) ? x + 8 * uu : N_CMP + N_KM + x + 8 * (N_DSA / 8 - 1 - (uu - (N_CMP + N_KM) / 8));
                            if (it < N_CMP) compress_item(it, Z, Wb, bias1p, kcmp, vcmp, lds, tid);
                            else if (it < N_CMP + N_KM) kmean_item(it - N_CMP, Z, kmean, lds, tid);
                            else dsa_item(it - N_CMP - N_KM, Z, OA, lds, tid);
                        }
                    }
                }
                PH_END;
                if (PH_ON) { int tid = threadIdx.x; asm volatile("" : "+v"(tid)); const int lane = tid & 63, wave = __builtin_amdgcn_readfirstlane(tid >> 6); (void)lane; (void)wave;
                    LAS unsigned char* wl = lds + wave * NSA_WLDS;
                    {
                        const bool perx = (G == 256);
                        unsigned* qctr = (unsigned*)(args.ws + WS_CTL) + 9216 + (l * 8 + (perx ? (bx & 7) : 0)) * 16;
                        const int qlim = perx ? 96 : 768;
                        for (;;) {
                            __syncthreads();
                            if (tid == 0) MISC[16] = atomicAdd(qctr, 1u);
                            __syncthreads();
                            const int U = (int)MISC[16];
                            if (U >= qlim) break;
                            const int x = perx ? (bx & 7) : U / 96, uu = perx ? U : U % 96;
                            if (uu < 64) { const int par = x >> 2, bg = x & 3;
                                const int tile = (uu < 32) ? 127 - par - 2 * uu : 62 + par - 2 * (uu - 32);
                                nsa_block_unit(bg >> 1, bg & 1, 64 * tile, Z, CQN, kcmp, vcmp, OC, lds, tid); }
                            else { const int own = 31 - (uu - 64);
                                moba_block_item(x >> 2, x & 3, own, own * 8 + x, Z, kmean, OB, (float*)(args.ws + WS_PART), lds, tid); }
                        }
                    }
                }
                PH_END;
                for (int c = 0; c < 6; ++c) {
                    if (PH_ON) { int tid = threadIdx.x; asm volatile("" : "+v"(tid)); (void)tid;
                        if (c == 0) RINV_FILL();
                        const int i = c >> 1;
                        pg8::Gemm g; g.M = M; g.N = D;
                        if ((c & 1) == 0) { g.A = XB; g.Bt = Wb + W_G + (size_t)i * D * D; g.K = D; }
                        else if (i == 0) { g.A = OA; g.Bt = Wb + W_A; g.K = 256; }
                        else if (i == 1) { g.A = OB; g.Bt = Wb + W_B; g.K = 256; }
                        else { g.A = OC; g.Bt = Wb + W_C; g.K = 512; }
                        pg8::StaticOrder S; S.init(M, D, G, bx);
                        if ((c & 1) == 0) { pg8::EpiMerge<0> E{GB, MF, SS, RLP}; pg8::gemm_phase<pg8::EpiMerge<0>, pg8::StaticOrder, true, true>(lds, g, S, E); }
                        else if (i == 0) { pg8::EpiMerge<1> E{GB, MF, SS, RLP}; pg8::gemm_phase<pg8::EpiMerge<1>, pg8::StaticOrder, true, true>(lds, g, S, E); }
                        else if (i == 1) { pg8::EpiMerge<2> E{GB, MF, SS, RLP}; pg8::gemm_phase<pg8::EpiMerge<2>, pg8::StaticOrder, true, true>(lds, g, S, E); }
                        else { pg8::EpiMerge<3> E{GB, MF, SS, RLP}; pg8::gemm_phase<pg8::EpiMerge<3>, pg8::StaticOrder, true, true>(lds, g, S, E); }
                        VM_WAIT(); __syncthreads();
                    }
                }
                PH_END;
                if (PH_ON) { int tid = threadIdx.x; asm volatile("" : "+v"(tid)); const int lane = tid & 63, wave = __builtin_amdgcn_readfirstlane(tid >> 6); (void)lane; (void)wave;
                    pg8::Gemm g{GB, Wb + W_O, M, D, D}; pg8::StaticOrder S; S.init(M, D, G, bx);
                    pg8::EpiResid E{XB, XB, 1.0f, SS};
                    pg8::gemm_phase<pg8::EpiResid, pg8::StaticOrder, true, true>(lds, g, S, E);
                }
                PH_END;
            }
        }
    }
    if (PH_ON) { int tid = threadIdx.x; asm volatile("" : "+v"(tid)); const int lane = tid & 63, wave = __builtin_amdgcn_readfirstlane(tid >> 6); (void)lane; (void)wave; for (int m = gw; m < M; m += NGW) rms_row_b2f(XB + (size_t)m * D, args.in[21], out + (size_t)m * D, lane); }
#undef PH_ON
#undef PH_END
#undef x_in
#undef out
#undef cosT
#undef sinT
#undef kmean
#undef kcmp
#undef vcmp
#undef bias1p
#undef Wb
#undef H
#undef Z
#undef HID
#undef GB
#undef MF
#undef CQN
#undef OA
#undef OB
#undef OC
#undef gw
#undef NGW
#undef G
#undef bx
}

extern "C" void kernel_launch(void* const* d_in, const int* in_sizes, int n_in, void* d_out, int out_size, void* d_ws, size_t ws_size, hipStream_t stream) {
    static int grid = 0;
    if (grid == 0) {
        if (n_in != 22 || out_size != M * D || ws_size < WS_END) { fprintf(stderr, "kernel_launch: unexpected shapes (n_in %d, out %d, ws %zu, need %zu)\n", n_in, out_size, ws_size, (size_t)WS_END); grid = -1; return; }
        int dev = 0, cus = 0, per_cu = 0;
        if (hipGetDevice(&dev) != hipSuccess || hipDeviceGetAttribute(&cus, hipDeviceAttributeMultiprocessorCount, dev) != hipSuccess) { grid = -1; return; }
        if (hipFuncSetAttribute((const void*)fwd_kernel, hipFuncAttributeMaxDynamicSharedMemorySize, LDS_BYTES) != hipSuccess) { fprintf(stderr, "kernel_launch: hipFuncSetAttribute failed\n"); grid = -1; return; }
        if (hipOccupancyMaxActiveBlocksPerMultiprocessor(&per_cu, (const void*)fwd_kernel, NWAVES * 64, LDS_BYTES) != hipSuccess || per_cu < 1)
            fprintf(stderr, "kernel_launch: occupancy query reports %d workgroups per CU\n", per_cu);
        (void)hipGetLastError();
        grid = cus;
    }
    if (grid < 0) return;
    if (hipMemsetAsync((char*)d_ws + WS_CTL, 0, CTL_ZERO_BYTES, stream) != hipSuccess) return;
    Args a{};
    for (int i = 0; i < 22; ++i) a.in[i] = (const float*)d_in[i];
    a.out = (float*)d_out; a.ws = (unsigned char*)d_ws;
#if N_LAUNCH_SPLIT
    for (int p = 0; p < PH_TOTAL; ++p) { a.ph_lo = p; a.ph_hi = p + 1; hipLaunchKernelGGL(fwd_kernel, dim3(grid), dim3(NWAVES * 64), LDS_BYTES, stream, a); }
#else
    a.ph_lo = 0; a.ph_hi = PH_TOTAL;
    hipLaunchKernelGGL(fwd_kernel, dim3(grid), dim3(NWAVES * 64), LDS_BYTES, stream, a);
#endif
}
```

```cpp
#include <hip/hip_runtime.h>
#include <cstdio>
#include <cstdint>

constexpr int BATCH = 2, T = 8192, D = 1024, DEPTH = 4, DFF = 2816, M = BATCH * T;
constexpr int IN_COLS = 5852;
constexpr float NORM_EPS = 1e-6f;
constexpr int ZLD = 2816;
constexpr int Z_AQ = 0, Z_AK = 256, Z_IQ = 320, Z_IK = 576, Z_BQ = 640, Z_BK = 896, Z_CQ = 1152, Z_KS = 1664, Z_KW = 1792, Z_ROPE_END = 1920;
constexpr int Z_AV = 1920, Z_BV = 1984, Z_KC = 2240, Z_VC = 2368, Z_VS = 2496, Z_VW = 2624, Z_IW = 2752, Z_CG = 2756, Z_END = 2780;
constexpr int O_A = 0, O_B = 256, O_C = 512;

namespace pg8 {
#define PG8_LAS __attribute__((address_space(3)))
typedef unsigned short bf16_t;
typedef short bf16x8 __attribute__((ext_vector_type(8)));
typedef float f32x4 __attribute__((ext_vector_type(4)));
typedef unsigned u32x4 __attribute__((ext_vector_type(4)));
constexpr int BM = 256, BK = 64, HALF = 128, HTB = HALF * BK * 2  , STAGE_BYTES = 8 * HTB, NXCD = 8, WGM = 8;

__host__ __device__ __forceinline__ int lds_byte(int r, int c) { const int st = (r >> 4) * 2 + (c >> 5), rr = r & 15, cc = c & 31, ob = rr * 64 + cc * 2; return st * 1024 + (ob ^ (((ob >> 9) & 1) << 5)); }
__host__ __device__ __forceinline__ void stage_rc(int b, int& R, int& C) { const int st = b / 1024, sb = b % 1024, swz = sb ^ (((sb >> 9) & 1) << 5); R = (st >> 1) * 16 + swz / 64; C = (st & 1) * 32 + (swz % 64) / 2; }
__host__ __device__ __forceinline__ int perm32(int rho) { const int n = rho >> 4, i = rho & 15; return 8 * (i >> 2) + 4 * n + (i & 3); }

struct Unit { int pm, pn; };
struct Gemm { const bf16_t* A; const bf16_t* Bt; int M, N, K; };

struct StaticOrder {
    int nM, nN, nwg, G, c;
    __host__ __device__ void init(int M, int N, int G_, int c_) { nM = M / BM; nN = N / BM; nwg = nM * nN; G = G_; c = c_; }
    __host__ __device__ bool next(int i, Unit& u) const {
        const long L = (long)i * G + c; if (L >= nwg) return false;
        int wgid = (int)L; { const int q = nwg / NXCD, r = nwg % NXCD, xcd = wgid % NXCD, off = wgid / NXCD; wgid = (xcd < r ? xcd * (q + 1) : r * (q + 1) + (xcd - r) * q) + off; }
        const int nig = WGM * nN, gid = wgid / nig, fm = gid * WGM, gsz = (nM - fm) < WGM ? (nM - fm) : WGM;
        u.pm = fm + ((wgid % nig) % gsz); u.pn = (wgid % nig) / gsz; return true;
    }
    __device__ __forceinline__ void a_ready(const Unit&) const {}
    __device__ __forceinline__ void done(const Unit&) const {}
};

typedef float f32x2_ __attribute__((ext_vector_type(2)));
typedef __bf16 bf16x2_ __attribute__((ext_vector_type(2)));
__device__ __forceinline__ unsigned cvt_pk_bf16(float lo, float hi) { f32x2_ v = {lo, hi}; bf16x2_ b = __builtin_convertvector(v, bf16x2_); return __builtin_bit_cast(unsigned, b); }
__device__ __forceinline__ float bf_lo(unsigned u) { return __builtin_bit_cast(float, u << 16); }
__device__ __forceinline__ float bf_hi(unsigned u) { return __builtin_bit_cast(float, u & 0xffff0000u); }
__device__ __forceinline__ float fast_sigmoid(float v) { return __builtin_amdgcn_rcpf(1.f + __builtin_amdgcn_exp2f(-1.4426950408889634f * v)); }
typedef unsigned u32x2 __attribute__((ext_vector_type(2)));

__device__ __forceinline__ void row_rinv8(const float* ss, const PG8_LAS float* rl, int row0, int fq, int lane, float (&rinv)[8]) {
    if (rl) {
#pragma unroll
        for (int ri = 0; ri < 8; ++ri) rinv[ri] = rl[(row0 + (ri >> 2) * HALF + (ri & 3) * 16) & 2047];
        return; }
    float mine[2];
#pragma unroll
    for (int t = 0; t < 2; ++t) { const int row = row0 + (fq >> 1) * HALF + (2 * (fq & 1) + t) * 16; const f32x4* p = (const f32x4*)(ss + (size_t)row * 16);
        const f32x4 s4 = (p[0] + p[1]) + (p[2] + p[3]); mine[t] = __builtin_amdgcn_rsqf(((s4[0] + s4[1]) + (s4[2] + s4[3])) * (1.f / D) + NORM_EPS); }
#pragma unroll
    for (int ri = 0; ri < 8; ++ri) rinv[ri] = __shfl(mine[ri & 1], (lane & 15) + 16 * (ri >> 1));
}
struct EpiSwiGLU {
    static constexpr bool PERM = true, AFTER_DRAIN = false;
    bf16_t* H; int ldh; const float* ss; const PG8_LAS float* rl;
    __device__ __forceinline__ void operator()(const f32x4 (&acc)[2][2][4][2], const Unit& u, int wr, int wc, int fr, int fq) const {
        const int row0 = u.pm * BM + wr * 64 + fr, col0 = u.pn * BM + wc * 32 + 8 * fq;
        float rinv[8]; row_rinv8(ss, rl, row0, fq, fq * 16 + fr, rinv);
#pragma unroll
        for (int ai = 0; ai < 2; ++ai)
#pragma unroll
            for (int m = 0; m < 4; ++m) { const unsigned rowb = (unsigned)(row0 + ai * HALF + m * 16) * (unsigned)ldh * 2u; const float ri = rinv[ai * 4 + m];
#pragma unroll
                for (int bj = 0; bj < 2; ++bj) { const f32x4 v0 = acc[ai][bj][m][0] * ri, v1 = acc[ai][bj][m][1] * ri;
                    const float h0 = v0[0] * fast_sigmoid(v0[0]) * v0[1], h1 = v0[2] * fast_sigmoid(v0[2]) * v0[3];
                    const float h2 = v1[0] * fast_sigmoid(v1[0]) * v1[1], h3 = v1[2] * fast_sigmoid(v1[2]) * v1[3];
                    u32x2 o; o.x = cvt_pk_bf16(h0, h1); o.y = cvt_pk_bf16(h2, h3);
                    *(u32x2*)((char*)H + rowb + (unsigned)((col0 + bj * HALF) >> 1) * 2u) = o; } }
    }
};
struct EpiResid {
    static constexpr bool PERM = true, AFTER_DRAIN = false;
    const bf16_t* src; bf16_t* dst; float scale; float* ss;
    __device__ __forceinline__ void operator()(const f32x4 (&acc)[2][2][4][2], const Unit& u, int wr, int wc, int fr, int fq) const {
        const int row0 = u.pm * BM + wr * 64 + fr, col0 = u.pn * BM + wc * 32 + 8 * fq;
#pragma unroll
        for (int ai = 0; ai < 2; ++ai)
#pragma unroll
            for (int m = 0; m < 4; ++m) { const int row = row0 + ai * HALF + m * 16; const unsigned ro = ((unsigned)row * (unsigned)D + (unsigned)col0) * 2u; float sq = 0.f;
#pragma unroll
                for (int bj = 0; bj < 2; ++bj) { const unsigned o = ro + (unsigned)(bj * HALF) * 2u; f32x4 v0 = acc[ai][bj][m][0] * scale, v1 = acc[ai][bj][m][1] * scale;
                    const u32x4 so = *(const u32x4*)((const char*)src + o);
                    v0[0] += bf_lo(so.x); v0[1] += bf_hi(so.x); v0[2] += bf_lo(so.y); v0[3] += bf_hi(so.y); v1[0] += bf_lo(so.z); v1[1] += bf_hi(so.z); v1[2] += bf_lo(so.w); v1[3] += bf_hi(so.w);
                    sq += ((v0[0] * v0[0] + v0[1] * v0[1]) + (v0[2] * v0[2] + v0[3] * v0[3])) + ((v1[0] * v1[0] + v1[1] * v1[1]) + (v1[2] * v1[2] + v1[3] * v1[3]));
                    u32x4 r; r.x = cvt_pk_bf16(v0[0], v0[1]); r.y = cvt_pk_bf16(v0[2], v0[3]); r.z = cvt_pk_bf16(v1[0], v1[1]); r.w = cvt_pk_bf16(v1[2], v1[3]);
                    *(u32x4*)((char*)dst + o) = r; }
                sq += __shfl_xor(sq, 16); sq += __shfl_xor(sq, 32);
                if (fq == 0) ss[(size_t)row * 16 + u.pn * 4 + wc] = sq; }
    }
};
struct EpiZin {
    static constexpr bool PERM = true, AFTER_DRAIN = false;
    bf16_t* Z; bf16_t* CQN; const float* cosT; const float* sinT; const float* ss; const PG8_LAS float* rl;
    __device__ __forceinline__ void operator()(const f32x4 (&acc)[2][2][4][2], const Unit& u, int wr, int wc, int fr, int fq) const {
        const int row0 = u.pm * BM + wr * 64 + fr, col0 = u.pn * BM + wc * 32 + 8 * fq;
        float rinv[8]; row_rinv8(ss, rl, row0, fq, fq * 16 + fr, rinv);
#pragma unroll
        for (int ai = 0; ai < 2; ++ai)
#pragma unroll
            for (int m = 0; m < 4; ++m) { const int row = row0 + ai * HALF + m * 16; const int pos = row & (T - 1); const float ri = rinv[ai * 4 + m];
#pragma unroll
                for (int bj = 0; bj < 2; ++bj) { const int col = col0 + bj * HALF; f32x4 v0 = acc[ai][bj][m][0] * ri, v1 = acc[ai][bj][m][1] * ri;
                    if (col < Z_ROPE_END) {
                        if (col >= Z_CQ && col < Z_KS) { u32x4 r; r.x = cvt_pk_bf16(v0[0], v0[1]); r.y = cvt_pk_bf16(v0[2], v0[3]); r.z = cvt_pk_bf16(v1[0], v1[1]); r.w = cvt_pk_bf16(v1[2], v1[3]);
                            *(u32x4*)((char*)CQN + ((unsigned)row * 512u + (unsigned)(col - Z_CQ)) * 2u) = r; }
                        const int i0 = (col & 63) >> 1;
                        const f32x4 c = *(const f32x4*)(cosT + pos * 32 + i0), s = *(const f32x4*)(sinT + pos * 32 + i0);
                        f32x4 w0, w1;
                        w0[0] = v0[0] * c[0] - v0[1] * s[0]; w0[1] = v0[0] * s[0] + v0[1] * c[0];
                        w0[2] = v0[2] * c[1] - v0[3] * s[1]; w0[3] = v0[2] * s[1] + v0[3] * c[1];
                        w1[0] = v1[0] * c[2] - v1[1] * s[2]; w1[1] = v1[0] * s[2] + v1[1] * c[2];
                        w1[2] = v1[2] * c[3] - v1[3] * s[3]; w1[3] = v1[2] * s[3] + v1[3] * c[3];
                        v0 = w0; v1 = w1;
                    } else if (col >= Z_IW) {
#pragma unroll
                        for (int e = 0; e < 4; ++e) { if (col + e >= Z_CG) v0[e] = fast_sigmoid(v0[e]); if (col + 4 + e >= Z_CG) v1[e] = fast_sigmoid(v1[e]); }
                    }
                    u32x4 r; r.x = cvt_pk_bf16(v0[0], v0[1]); r.y = cvt_pk_bf16(v0[2], v0[3]); r.z = cvt_pk_bf16(v1[0], v1[1]); r.w = cvt_pk_bf16(v1[2], v1[3]);
                    *(u32x4*)((char*)Z + ((unsigned)row * (unsigned)ZLD + (unsigned)col) * 2u) = r; } asm volatile("" ::: "memory"); }
    }
};
template <int MODE> struct EpiMerge {
    static constexpr bool PERM = true, AFTER_DRAIN = false;
    bf16_t* Gb; float* Mf; const float* ss; const PG8_LAS float* rl;
    __device__ __forceinline__ void operator()(const f32x4 (&acc)[2][2][4][2], const Unit& u, int wr, int wc, int fr, int fq) const {
        const int row0 = u.pm * BM + wr * 64 + fr, col0 = u.pn * BM + wc * 32 + 8 * fq;
        float rinv[8];
        if constexpr (MODE == 0) row_rinv8(ss, rl, row0, fq, fq * 16 + fr, rinv);
#pragma unroll
        for (int ai = 0; ai < 2; ++ai)
#pragma unroll
            for (int m = 0; m < 4; ++m) { const unsigned ro = ((unsigned)(row0 + ai * HALF + m * 16) * (unsigned)D + (unsigned)col0) * 2u;
#pragma unroll
                for (int bj = 0; bj < 2; ++bj) { const unsigned o = ro + (unsigned)(bj * HALF) * 2u; f32x4 v0 = acc[ai][bj][m][0], v1 = acc[ai][bj][m][1];
                    if constexpr (MODE == 0) {
#pragma unroll
                        for (int e = 0; e < 4; ++e) { v0[e] = fast_sigmoid(v0[e] * rinv[ai * 4 + m]); v1[e] = fast_sigmoid(v1[e] * rinv[ai * 4 + m]); }
                        u32x4 r; r.x = cvt_pk_bf16(v0[0], v0[1]); r.y = cvt_pk_bf16(v0[2], v0[3]); r.z = cvt_pk_bf16(v1[0], v1[1]); r.w = cvt_pk_bf16(v1[2], v1[3]);
                        *(u32x4*)((char*)Gb + o) = r;
                    } else {
                        const u32x4 g = *(const u32x4*)((const char*)Gb + o);
                        v0[0] *= bf_lo(g.x); v0[1] *= bf_hi(g.x); v0[2] *= bf_lo(g.y); v0[3] *= bf_hi(g.y);
                        v1[0] *= bf_lo(g.z); v1[1] *= bf_hi(g.z); v1[2] *= bf_lo(g.w); v1[3] *= bf_hi(g.w);
                        bf16_t* Mb = (bf16_t*)Mf;
                        if constexpr (MODE >= 2) { const u32x4 mo = *(const u32x4*)((const char*)Mb + o);
                            v0[0] += bf_lo(mo.x); v0[1] += bf_hi(mo.x); v0[2] += bf_lo(mo.y); v0[3] += bf_hi(mo.y); v1[0] += bf_lo(mo.z); v1[1] += bf_hi(mo.z); v1[2] += bf_lo(mo.w); v1[3] += bf_hi(mo.w); }
                        u32x4 r; r.x = cvt_pk_bf16(v0[0], v0[1]); r.y = cvt_pk_bf16(v0[2], v0[3]); r.z = cvt_pk_bf16(v1[0], v1[1]); r.w = cvt_pk_bf16(v1[2], v1[3]);
                        if constexpr (MODE == 3) *(u32x4*)((char*)Gb + o) = r; else *(u32x4*)((char*)Mb + o) = r;
                    } } }
    }
};

template <class Epi, class Sched, bool ALIGN_EPI = false, bool SP2 = false>
__device__ __forceinline__ void gemm_phase(PG8_LAS unsigned char* lds, const Gemm g, const Sched& S, const Epi& E) {
    int tid_o = threadIdx.x; asm volatile("" : "+v"(tid_o)); const int tid = tid_o, wid = __builtin_amdgcn_readfirstlane(tid >> 6), lane = tid & 63, wr = wid >> 2, wc = wid & 3, fr = lane & 15, fq = lane >> 4;
    const int K = g.K, nt = K / BK;
    unsigned voffA[2], voffB[2];
#pragma unroll
    for (int i = 0; i < 2; ++i) { int R, C; stage_rc(tid * 16 + i * 8192, R, C); const int Rb = Epi::PERM ? ((R & ~31) + perm32(R & 31)) : R;
        voffA[i] = (unsigned)(R * K + C) * 2u; voffB[i] = (unsigned)(Rb * K + C) * 2u; }
    const size_t kstep = (size_t)(BK * 2);
    const size_t hstep = (size_t)HALF * K * 2;
    const size_t tstep = 2 * hstep;
    const unsigned ldsw = (unsigned)wid * 1024u;
    const int aoff = lds_byte(wr * 64 + fr, fq * 8), boff = lds_byte(wc * 32 + fr, fq * 8);
#define PG8_SA(b, h) (((b) * 2 + (h)) * HTB)
#define PG8_SB(b, h) ((4 + (b) * 2 + (h)) * HTB)
#define PG8_STAGE(bufoff, gbase, voff) do { _Pragma("unroll") for (int _i = 0; _i < 2; ++_i) \
        __builtin_amdgcn_global_load_lds((const unsigned*)((const char*)(gbase) + (voff)[_i]), (PG8_LAS unsigned*)(lds + (bufoff) + ldsw + _i * 8192), 16, 0, 0); } while (0)
#define PG8_LDA(dst, b, h) do { _Pragma("unroll") for (int m = 0; m < 4; ++m) _Pragma("unroll") for (int k = 0; k < 2; ++k) dst[m][k] = *(const PG8_LAS bf16x8*)(lds + PG8_SA(b, h) + aoff + m * 2048 + k * 1024); } while (0)
#define PG8_LDB(dst, b, h) do { _Pragma("unroll") for (int n = 0; n < 2; ++n) _Pragma("unroll") for (int k = 0; k < 2; ++k) dst[n][k] = *(const PG8_LAS bf16x8*)(lds + PG8_SB(b, h) + boff + n * 2048 + k * 1024); } while (0)
#define PG8_MMA(ai, bj, At, Bt) do { __builtin_amdgcn_s_setprio(1); _Pragma("unroll") for (int m = 0; m < 4; ++m) _Pragma("unroll") for (int n = 0; n < 2; ++n) _Pragma("unroll") for (int k = 0; k < 2; ++k) \
        acc[ai][bj][m][n] = __builtin_amdgcn_mfma_f32_16x16x32_bf16(Bt[n][k], At[m][k], acc[ai][bj][m][n], 0, 0, 0); __builtin_amdgcn_s_setprio(0); } while (0)
#define PG8_WAIT_V(n) asm volatile("s_waitcnt vmcnt(" #n ")" ::: "memory")
#define PG8_WAIT_L(n) asm volatile("s_waitcnt lgkmcnt(" #n ")" ::: "memory")
#define PG8_BAR __builtin_amdgcn_s_barrier()
#define PG8_SCHED __builtin_amdgcn_sched_barrier(0)
    Unit cur, nxt; int ui = 0;
    if (!S.next(0, cur)) return;
    f32x4 acc[2][2][4][2];
#pragma unroll
    for (int a = 0; a < 2; ++a)
#pragma unroll
        for (int b = 0; b < 2; ++b)
#pragma unroll
            for (int m = 0; m < 4; ++m)
#pragma unroll
                for (int n = 0; n < 2; ++n) acc[a][b][m][n] = (f32x4){0.f, 0.f, 0.f, 0.f};
    bf16x8 At[4][2], B0[2][2], B1[2][2];
    const char* cA = (const char*)g.A + (size_t)cur.pm * tstep; const char* cB = (const char*)g.Bt + (size_t)cur.pn * tstep;
    S.a_ready(cur);
    if constexpr (SP2) {
        PG8_STAGE(PG8_SB(0, 0), cB, voffB); PG8_STAGE(PG8_SB(0, 1), cB + hstep, voffB); PG8_STAGE(PG8_SA(0, 0), cA, voffA); PG8_STAGE(PG8_SA(0, 1), cA + hstep, voffA);
        if (wr == 1) PG8_BAR;
        PG8_WAIT_V(2); PG8_BAR;
        PG8_STAGE(PG8_SB(1, 0), cB + kstep, voffB); PG8_STAGE(PG8_SA(1, 0), cA + kstep, voffA); PG8_STAGE(PG8_SB(1, 1), cB + hstep + kstep, voffB);
        PG8_WAIT_V(6); PG8_BAR;
    } else {
        PG8_STAGE(PG8_SB(0, 0), cB, voffB); PG8_STAGE(PG8_SA(0, 0), cA, voffA); PG8_STAGE(PG8_SB(0, 1), cB + hstep, voffB); PG8_STAGE(PG8_SA(0, 1), cA + hstep, voffA);
        if (wr == 1) PG8_BAR;
        PG8_WAIT_V(4); PG8_BAR;
        PG8_STAGE(PG8_SB(1, 0), cB + kstep, voffB); PG8_STAGE(PG8_SA(1, 0), cA + kstep, voffA); PG8_STAGE(PG8_SB(1, 1), cB + hstep + kstep, voffB);
        PG8_WAIT_V(6); PG8_BAR;
    }
    for (;;) {
        const bool has_next = S.next(ui + 1, nxt);
        const char* nA = has_next ? (const char*)g.A + (size_t)nxt.pm * tstep : cA; const char* nB = has_next ? (const char*)g.Bt + (size_t)nxt.pn * tstep : cB;
        for (int t = 0; t < nt; t += 2) {
            const bool last = (t == nt - 2);
            const char* a1 = cA + (size_t)(t + 1) * kstep;
            const char* a2 = last ? nA : cA + (size_t)(t + 2) * kstep; const char* b2 = last ? nB : cB + (size_t)(t + 2) * kstep;
            const char* a3 = a2 + kstep; const char* b3 = b2 + kstep;
            if (last && has_next) S.a_ready(nxt);
            if constexpr (SP2) {
            PG8_LDB(B0, 0, 0); PG8_LDB(B1, 0, 1); PG8_SCHED; PG8_LDA(At, 0, 0); PG8_STAGE(PG8_SA(1, 1), a1 + hstep, voffA);
            PG8_WAIT_V(8); PG8_WAIT_L(0); PG8_BAR; PG8_MMA(0, 0, At, B0); PG8_MMA(0, 1, At, B1); PG8_BAR; PG8_SCHED;
            PG8_LDA(At, 0, 1); PG8_STAGE(PG8_SB(0, 0), b2, voffB); PG8_STAGE(PG8_SB(0, 1), b2 + hstep, voffB); PG8_STAGE(PG8_SA(0, 0), a2, voffA);
            PG8_WAIT_V(8); PG8_WAIT_L(0); PG8_BAR; PG8_MMA(1, 0, At, B0); PG8_MMA(1, 1, At, B1); PG8_BAR; PG8_SCHED;
            PG8_LDB(B0, 1, 0); PG8_LDB(B1, 1, 1); PG8_SCHED; PG8_LDA(At, 1, 0); PG8_STAGE(PG8_SA(0, 1), a2 + hstep, voffA);
            PG8_WAIT_V(8); PG8_WAIT_L(0); PG8_BAR; PG8_MMA(0, 0, At, B0); PG8_MMA(0, 1, At, B1); PG8_BAR; PG8_SCHED;
            PG8_LDA(At, 1, 1); PG8_STAGE(PG8_SB(1, 0), b3, voffB); PG8_STAGE(PG8_SB(1, 1), b3 + hstep, voffB); PG8_STAGE(PG8_SA(1, 0), a3, voffA);
            PG8_WAIT_V(8); PG8_WAIT_L(0); PG8_BAR; PG8_MMA(1, 0, At, B0); PG8_MMA(1, 1, At, B1); PG8_BAR; PG8_SCHED;
            } else {
            PG8_LDB(B0, 0, 0); PG8_SCHED; PG8_LDA(At, 0, 0); PG8_STAGE(PG8_SA(1, 1), a1 + hstep, voffA);
            PG8_WAIT_L(8); PG8_BAR; PG8_WAIT_L(0); PG8_MMA(0, 0, At, B0); PG8_BAR; PG8_SCHED;
            PG8_LDB(B1, 0, 1); PG8_STAGE(PG8_SB(0, 0), b2, voffB);
            PG8_BAR; PG8_WAIT_L(0); PG8_MMA(0, 1, At, B1); PG8_BAR;
            PG8_LDA(At, 0, 1); PG8_STAGE(PG8_SA(0, 0), a2, voffA);
            PG8_BAR; PG8_WAIT_L(0); PG8_MMA(1, 0, At, B0); PG8_BAR; PG8_SCHED;
            PG8_STAGE(PG8_SB(0, 1), b2 + hstep, voffB);
            PG8_WAIT_V(6); PG8_BAR; PG8_MMA(1, 1, At, B1); PG8_BAR;
            PG8_LDB(B0, 1, 0); PG8_SCHED; PG8_LDA(At, 1, 0); PG8_STAGE(PG8_SA(0, 1), a2 + hstep, voffA);
            PG8_WAIT_L(8); PG8_BAR; PG8_WAIT_L(0); PG8_MMA(0, 0, At, B0); PG8_BAR; PG8_SCHED;
            PG8_LDB(B1, 1, 1); PG8_STAGE(PG8_SB(1, 0), b3, voffB);
            PG8_BAR; PG8_WAIT_L(0); PG8_MMA(0, 1, At, B1); PG8_BAR;
            PG8_LDA(At, 1, 1); PG8_STAGE(PG8_SA(1, 0), a3, voffA);
            PG8_BAR; PG8_WAIT_L(0); PG8_MMA(1, 0, At, B0); PG8_BAR; PG8_SCHED;
            PG8_STAGE(PG8_SB(1, 1), b3 + hstep, voffB);
            PG8_WAIT_V(6); PG8_BAR; PG8_MMA(1, 1, At, B1); PG8_BAR;
            }
        }
        if constexpr (ALIGN_EPI) { if (wr == 0) PG8_BAR; }
        if constexpr (!Epi::AFTER_DRAIN) { E(acc, cur, wr, wc, fr, fq); S.done(cur); }
        if (!has_next) break;
#pragma unroll
        for (int a = 0; a < 2; ++a)
#pragma unroll
            for (int b = 0; b < 2; ++b)
#pragma unroll
                for (int m = 0; m < 4; ++m)
#pragma unroll
                    for (int n = 0; n < 2; ++n) acc[a][b][m][n] = (f32x4){0.f, 0.f, 0.f, 0.f};
        cur = nxt; cA = nA; cB = nB; ++ui;
        if constexpr (ALIGN_EPI) { if (wr == 1) PG8_BAR; }
    }
    PG8_WAIT_V(0);
    if constexpr (!ALIGN_EPI) { if (wr == 0) PG8_BAR; }
    PG8_BAR;
    if constexpr (Epi::AFTER_DRAIN) { E.fused(acc, cur, wr, wc, fr, fq, lds, wid, lane); S.done(cur); }
#undef PG8_SA
#undef PG8_SB
#undef PG8_STAGE
#undef PG8_LDA
#undef PG8_LDB
#undef PG8_MMA
#undef PG8_WAIT_V
#undef PG8_WAIT_L
#undef PG8_BAR
#undef PG8_SCHED
}
}

#define LAS __attribute__((address_space(3)))
#define DI __device__ __forceinline__
typedef unsigned short bf16;
typedef short bf16x8 __attribute__((ext_vector_type(8)));
typedef short s16x4 __attribute__((ext_vector_type(4)));
typedef float f32x2 __attribute__((ext_vector_type(2)));
typedef float f32x4 __attribute__((ext_vector_type(4)));
typedef float f32x16 __attribute__((ext_vector_type(16)));
typedef unsigned u32x2 __attribute__((ext_vector_type(2)));
typedef unsigned u32x4 __attribute__((ext_vector_type(4)));
typedef __bf16 bf16x2_t __attribute__((ext_vector_type(2)));
typedef __attribute__((address_space(1))) unsigned gu32;
#define RLX_AGENT __ATOMIC_RELAXED, __HIP_MEMORY_SCOPE_AGENT
#define LDS_WAIT() asm volatile("s_waitcnt lgkmcnt(0)" ::: "memory")
#define VM_WAIT() asm volatile("s_waitcnt vmcnt(0)" ::: "memory")
#define MFMA32(a, b, c) __builtin_amdgcn_mfma_f32_32x32x16_bf16((a), (b), (c), 0, 0, 0)
#define MFMA16(a, b, c) __builtin_amdgcn_mfma_f32_16x16x32_bf16((a), (b), (c), 0, 0, 0)
constexpr float LOG2E = 1.4426950408889634f;
constexpr float NEG_INF = -__builtin_inff();
DI unsigned f2bf(float f) { unsigned u = __builtin_bit_cast(unsigned, f); return (u + 0x7fffu + ((u >> 16) & 1u)) >> 16; }
DI unsigned pk2(float lo, float hi) { f32x2 v = {lo, hi}; bf16x2_t b = __builtin_convertvector(v, bf16x2_t); return __builtin_bit_cast(unsigned, b); }
DI float bflo(unsigned u) { return __builtin_bit_cast(float, u << 16); }
DI float bfhi(unsigned u) { return __builtin_bit_cast(float, u & 0xffff0000u); }
DI float bf2f(bf16 v) { return __builtin_bit_cast(float, (unsigned)v << 16); }
DI float ex2(float x) { return __builtin_amdgcn_exp2f(x); }
DI int crow(int reg, int h) { return (reg & 3) + 8 * (reg >> 2) + 4 * h; }
DI float wave_sum(float v) {
#pragma unroll
    for (int o = 1; o < 64; o <<= 1) v += __shfl_xor(v, o);
    return v;
}
DI float wave_max(float v) {
#pragma unroll
    for (int o = 1; o < 64; o <<= 1) v = fmaxf(v, __shfl_xor(v, o));
    return v;
}

constexpr size_t MiB = 1u << 20;
constexpr size_t WS_CTL = 0, CTL_ZERO_BYTES = 64 * 1024;
constexpr size_t WS_COS = 1 * MiB, WS_SIN = 2 * MiB;
constexpr size_t WS_KMEAN = 3 * MiB, WS_KCMP = 3 * MiB + 128 * 1024, WS_VCMP = 3 * MiB + 384 * 1024, WS_BIAS1 = 3 * MiB + 640 * 1024;
constexpr size_t WS_W = 4 * MiB, WS_H = 60 * MiB, WS_O = 92 * MiB, WS_Z = 124 * MiB, WS_HID = WS_Z, WS_GB = WS_Z, WS_MF = 156 * MiB, WS_CQN = 220 * MiB, WS_PART = 240 * MiB, WS_XB = 320 * MiB, WS_SS = 352 * MiB, WS_END = 353 * MiB;
constexpr size_t W_UP1 = 0, W_DN1 = W_UP1 + (size_t)2 * DFF * D, W_UP2 = W_DN1 + (size_t)D * DFF, W_DN2 = W_UP2 + (size_t)2 * DFF * D, W_IN = W_DN2 + (size_t)D * DFF,
                 W_G = W_IN + (size_t)ZLD * D, W_A = W_G + (size_t)3 * D * D, W_B = W_A + (size_t)D * 256, W_C = W_B + (size_t)D * 256, W_O = W_C + (size_t)D * 512,
                 W_1K = W_O + (size_t)D * D, W_1V = W_1K + (size_t)128 * 2048, W_2K = W_1V + (size_t)128 * 2048, W_2V = W_2K + (size_t)64 * 128, W_END = W_2V + (size_t)64 * 128;
static_assert(W_END * 2 <= 56 * MiB, "weights region");
constexpr int CW_BAR = 1024;

constexpr int RING_BYTES = 131072;
constexpr int LDSCTL_OFF = RING_BYTES, MISC_OFF = LDSCTL_OFF + 320;
constexpr int LDS_BYTES = 147456;
constexpr int NWAVES = 8;

#define XB_TMO      128
#define XB_XCNT(j)  (256  + 64 * (j))
#define XB_XSUB(j)  (1280 + 64 * (j))
#define XB_XGEN(j)  (2304 + 64 * (j))
#define XB_TOP      3328
#define XB_TOPGEN   3392
#define XCD_BAR_WORDS 3456
#define XB_SPIN_CAP (1u << 18)

__device__ __forceinline__ unsigned xb_ld(unsigned* p)              { return __hip_atomic_load(p, __ATOMIC_RELAXED, __HIP_MEMORY_SCOPE_AGENT); }
__device__ __forceinline__ unsigned xb_add(unsigned* p, unsigned v) { return __hip_atomic_fetch_add(p, v, __ATOMIC_RELAXED, __HIP_MEMORY_SCOPE_AGENT); }
__device__ __forceinline__ unsigned xb_xcc_id() { return (unsigned)__builtin_amdgcn_s_getreg((3 << 11) | 20) & 0xFu; }
#define XB_SPIN(cond, bar) do { unsigned _sp = 0; while (cond) { __builtin_amdgcn_s_sleep(1); \
    if ((++_sp & 255u) == 0u) { if (xb_ld(&(bar)[XB_TMO])) break; if (_sp > XB_SPIN_CAP) { atomicAdd(&(bar)[XB_TMO], 1u); break; } } } } while (0)

struct XcdBarrier {
    unsigned* bar; unsigned x;
    volatile LAS unsigned* st;
};

__device__ __forceinline__ XcdBarrier xcd_barrier_post(unsigned* bar, volatile LAS unsigned* st) {
    XcdBarrier b; b.bar = bar; b.x = xb_xcc_id(); b.st = st;
    if (threadIdx.x == 0) (void)xb_add(&bar[XB_XCNT(b.x)], 1u);
    return b;
}
__device__ __forceinline__ void xcd_barrier_complete(unsigned* bar, unsigned x, unsigned& nloc, unsigned& nx) {
    const unsigned G = gridDim.x * gridDim.y * gridDim.z;
    unsigned sum, cnt, mine, sp = 0u;
    for (;;) {
        sum = 0u; cnt = 0u; mine = 0u;
#pragma unroll
        for (unsigned j = 0; j < 16; ++j) { const unsigned c = xb_ld(&bar[XB_XCNT(j)]); sum += c; cnt += (c > 0u) ? 1u : 0u; mine = (j == x) ? c : mine; }
        if (sum == G) break;
        __builtin_amdgcn_s_sleep(1);
        if ((++sp & 255u) == 0u) { if (xb_ld(&bar[XB_TMO])) break; if (sp > XB_SPIN_CAP) { atomicAdd(&bar[XB_TMO], 1u); break; } }
    }
    nloc = mine > 0u ? mine : 1u; nx = cnt > 0u ? cnt : 1u;
}

__device__ __forceinline__ void xcd_barrier(const XcdBarrier& b) {
    asm volatile("s_waitcnt vmcnt(0)" ::: "memory");
    __syncthreads();
    if (threadIdx.x == 0) {
        unsigned* bar = b.bar;
        __builtin_amdgcn_s_waitcnt(0);
        unsigned nloc = b.st[0], nx = b.st[1];
        if (nloc == 0u) { xcd_barrier_complete(bar, b.x, nloc, nx); b.st[0] = nloc; b.st[1] = nx; }
        const unsigned old = xb_add(&bar[XB_XSUB(b.x)], 1u);
        const unsigned gen = old / nloc;
        if (old + 1u == (gen + 1u) * nloc) {
            __builtin_amdgcn_fence(__ATOMIC_RELEASE, "agent");
            asm volatile("s_waitcnt vmcnt(0)" ::: "memory");
            const unsigned og = xb_add(&bar[XB_TOP], 1u);
            const unsigned tg = og / nx;
            if (og + 1u == (tg + 1u) * nx) xb_add(&bar[XB_TOPGEN], 1u);
            else XB_SPIN(xb_ld(&bar[XB_TOPGEN]) == tg, bar);
            __builtin_amdgcn_fence(__ATOMIC_ACQUIRE, "agent");
            xb_add(&bar[XB_XGEN(b.x)], 1u);
            asm volatile("s_waitcnt vmcnt(0)" ::: "memory");
        } else {
            XB_SPIN(xb_ld(&bar[XB_XGEN(b.x)]) == gen, bar);
            __builtin_amdgcn_fence(__ATOMIC_ACQUIRE, "agent");
            asm volatile("s_waitcnt vmcnt(0)" ::: "memory");
        }
    }
    __syncthreads();
}


DI int zcol_to_orig(int n) {
    if (n < Z_ROPE_END) { const int hh = n >> 6, w = n & 63, e = (w >> 1) + 32 * (w & 1); int base;
        if (hh < 4) base = hh * 64; else if (hh == 4) base = 256; else if (hh < 9) base = 384 + (hh - 5) * 64; else if (hh == 9) base = 640;
        else if (hh < 14) base = 708 + (hh - 10) * 64; else if (hh < 18) base = 964 + (hh - 14) * 64; else if (hh < 26) base = 1476 + (hh - 18) * 64;
        else if (hh < 28) base = 2244 + (hh - 26) * 64; else base = 2500 + (hh - 28) * 64;
        return base + e; }
    if (n < Z_BV) return 320 + (n - Z_AV);
    if (n < Z_KC) return 1220 + (n - Z_BV);
    if (n < Z_VC) return 1988 + (n - Z_KC);
    if (n < Z_VS) return 2116 + (n - Z_VC);
    if (n < Z_VW) return 2372 + (n - Z_VS);
    if (n < Z_IW) return 2628 + (n - Z_VW);
    if (n < Z_CG) return 704 + (n - Z_IW);
    if (n < Z_END) return 2756 + (n - Z_CG);
    return -1;
}
struct MapPlain { const float* W; DI const float* operator()(int n) const { return W + n; } };
struct MapGateUp { const float* Wg; const float* Wu; DI const float* operator()(int n) const { return ((n & 1) ? Wu : Wg) + (n >> 1); } };
struct MapZin { const float* W; DI const float* operator()(int n) const { const int oc = zcol_to_orig(n); return oc < 0 ? nullptr : W + oc; } };
struct MapW2K { const float* W; DI const float* operator()(int n) const { return W + (n >> 1) + 32 * (n & 1); } };
template <class Map>
DI void tr_item(const Map& mp, int ld, int K, int nblk, bf16* WT, LAS float* scr, int item, int lane) {
    const int kb = item / nblk, nb = item % nblk, k0 = 64 * kb, n0 = 32 * nb;
    if (mp.kind <= 1) {
        const int rr = lane >> 3, c4 = lane & 7;
        const float* src = (mp.kind == 0) ? mp.W0 + n0 + 4 * c4 : ((c4 < 4) ? mp.W0 : mp.W1) + (n0 >> 1) + 4 * (c4 & 3);
        f32x4 v[8];
#pragma unroll
        for (int i = 0; i < 8; ++i) v[i] = *(const f32x4*)(src + (size_t)(k0 + 8 * i + rr) * ld);
#pragma unroll
        for (int i = 0; i < 8; ++i) { LAS float* d = scr + (8 * i + rr) * 33;
            if (mp.kind == 0) { d[4 * c4] = v[i].x; d[4 * c4 + 1] = v[i].y; d[4 * c4 + 2] = v[i].z; d[4 * c4 + 3] = v[i].w; }
            else { const int nl = 8 * (c4 & 3) + (c4 >> 2); d[nl] = v[i].x; d[nl + 2] = v[i].y; d[nl + 4] = v[i].z; d[nl + 6] = v[i].w; } }
    } else {
        const float* colp = mp(n0 + (lane & 31));
#pragma unroll 8
        for (int i = 0; i < 32; ++i) { const int kk = 2 * i + (lane >> 5); scr[kk * 33 + (lane & 31)] = colp ? colp[(size_t)(k0 + kk) * ld] : 0.f; }
    }
    LDS_WAIT(); asm volatile("" ::: "memory");
    const int c = lane & 7;
    f32x4 ga = {1.f, 1.f, 1.f, 1.f}, gb = {1.f, 1.f, 1.f, 1.f};
    if (mp.gk) { ga = *(const f32x4*)(mp.gk + k0 + 8 * c); gb = *(const f32x4*)(mp.gk + k0 + 8 * c + 4); }
#pragma unroll
    for (int j = 0; j < 4; ++j) { const int n = (lane >> 3) + 8 * j; const LAS float* s = scr + (8 * c) * 33 + n;
        u32x4 o; o.x = pk2(s[0 * 33] * ga.x, s[1 * 33] * ga.y); o.y = pk2(s[2 * 33] * ga.z, s[3 * 33] * ga.w); o.z = pk2(s[4 * 33] * gb.x, s[5 * 33] * gb.y); o.w = pk2(s[6 * 33] * gb.z, s[7 * 33] * gb.w);
        *(u32x4*)(WT + (size_t)(n0 + n) * K + k0 + 8 * c) = o; }
    LDS_WAIT(); asm volatile("" ::: "memory");
}
DI void rms_row_bf16(const float* xrow, const float* g, bf16* orow, bf16* xbrow, int lane) {
    const f32x4* xr = (const f32x4*)xrow + lane; const f32x4* gr = (const f32x4*)g + lane;
    f32x4 v[4]; float s = 0.f;
#pragma unroll
    for (int j = 0; j < 4; ++j) { v[j] = xr[64 * j]; s += (v[j].x * v[j].x + v[j].y * v[j].y) + (v[j].z * v[j].z + v[j].w * v[j].w); }
    const float rstd = 1.f / sqrtf(wave_sum(s) * (1.f / D) + NORM_EPS);
    unsigned long long* o8 = (unsigned long long*)orow + lane; unsigned long long* x8 = (unsigned long long*)xbrow + lane;
#pragma unroll
    for (int j = 0; j < 4; ++j) { const f32x4 gg = gr[64 * j];
        x8[64 * j] = (unsigned long long)pk2(v[j].x, v[j].y) | ((unsigned long long)pk2(v[j].z, v[j].w) << 32);
        o8[64 * j] = (unsigned long long)pk2(v[j].x * rstd * gg.x, v[j].y * rstd * gg.y) | ((unsigned long long)pk2(v[j].z * rstd * gg.z, v[j].w * rstd * gg.w) << 32); }
}
DI void rms_rows4_bf16(const float* x, const float* g, bf16* o, bf16* xb, size_t m0, size_t stride, int lane) {
    f32x4 v[4][4]; float ss[4];
#pragma unroll
    for (int q = 0; q < 4; ++q) { const f32x4* xr = (const f32x4*)(x + (m0 + q * stride) * D) + lane;
#pragma unroll
        for (int j = 0; j < 4; ++j) v[q][j] = xr[64 * j]; }
#pragma unroll
    for (int q = 0; q < 4; ++q) { float a = 0.f;
#pragma unroll
        for (int j = 0; j < 4; ++j) a += (v[q][j].x * v[q][j].x + v[q][j].y * v[q][j].y) + (v[q][j].z * v[q][j].z + v[q][j].w * v[q][j].w);
        ss[q] = a; }
#pragma unroll
    for (int of = 1; of < 64; of <<= 1) {
#pragma unroll
        for (int q = 0; q < 4; ++q) ss[q] += __shfl_xor(ss[q], of); }
    const f32x4* gr = (const f32x4*)g + lane;
#pragma unroll
    for (int q = 0; q < 4; ++q) { const float rstd = 1.f / sqrtf(ss[q] * (1.f / D) + NORM_EPS);
        unsigned long long* o8 = (unsigned long long*)(o + (m0 + q * stride) * D) + lane; unsigned long long* x8 = (unsigned long long*)(xb + (m0 + q * stride) * D) + lane;
#pragma unroll
        for (int j = 0; j < 4; ++j) { const f32x4 gg = gr[64 * j];
            x8[64 * j] = (unsigned long long)pk2(v[q][j].x, v[q][j].y) | ((unsigned long long)pk2(v[q][j].z, v[q][j].w) << 32);
            o8[64 * j] = (unsigned long long)pk2(v[q][j].x * rstd * gg.x, v[q][j].y * rstd * gg.y) | ((unsigned long long)pk2(v[q][j].z * rstd * gg.z, v[q][j].w * rstd * gg.w) << 32); } }
}
DI void xb_init_rows4(const float* x, bf16* xb, float* ss, size_t m0, size_t stride, int lane) {
    f32x4 v[4][4]; float sq[4];
#pragma unroll
    for (int q = 0; q < 4; ++q) { const f32x4* xr = (const f32x4*)(x + (m0 + q * stride) * D) + lane;
#pragma unroll
        for (int j = 0; j < 4; ++j) v[q][j] = xr[64 * j]; }
#pragma unroll
    for (int q = 0; q < 4; ++q) { float a = 0.f;
#pragma unroll
        for (int j = 0; j < 4; ++j) a += (v[q][j].x * v[q][j].x + v[q][j].y * v[q][j].y) + (v[q][j].z * v[q][j].z + v[q][j].w * v[q][j].w);
        sq[q] = a; }
#pragma unroll
    for (int of = 1; of < 64; of <<= 1) {
#pragma unroll
        for (int q = 0; q < 4; ++q) sq[q] += __shfl_xor(sq[q], of); }
#pragma unroll
    for (int q = 0; q < 4; ++q) { unsigned long long* x8 = (unsigned long long*)(xb + (m0 + q * stride) * D) + lane;
#pragma unroll
        for (int j = 0; j < 4; ++j) x8[64 * j] = (unsigned long long)pk2(v[q][j].x, v[q][j].y) | ((unsigned long long)pk2(v[q][j].z, v[q][j].w) << 32);
        if (lane < 16) ss[(m0 + q * stride) * 16 + lane] = lane == 0 ? sq[q] : 0.f; }
}
template <int NR>
DI void rms_rows_b2b(const bf16* x, const float* g, bf16* o, size_t m0, size_t stride, int lane) {
    u32x4 v[NR][2]; float ss[NR];
#pragma unroll
    for (int q = 0; q < NR; ++q) { const u32x4* xr = (const u32x4*)(x + (m0 + q * stride) * D) + lane;
#pragma unroll
        for (int j = 0; j < 2; ++j) v[q][j] = xr[64 * j]; }
#pragma unroll
    for (int q = 0; q < NR; ++q) { float a = 0.f;
#pragma unroll
        for (int j = 0; j < 2; ++j) { const u32x4 t = v[q][j];
            a += (bflo(t.x) * bflo(t.x) + bfhi(t.x) * bfhi(t.x)) + (bflo(t.y) * bflo(t.y) + bfhi(t.y) * bfhi(t.y)) + (bflo(t.z) * bflo(t.z) + bfhi(t.z) * bfhi(t.z)) + (bflo(t.w) * bflo(t.w) + bfhi(t.w) * bfhi(t.w)); }
        ss[q] = a; }
#pragma unroll
    for (int of = 1; of < 64; of <<= 1) {
#pragma unroll
        for (int q = 0; q < NR; ++q) ss[q] += __shfl_xor(ss[q], of); }
#pragma unroll
    for (int q = 0; q < NR; ++q) { const float rstd = 1.f / sqrtf(ss[q] * (1.f / D) + NORM_EPS);
        u32x4* o16 = (u32x4*)(o + (m0 + q * stride) * D) + lane;
#pragma unroll
        for (int j = 0; j < 2; ++j) { const f32x4 g0 = ((const f32x4*)g)[2 * (lane + 64 * j)], g1 = ((const f32x4*)g)[2 * (lane + 64 * j) + 1]; const u32x4 t = v[q][j];
            u32x4 r; r.x = pk2(bflo(t.x) * rstd * g0.x, bfhi(t.x) * rstd * g0.y); r.y = pk2(bflo(t.y) * rstd * g0.z, bfhi(t.y) * rstd * g0.w);
            r.z = pk2(bflo(t.z) * rstd * g1.x, bfhi(t.z) * rstd * g1.y); r.w = pk2(bflo(t.w) * rstd * g1.z, bfhi(t.w) * rstd * g1.w);
            o16[64 * j] = r; } }
}
DI void rms_row_b2f(const bf16* xrow, const float* g, float* orow, int lane) {
    u32x4 v[2]; float s = 0.f;
#pragma unroll
    for (int j = 0; j < 2; ++j) { v[j] = ((const u32x4*)xrow)[lane + 64 * j]; const u32x4 t = v[j];
        s += (bflo(t.x) * bflo(t.x) + bfhi(t.x) * bfhi(t.x)) + (bflo(t.y) * bflo(t.y) + bfhi(t.y) * bfhi(t.y)) + (bflo(t.z) * bflo(t.z) + bfhi(t.z) * bfhi(t.z)) + (bflo(t.w) * bflo(t.w) + bfhi(t.w) * bfhi(t.w)); }
    const float rstd = 1.f / sqrtf(wave_sum(s) * (1.f / D) + NORM_EPS);
#pragma unroll
    for (int j = 0; j < 2; ++j) { const f32x4 g0 = ((const f32x4*)g)[2 * (lane + 64 * j)], g1 = ((const f32x4*)g)[2 * (lane + 64 * j) + 1]; const u32x4 t = v[j];
        f32x4 r0, r1; r0.x = bflo(t.x) * rstd * g0.x; r0.y = bfhi(t.x) * rstd * g0.y; r0.z = bflo(t.y) * rstd * g0.z; r0.w = bfhi(t.y) * rstd * g0.w;
        r1.x = bflo(t.z) * rstd * g1.x; r1.y = bfhi(t.z) * rstd * g1.y; r1.z = bflo(t.w) * rstd * g1.z; r1.w = bfhi(t.w) * rstd * g1.w;
        ((f32x4*)orow)[2 * (lane + 64 * j)] = r0; ((f32x4*)orow)[2 * (lane + 64 * j) + 1] = r1; }
}

struct Args { const float* in[22]; float* out; unsigned char* ws; int ph_lo, ph_hi; };
struct MapGen { int kind; const float* W0; const float* W1; const float* gk;
    DI const float* operator()(int n) const {
        if (kind == 0) return W0 + n;
        if (kind == 1) return ((n & 1) ? W1 : W0) + (n >> 1);
        if (kind == 2) { const int oc = zcol_to_orig(n); return oc < 0 ? nullptr : W0 + oc; }
        return W0 + (n >> 1) + 32 * (n & 1);
    } };
DI void convert_weights(const Args& A, int l, bf16* Wb, float* bias1p, LAS unsigned char* lds, int gw, int NGW, int wave, int lane, int tid) {
    LAS float* scr = (LAS float*)(lds + wave * 16384);
    constexpr int I_UP = 16 * 176, I_DN = 44 * 32, I_IN = 16 * 88, I_G = 16 * 96, I_A = 4 * 32, I_C = 8 * 32, I_O = 16 * 32, I_1 = 32 * 4, I_2 = 2 * 2;
    constexpr int NIT = 2 * I_UP + 2 * I_DN + I_IN + I_G + 2 * I_A + I_C + I_O + 2 * I_1 + 2 * I_2;
    for (int it = gw; it < NIT; it += NGW) {
        int r = it; MapGen mp; mp.kind = 0; mp.W0 = nullptr; mp.W1 = nullptr; mp.gk = nullptr; int ld, K, nblk; size_t dst;
        if (r < I_UP) { mp.kind = 1; mp.W0 = A.in[2] + (size_t)l * D * DFF; mp.W1 = A.in[3] + (size_t)l * D * DFF; mp.gk = A.in[1] + (size_t)l * D; ld = DFF; K = D; nblk = 176; dst = W_UP1; }
        else if ((r -= I_UP) < I_DN) { mp.W0 = A.in[4] + (size_t)l * DFF * D; ld = D; K = DFF; nblk = 32; dst = W_DN1; }
        else if ((r -= I_DN) < I_UP) { mp.kind = 1; mp.W0 = A.in[18] + (size_t)l * D * DFF; mp.W1 = A.in[19] + (size_t)l * D * DFF; mp.gk = A.in[17] + (size_t)l * D; ld = DFF; K = D; nblk = 176; dst = W_UP2; }
        else if ((r -= I_UP) < I_DN) { mp.W0 = A.in[20] + (size_t)l * DFF * D; ld = D; K = DFF; nblk = 32; dst = W_DN2; }
        else if ((r -= I_DN) < I_IN) { mp.kind = 2; mp.W0 = A.in[6] + (size_t)l * D * IN_COLS; mp.gk = A.in[5] + (size_t)l * D; ld = IN_COLS; K = D; nblk = 88; dst = W_IN; }
        else if ((r -= I_IN) < I_G) { mp.W0 = A.in[6] + (size_t)l * D * IN_COLS + Z_END; mp.gk = A.in[5] + (size_t)l * D; ld = IN_COLS; K = D; nblk = 96; dst = W_G; }
        else if ((r -= I_G) < I_A) { mp.W0 = A.in[13] + (size_t)l * 256 * D; ld = D; K = 256; nblk = 32; dst = W_A; }
        else if ((r -= I_A) < I_A) { mp.W0 = A.in[14] + (size_t)l * 256 * D; ld = D; K = 256; nblk = 32; dst = W_B; }
        else if ((r -= I_A) < I_C) { mp.W0 = A.in[15] + (size_t)l * 512 * D; ld = D; K = 512; nblk = 32; dst = W_C; }
        else if ((r -= I_C) < I_O) { mp.W0 = A.in[16] + (size_t)l * D * D; ld = D; K = D; nblk = 32; dst = W_O; }
        else if ((r -= I_O) < I_1) { mp.W0 = A.in[8] + (size_t)l * 2048 * 128; ld = 128; K = 2048; nblk = 4; dst = W_1K; }
        else if ((r -= I_1) < I_1) { mp.W0 = A.in[11] + (size_t)l * 2048 * 128; ld = 128; K = 2048; nblk = 4; dst = W_1V; }
        else if ((r -= I_1) < I_2) { mp.kind = 3; mp.W0 = A.in[9] + (size_t)l * 128 * 64; ld = 64; K = 128; nblk = 2; dst = W_2K; }
        else { r -= I_2; mp.W0 = A.in[12] + (size_t)l * 128 * 64; ld = 64; K = 128; nblk = 2; dst = W_2V; }
        tr_item(mp, ld, K, nblk, Wb + dst, scr, r, lane);
    }
    if (blockIdx.x < 16) {
        LDS_WAIT(); __syncthreads();
        const int kv = blockIdx.x >> 3, kc = blockIdx.x & 7, u = tid & 127, ks = tid >> 7;
        const float* pos = (kv ? A.in[10] : A.in[7]) + (size_t)l * 2048; const float* w1 = (kv ? A.in[11] : A.in[8]) + (size_t)l * 2048 * 128;
        float a = 0.f;
        for (int i = 0; i < 64; ++i) { const int k = kc * 256 + ks * 64 + i; a += pos[k] * w1[(size_t)k * 128 + u]; }
        LAS float* red = (LAS float*)lds;
        red[ks * 128 + u] = a;
        __syncthreads();
        if (tid < 128) bias1p[(kv * 8 + kc) * 128 + tid] = (red[tid] + red[128 + tid]) + (red[256 + tid] + red[384 + tid]);
        __syncthreads();
    }
}
DI void rope_table(float* cosT, float* sinT, int gtid, int gthreads) {
    for (int e = gtid; e < T * 32; e += gthreads) {
        const int pos = e >> 5, i = e & 31;
        double iv = 1.0;
        for (int k = 0; k < i; ++k) iv *= 0.74989420933245582;
        const float inv = (float)iv;
        const float ang = (float)pos * inv;
        const double x = (double)ang; const double n = rint(x * 0.15915494309189535);
        const float rr = (float)(x - n * 6.283185307179586);
        cosT[e] = __cosf(rr); sinT[e] = __sinf(rr);
    }
}

constexpr int VROWB = 192, VT_BYTES = 32 * VROWB;
DI void load_v_tile(const bf16* vbase, size_t vstride, LAS unsigned char* vt, int lane) {
#pragma unroll
    for (int it = 0; it < 4; ++it) { const int c = lane + 64 * it, key = c >> 3, ch = c & 7;
        const u32x4 v = *(const u32x4*)(vbase + (size_t)key * vstride + ch * 8);
        *(LAS u32x4*)(vt + key * VROWB + ch * 16) = v; }
}
DI f32x16 qk_tile(const bf16* kbase, size_t kstride, const bf16x8 (&qf)[4], int r, int h) {
    bf16x8 kf[4];
#pragma unroll
    for (int ks = 0; ks < 4; ++ks) kf[ks] = *(const bf16x8*)(kbase + (size_t)r * kstride + 16 * ks + 8 * h);
    f32x16 s;
#pragma unroll
    for (int i = 0; i < 16; ++i) s[i] = 0.f;
#pragma unroll
    for (int ks = 0; ks < 4; ++ks) s = MFMA32(kf[ks], qf[ks], s);
    return s;
}
DI s16x4 vtr(const LAS unsigned char* p) { return __builtin_bit_cast(s16x4, __builtin_amdgcn_ds_read_tr16_b64_v4i16((LAS s16x4*)p)); }
constexpr float SM_TAU = 8.f;
DI void softmax_pv(f32x16& s, float mx, float mref, f32x16& o0, f32x16& o1, float& m, float& l, const LAS unsigned char* vt, int lane) {
    mx = fmaxf(mx, __shfl_xor(mx, 32));
    const bool upd = (mx > SM_TAU) || (m < -1e29f && mx > -1e30f);
    if (__any(upd)) {
        const float d = upd ? mx : 0.f;
        const float alpha = (m < -1e29f) ? 1.f : ex2(-d);
        if (upd) m = mref + d;
        l *= alpha;
#pragma unroll
        for (int i = 0; i < 16; ++i) { o0[i] *= alpha; o1[i] *= alpha; s[i] -= d; }
    }
    float rs = 0.f;
#pragma unroll
    for (int i = 0; i < 16; ++i) { s[i] = ex2(s[i]); rs += s[i]; }
    l += rs;
    u32x4 pa, pb;
    pa.x = pk2(s[0], s[1]); pa.y = pk2(s[2], s[3]); pa.z = pk2(s[4], s[5]); pa.w = pk2(s[6], s[7]);
    pb.x = pk2(s[8], s[9]); pb.y = pk2(s[10], s[11]); pb.z = pk2(s[12], s[13]); pb.w = pk2(s[14], s[15]);
    const bf16x8 p0 = __builtin_bit_cast(bf16x8, pa), p1 = __builtin_bit_cast(bf16x8, pb);
    const int h = lane >> 5, blk = (lane >> 4) & 1, q = (lane & 15) >> 2, p = lane & 3;
    const LAS unsigned char* tb = vt + (4 * h + q) * VROWB + (16 * blk + 4 * p) * 2;
    s16x4 lo[2][2], hi[2][2];
#pragma unroll
    for (int dt = 0; dt < 2; ++dt)
#pragma unroll
        for (int ss = 0; ss < 2; ++ss) { lo[dt][ss] = vtr(tb + (16 * ss) * VROWB + 64 * dt); hi[dt][ss] = vtr(tb + (16 * ss + 8) * VROWB + 64 * dt); }
    asm volatile("" ::: "memory");
#pragma unroll
    for (int dt = 0; dt < 2; ++dt) {
#pragma unroll
        for (int ss = 0; ss < 2; ++ss) {
            const bf16x8 vf = __builtin_shufflevector(lo[dt][ss], hi[dt][ss], 0, 1, 2, 3, 4, 5, 6, 7);
            if (dt == 0) o0 = MFMA32(vf, ss ? p1 : p0, o0); else o1 = MFMA32(vf, ss ? p1 : p0, o1);
        }
    }
}
#define ZERO16(v) do { _Pragma("unroll") for (int _i = 0; _i < 16; ++_i) (v)[_i] = 0.f; } while (0)

struct KVPre { bf16x8 k[4]; u32x4 v[4]; };
DI void kv_issue(KVPre& p, const bf16* kb, size_t kstride, const bf16* vb, size_t vstride, int r, int h, int lane) {
#pragma unroll
    for (int ks = 0; ks < 4; ++ks) p.k[ks] = *(const bf16x8*)(kb + (size_t)r * kstride + 16 * ks + 8 * h);
#pragma unroll
    for (int it = 0; it < 4; ++it) { const int c = lane + 64 * it, key = c >> 3, ch = c & 7; p.v[it] = *(const u32x4*)(vb + (size_t)key * vstride + ch * 8); }
}
DI void k_issue(KVPre& p, const bf16* kb, size_t kstride, int r, int h) {
#pragma unroll
    for (int ks = 0; ks < 4; ++ks) p.k[ks] = *(const bf16x8*)(kb + (size_t)r * kstride + 16 * ks + 8 * h);
}
DI f32x16 qk_pre(const KVPre& p, const bf16x8 (&qf)[4]) {
    f32x16 s;
#pragma unroll
    for (int i = 0; i < 16; ++i) s[i] = 0.f;
#pragma unroll
    for (int ks = 0; ks < 4; ++ks) s = MFMA32(p.k[ks], qf[ks], s);
    return s;
}
DI void v_store(const KVPre& p, LAS unsigned char* vt, int lane) {
#pragma unroll
    for (int it = 0; it < 4; ++it) { const int c = lane + 64 * it, key = c >> 3, ch = c & 7; *(LAS u32x4*)(vt + key * VROWB + ch * 16) = p.v[it]; }
}
template <class It, class Mk>
DI void attn_loop(It& it, const Mk& mk, const bf16* kbase, size_t kstride, const bf16* vbase, size_t vstride, const bf16x8 (&qf)[4], float cs,
                  f32x16& o0, f32x16& o1, float& m, float& l, LAS unsigned char* vt0, LAS unsigned char* vt1, int lane) {
    const int r = lane & 31, h = lane >> 5;
    KVPre A, B;
    int kbA = -1, kbB = -1;
    bool hA = it.next(kbA), hB = false;
    if (!hA) return;
    kv_issue(A, kbase + (size_t)kbA * kstride, kstride, vbase + (size_t)kbA * vstride, vstride, r, h, lane);
    v_store(A, vt0, lane);
    for (;;) {
        kbB = kbA; hB = it.next(kbB);
        if (hB) { k_issue(B, kbase + (size_t)kbB * kstride, kstride, r, h);
            const bf16* vb = vbase + (size_t)kbB * vstride;
#pragma unroll
            for (int t4 = 0; t4 < 4; ++t4) { const int c = lane + 64 * t4, key = c >> 3, ch = c & 7; A.v[t4] = *(const u32x4*)(vb + (size_t)key * vstride + ch * 8); } }
        { f32x16 s = qk_pre(A, qf); const bool rw = mk.row(kbA); float mx; const float mref = (m < -1e29f) ? 0.f : m; const float biasm = (rw ? 0.f : NEG_INF) - mref;
          if (mk.full(kbA)) { const float bias = biasm;
#pragma unroll
            for (int i = 0; i < 16; ++i) s[i] = s[i] * cs + bias;
            mx = s[0];
#pragma unroll
            for (int i = 1; i < 16; ++i) mx = fmaxf(mx, s[i]);
          } else {
#pragma unroll
            for (int i = 0; i < 16; ++i) { const int key = kbA + crow(i, h); s[i] = mk.elem(key) ? s[i] * cs + biasm : NEG_INF; }
            mx = s[0];
#pragma unroll
            for (int i = 1; i < 16; ++i) mx = fmaxf(mx, s[i]); }
          softmax_pv(s, mx, mref, o0, o1, m, l, vt0, lane); }
        if (!hB) break;
        v_store(A, vt1, lane);
        kbA = kbB; hA = it.next(kbA);
        if (hA) { k_issue(A, kbase + (size_t)kbA * kstride, kstride, r, h);
            const bf16* vb = vbase + (size_t)kbA * vstride;
#pragma unroll
            for (int t4 = 0; t4 < 4; ++t4) { const int c = lane + 64 * t4, key = c >> 3, ch = c & 7; A.v[t4] = *(const u32x4*)(vb + (size_t)key * vstride + ch * 8); } }
        { f32x16 s = qk_pre(B, qf); const bool rw = mk.row(kbB); float mx; const float mref = (m < -1e29f) ? 0.f : m; const float biasm = (rw ? 0.f : NEG_INF) - mref;
          if (mk.full(kbB)) { const float bias = biasm;
#pragma unroll
            for (int i = 0; i < 16; ++i) s[i] = s[i] * cs + bias;
            mx = s[0];
#pragma unroll
            for (int i = 1; i < 16; ++i) mx = fmaxf(mx, s[i]);
          } else {
#pragma unroll
            for (int i = 0; i < 16; ++i) { const int key = kbB + crow(i, h); s[i] = mk.elem(key) ? s[i] * cs + biasm : NEG_INF; }
            mx = s[0];
#pragma unroll
            for (int i = 1; i < 16; ++i) mx = fmaxf(mx, s[i]); }
          softmax_pv(s, mx, mref, o0, o1, m, l, vt1, lane); }
        if (!hA) break;
        v_store(A, vt0, lane);
    }
}
struct ItRange { int kb0, kb_last; DI bool next(int& kb) const { const int nk = kb < 0 ? kb0 : kb + 32; if (nk > kb_last) return false; kb = nk; return true; } };
struct ItMoba { unsigned nm; int tmax; DI bool next(int& kb) const {
        if (kb >= 0) { const int nk = kb + 32; if ((nk & 255) && nk <= tmax) { kb = nk; return true; } }
        const int n = kb < 0 ? 0 : (kb >> 8) + 1; if (n > 31) return false; const unsigned mm = nm >> n; if (!mm) return false;
        kb = (n + __builtin_ctz(mm)) * 256; return true; } };
struct ItSlc { unsigned long long lo, hi; int tmax; DI bool next(int& kb) const {
        if (kb >= 0 && !(kb & 32) && kb + 32 <= tmax) { kb += 32; return true; }
        int j = kb < 0 ? 0 : (kb >> 6) + 1; if (j > 127) return false;
        if (j < 64) { const unsigned long long mm = lo >> j; if (mm) { kb = (j + __builtin_ctzll(mm)) * 64; return true; } j = 64; }
        const unsigned long long mh = hi >> (j - 64); if (!mh) return false; kb = (j + __builtin_ctzll(mh)) * 64; return true; } };

constexpr int KROWB = 144, KT2_BYTES = 64 * KROWB, VT2_BYTES = 64 * VROWB, BT_BYTES = KT2_BYTES + VT2_BYTES;
DI void softmax_pv2(f32x16& sa, f32x16& sb, float mx, float mref, f32x16& o0, f32x16& o1, float& m, float& l, const LAS unsigned char* vta, int lane) {
    mx = fmaxf(mx, __shfl_xor(mx, 32));
    const bool upd = (mx > SM_TAU) || (m < -1e29f && mx > -1e30f);
    if (__any(upd)) {
        const float d = upd ? mx : 0.f;
        const float alpha = (m < -1e29f) ? 1.f : ex2(-d);
        if (upd) m = mref + d;
        l *= alpha;
#pragma unroll
        for (int i = 0; i < 16; ++i) { o0[i] *= alpha; o1[i] *= alpha; sa[i] -= d; sb[i] -= d; }
    }
    float rs = 0.f;
#pragma unroll
    for (int i = 0; i < 16; i += 2) { sa[i] = ex2(sa[i]); sa[i + 1] = ex2(sa[i + 1]); sb[i] = ex2(sb[i]); sb[i + 1] = ex2(sb[i + 1]); rs += (sa[i] + sb[i]) + (sa[i + 1] + sb[i + 1]); }
    l += rs;
    u32x4 pa, pb, pc, pd;
    pa.x = pk2(sa[0], sa[1]); pa.y = pk2(sa[2], sa[3]); pa.z = pk2(sa[4], sa[5]); pa.w = pk2(sa[6], sa[7]);
    pb.x = pk2(sa[8], sa[9]); pb.y = pk2(sa[10], sa[11]); pb.z = pk2(sa[12], sa[13]); pb.w = pk2(sa[14], sa[15]);
    pc.x = pk2(sb[0], sb[1]); pc.y = pk2(sb[2], sb[3]); pc.z = pk2(sb[4], sb[5]); pc.w = pk2(sb[6], sb[7]);
    pd.x = pk2(sb[8], sb[9]); pd.y = pk2(sb[10], sb[11]); pd.z = pk2(sb[12], sb[13]); pd.w = pk2(sb[14], sb[15]);
    const bf16x8 p0 = __builtin_bit_cast(bf16x8, pa), p1 = __builtin_bit_cast(bf16x8, pb), p2 = __builtin_bit_cast(bf16x8, pc), p3 = __builtin_bit_cast(bf16x8, pd);
    const int h = lane >> 5, blk = (lane >> 4) & 1, q = (lane & 15) >> 2, p = lane & 3;
    const LAS unsigned char* tb = vta + (4 * h + q) * VROWB + (16 * blk + 4 * p) * 2;
#pragma unroll
    for (int dt = 0; dt < 2; ++dt) {
        s16x4 lo[4], hi[4];
#pragma unroll
        for (int ss = 0; ss < 4; ++ss) { lo[ss] = vtr(tb + (16 * ss) * VROWB + 64 * dt); hi[ss] = vtr(tb + (16 * ss + 8) * VROWB + 64 * dt); }
        asm volatile("" ::: "memory");
#pragma unroll
        for (int ss = 0; ss < 4; ++ss) {
            const bf16x8 vf = __builtin_shufflevector(lo[ss], hi[ss], 0, 1, 2, 3, 4, 5, 6, 7);
            const bf16x8 pp = ss == 0 ? p0 : ss == 1 ? p1 : ss == 2 ? p2 : p3;
            if (dt == 0) o0 = MFMA32(vf, pp, o0); else o1 = MFMA32(vf, pp, o1);
        }
    }
}
#define BLK_ISSUE(kbn) do { regk = *(const u32x4*)(kbase + (size_t)((kbn) + lk) * kstride + lc * 8); if (vbase) regv = *(const u32x4*)(vbase + (size_t)((kbn) + lk) * vstride + lc * 8); } while (0)
#define BLK_STORE(buf) do { *(LAS u32x4*)(tb + (buf) * BT_BYTES + lk * KROWB + lc * 16) = regk; if (vbase) *(LAS u32x4*)(tb + (buf) * BT_BYTES + KT2_BYTES + lk * VROWB + lc * 16) = regv; } while (0)
template <class It, class Mk>
DI void attn_loop_blk(It& it, const Mk& mk, const bf16* kbase, size_t kstride, const bf16* vbase, size_t vstride, const bf16x8 (&qf)[4], float cs,
                      f32x16& o0, f32x16& o1, float& m, float& l, LAS unsigned char* tb, int tid, int lane) {
    const int r = lane & 31, h = lane >> 5;
    const int lk = tid >> 3, lc = tid & 7;
    int kb = -1; bool has = it.next(kb);
    if (has) {
        u32x4 regk = {0u, 0u, 0u, 0u}, regv = {0u, 0u, 0u, 0u};
        BLK_ISSUE(kb); BLK_STORE(0);
        __syncthreads();
        int cur = 0;
        for (;;) {
            int kbn = kb; const bool hn = it.next(kbn);
            if (hn) BLK_ISSUE(kbn);
            if (mk.needs(kb)) {
                const LAS unsigned char* kt = tb + cur * BT_BYTES;
                f32x16 sa, sb;
#pragma unroll
                for (int i = 0; i < 16; ++i) { sa[i] = 0.f; sb[i] = 0.f; }
#pragma unroll
                for (int ks = 0; ks < 4; ++ks) { const bf16x8 ka = *(const LAS bf16x8*)(kt + r * KROWB + (16 * ks + 8 * h) * 2), kc = *(const LAS bf16x8*)(kt + (32 + r) * KROWB + (16 * ks + 8 * h) * 2);
                    sa = MFMA32(ka, qf[ks], sa); sb = MFMA32(kc, qf[ks], sb); }
                const bool rw = mk.row(kb); float mx; const float mref = (m < -1e29f) ? 0.f : m; const float biasm = (rw ? 0.f : NEG_INF) - mref;
                if (mk.full(kb)) { const float bias = biasm;
#pragma unroll
                    for (int i = 0; i < 16; ++i) { sa[i] = sa[i] * cs + bias; sb[i] = sb[i] * cs + bias; }
                    mx = fmaxf(sa[0], sb[0]);
#pragma unroll
                    for (int i = 1; i < 16; ++i) mx = fmaxf(mx, fmaxf(sa[i], sb[i]));
                } else {
#pragma unroll
                    for (int i = 0; i < 16; ++i) { const int key = kb + crow(i, h); sa[i] = mk.elem(key) ? sa[i] * cs + biasm : NEG_INF; sb[i] = mk.elem(key + 32) ? sb[i] * cs + biasm : NEG_INF; }
                    mx = fmaxf(sa[0], sb[0]);
#pragma unroll
                    for (int i = 1; i < 16; ++i) mx = fmaxf(mx, fmaxf(sa[i], sb[i])); }
                softmax_pv2(sa, sb, mx, mref, o0, o1, m, l, kt + KT2_BYTES, lane);
            }
            if (!hn) break;
            BLK_STORE(cur ^ 1);
            __syncthreads();
            cur ^= 1; kb = kbn;
        }
    }
    __syncthreads();
}
struct ItRange64 { int kb0, kb_last; DI bool next(int& kb) const { const int nk = kb < 0 ? kb0 : kb + 64; if (nk > kb_last) return false; kb = nk; return true; } };
struct ItSlc64 { unsigned long long lo, hi; DI bool next(int& kb) const {
        int j = kb < 0 ? 0 : (kb >> 6) + 1; if (j > 127) return false;
        if (j < 64) { const unsigned long long mm = lo >> j; if (mm) { kb = (j + __builtin_ctzll(mm)) * 64; return true; } j = 64; }
        const unsigned long long mh = hi >> (j - 64); if (!mh) return false; kb = (j + __builtin_ctzll(mh)) * 64; return true; } };

constexpr int NSA_WLDS = 2 * VT_BYTES;
constexpr int NSAB_IMP = 2 * BT_BYTES, NSAB_XCH = NSAB_IMP + 8 * 8192, NSAB_END = NSAB_XCH + 128;
DI void nsa_block_unit(int b, int g, int Q0, const bf16* z, const bf16* cqn, const bf16* kcmp, const bf16* vcmp, bf16* O, LAS unsigned char* lds, int tid) {
    const int lane = tid & 63, wave = __builtin_amdgcn_readfirstlane(tid >> 6), tq0 = Q0 + 8 * wave, tmaxb = Q0 + 63;
    LAS unsigned char* tb = lds;
    const int r = lane & 31, h = lane >> 5, qi = r >> 2, hh = r & 3, head = 4 * g + hh, t_row = tq0 + qi, tmax = tq0 + 7;
    const size_t row = (size_t)b * T + t_row;
    LAS float* impA = (LAS float*)(lds + NSAB_IMP + wave * 8192); LAS float* impB = impA + 1024;
    bf16x8 qn[4];
    { const bf16* qnp = cqn + row * 512 + head * 64 + 8 * h;
#pragma unroll
      for (int ks = 0; ks < 4; ++ks) qn[ks] = *(const bf16x8*)(qnp + 16 * ks); }
    const float cs = 0.125f * LOG2E;
    const bf16* gp = z + row * ZLD + Z_CG + head * 3;
    const float gate_c = bf2f(gp[0]), gate_s = bf2f(gp[1]), gate_w = bf2f(gp[2]);
    f32x16 tot0, tot1, o0, o1; ZERO16(tot0); ZERO16(tot1);
    float m, l;
    const bf16* zb = z + (size_t)b * T * ZLD;
    const int ncmp = (tmax >= 31) ? ((tmax - 31) >> 4) + 1 : 0, ntc = (ncmp + 31) >> 5;
    const bf16* kcb = kcmp + (size_t)((b * 2 + g) * 512) * 64; const bf16* vcb = vcmp + (size_t)((b * 2 + g) * 512) * 64;
    ZERO16(o0); ZERO16(o1); m = -1e30f; l = 0.f;
    const int ncmpb = (tmaxb >= 31) ? ((tmaxb - 31) >> 4) + 1 : 0, nscb = (ncmpb + 63) >> 6;
    { struct MkCmp { int t_row, tq0, ncmp; DI bool needs(int nb) const { return nb < ncmp; } DI bool row(int) const { return true; } DI bool elem(int n) const { return 16 * n + 31 <= t_row; } DI bool full(int nb) const { return 16 * (nb + 63) + 31 <= tq0; } } mk{t_row, tq0, ncmp};
      ItRange64 itc{0, 64 * (nscb - 1)};
      attn_loop_blk(itc, mk, kcb, 64, vcb, 64, qn, cs, o0, o1, m, l, tb, tid, lane); }
    float ltot = l + __shfl_xor(l, 32);
    const float inv_c = ltot > 0.f ? 1.f / ltot : 0.f;
    { const float f = gate_c * inv_c;
#pragma unroll
      for (int i = 0; i < 16; ++i) { tot0[i] = o0[i] * f; tot1[i] = o1[i] * f; } }
#pragma unroll
    for (int i = 0; i < 16; ++i) { impA[lane + 64 * i] = 0.f; impB[lane + 64 * i] = 0.f; }
    {
        const int lk = tid >> 3, lc = tid & 7;
        const bf16* kbase = kcb; const size_t kstride = 64; const bf16* vbase = nullptr; const size_t vstride = 0;
        if (nscb > 0) {
            u32x4 regk = {0u, 0u, 0u, 0u}, regv = {0u, 0u, 0u, 0u};
            BLK_ISSUE(0); BLK_STORE(0);
            __syncthreads();
            int cur = 0;
            for (int st = 0; st < nscb; ++st) {
                const int nb0 = 64 * st; const bool hn = st + 1 < nscb;
                if (hn) BLK_ISSUE(nb0 + 64);
                if (nb0 < ncmp) {
                    const LAS unsigned char* ktile = tb + cur * BT_BYTES;
#pragma unroll
                    for (int hf = 0; hf < 2; ++hf) {
                        const int nb = nb0 + 32 * hf, kt = 2 * st + hf;
                        f32x16 s; ZERO16(s);
#pragma unroll
                        for (int ks = 0; ks < 4; ++ks) { const bf16x8 kf = *(const LAS bf16x8*)(ktile + (32 * hf + r) * KROWB + (16 * ks + 8 * h) * 2); s = MFMA32(kf, qn[ks], s); }
#pragma unroll
                        for (int g4 = 0; g4 < 4; ++g4) {
                            float pp[4];
#pragma unroll
                            for (int i = 0; i < 4; ++i) { const int n = nb + 8 * g4 + 4 * h + i; pp[i] = (16 * n + 31 <= t_row) ? ex2(s[4 * g4 + i] * cs - m) * inv_c : 0.f; }
                            float s4 = (pp[0] + pp[1]) + (pp[2] + pp[3]), p3 = pp[3];
                            s4 += __shfl_xor(s4, 1); p3 += __shfl_xor(p3, 1);
                            s4 += __shfl_xor(s4, 2); p3 += __shfl_xor(p3, 2);
                            if (hh == 0) { const int j0 = 8 * kt + 2 * g4 + h; impA[qi * 128 + j0] = s4; impB[qi * 128 + j0] = p3; }
                        }
                    }
                }
                if (!hn) break;
                BLK_STORE(cur ^ 1);
                __syncthreads();
                cur ^= 1;
            }
        }
        __syncthreads();
    }
    const int jq = tmax >> 6;
    unsigned mk0 = 0, mk1 = 0, mk2 = 0, mk3 = 0;
    unsigned long long ulo = 0ull, uhi = 0ull;
    for (int q8 = 0; q8 < 8; ++q8) {
        const int j0 = lane, j1 = lane + 64;
        bool sel0, sel1;
        if (jq + 1 <= 16) { sel0 = j0 <= jq; sel1 = false; }
        else {
            const float i0 = impA[q8 * 128 + j0] + (j0 >= 1 ? impB[q8 * 128 + j0 - 1] : 0.f);
            const float i1 = impA[q8 * 128 + j1] + impB[q8 * 128 + j1 - 1];
            const bool fr0 = (j0 >= 1 && j0 <= jq - 2), fr1 = (j1 <= jq - 2);
            const bool fo0 = (j0 == 0 || j0 == jq || j0 == jq - 1), fo1 = (j1 == jq || j1 == jq - 1);
            const unsigned long long k0 = fr0 ? (((unsigned long long)__builtin_bit_cast(unsigned, i0) << 7) | (unsigned)(127 - j0)) : 0ull;
            const unsigned long long k1 = fr1 ? (((unsigned long long)__builtin_bit_cast(unsigned, i1) << 7) | (unsigned)(127 - j1)) : 0ull;
            unsigned long long Tk = 0ull;
            for (int bit = 38; bit >= 0; --bit) {
                const unsigned long long cand = Tk | (1ull << bit);
                const int cnt = __builtin_popcountll(__ballot(k0 >= cand)) + __builtin_popcountll(__ballot(k1 >= cand));
                if (cnt >= 13) Tk = cand;
            }
            sel0 = fo0 || (fr0 && k0 >= Tk); sel1 = fo1 || (fr1 && k1 >= Tk);
        }
        const unsigned long long mlo = __ballot(sel0), mhi = __ballot(sel1);
        ulo |= mlo; uhi |= mhi;
        if (qi == q8) { mk0 = (unsigned)mlo; mk1 = (unsigned)(mlo >> 32); mk2 = (unsigned)mhi; mk3 = (unsigned)(mhi >> 32); }
    }
#pragma unroll
    for (int i = 0; i < 16; ++i) { impA[i * 64 + lane] = tot0[i]; impA[(16 + i) * 64 + lane] = tot1[i]; }
    bf16x8 qr[4];
    { const bf16* qrp = z + row * ZLD + Z_CQ + head * 64 + 8 * h;
#pragma unroll
      for (int ks = 0; ks < 4; ++ks) qr[ks] = *(const bf16x8*)(qrp + 16 * ks); }
    ZERO16(o0); ZERO16(o1); m = -1e30f; l = 0.f;
    { struct MkSlc { unsigned m0, m1, m2, m3; int t_row; DI bool row(int kb) const { const int j = kb >> 6; const unsigned mw = (j < 32) ? m0 : (j < 64) ? m1 : (j < 96) ? m2 : m3; return (mw >> (j & 31)) & 1u; }
                      DI bool elem(int key) const { return key <= t_row; } DI bool full(int kb) const { return kb + 63 <= tq0; } int tq0; unsigned long long wlo, whi; DI bool needs(int kb) const { const int j = kb >> 6; return kb <= tq0 + 7 && ((j < 64) ? ((wlo >> j) & 1ull) : ((whi >> (j - 64)) & 1ull)); } } mk{mk0, mk1, mk2, mk3, t_row, tq0, ulo, uhi};
      LAS unsigned long long* xch = (LAS unsigned long long*)(lds + NSAB_XCH);
      if (lane == 0) { xch[2 * wave] = ulo; xch[2 * wave + 1] = uhi; }
      __syncthreads();
      unsigned long long blo = 0ull, bhi = 0ull;
#pragma unroll
      for (int ww = 0; ww < 8; ++ww) { blo |= xch[2 * ww]; bhi |= xch[2 * ww + 1]; }
      ItSlc64 its{blo, bhi};
      attn_loop_blk(its, mk, zb + Z_KS + g * 64, ZLD, zb + Z_VS + g * 64, ZLD, qr, cs, o0, o1, m, l, tb, tid, lane); }
    ltot = l + __shfl_xor(l, 32);
    { const float f = gate_s * (ltot > 0.f ? 1.f / ltot : 0.f);
#pragma unroll
      for (int i = 0; i < 16; ++i) { impA[i * 64 + lane] += o0[i] * f; impA[(16 + i) * 64 + lane] += o1[i] * f; } }
    ZERO16(o0); ZERO16(o1); m = -1e30f; l = 0.f;
    { const int klo = tq0 - 511 > 0 ? tq0 - 511 : 0;
      struct MkWin { int t_row, tq0, klo; DI bool needs(int kb) const { return kb <= tq0 + 7 && kb + 63 >= klo; } DI bool row(int) const { return true; } DI bool elem(int key) const { return key <= t_row && t_row - key < 512; } DI bool full(int kb) const { return kb + 63 <= tq0 && (tq0 + 7) - kb < 512; } } mk{t_row, tq0, klo};
      const int klob = Q0 - 511 > 0 ? Q0 - 511 : 0;
      ItRange64 itw{klob & ~63, tmaxb & ~63};
      attn_loop_blk(itw, mk, zb + Z_KW + g * 64, ZLD, zb + Z_VW + g * 64, ZLD, qr, cs, o0, o1, m, l, tb, tid, lane); }
    ltot = l + __shfl_xor(l, 32);
    { const float f = gate_w * (ltot > 0.f ? 1.f / ltot : 0.f);
#pragma unroll
      for (int i = 0; i < 16; ++i) { tot0[i] = impA[i * 64 + lane] + o0[i] * f; tot1[i] = impA[(16 + i) * 64 + lane] + o1[i] * f; } }
    bf16* op = O + row * 512 + head * 64 + 4 * h;
#pragma unroll
    for (int g4 = 0; g4 < 4; ++g4) {
        u32x2 a, c2; a.x = pk2(tot0[4 * g4], tot0[4 * g4 + 1]); a.y = pk2(tot0[4 * g4 + 2], tot0[4 * g4 + 3]);
        c2.x = pk2(tot1[4 * g4], tot1[4 * g4 + 1]); c2.y = pk2(tot1[4 * g4 + 2], tot1[4 * g4 + 3]);
        *(u32x2*)(op + 8 * g4) = a; *(u32x2*)(op + 32 + 8 * g4) = c2;
    }
}

constexpr int MB_SEL = 8 * 12288, MB_LIST = MB_SEL + 1024, MB_KM = MB_LIST + 8 * 512, MB_END = MB_KM + 8192;
constexpr int PART_F = 36;
DI void moba_write_partial(float* pp, bool active, int h, const f32x16& o0, const f32x16& o1, float m, float ltot) {
    if (active) {
#pragma unroll
        for (int g4 = 0; g4 < 4; ++g4) { u32x2 a, c; a.x = pk2(o0[4 * g4], o0[4 * g4 + 1]); a.y = pk2(o0[4 * g4 + 2], o0[4 * g4 + 3]); c.x = pk2(o1[4 * g4], o1[4 * g4 + 1]); c.y = pk2(o1[4 * g4 + 2], o1[4 * g4 + 3]);
            *(u32x2*)((bf16*)pp + 8 * g4 + 4 * h) = a; *(u32x2*)((bf16*)pp + 32 + 8 * g4 + 4 * h) = c; }
        if (h == 0) { pp[32] = m; pp[33] = ltot; }
    }
}
DI void moba_block_item(int b, int head, int own, int item, const bf16* z, const float* kmean, bf16* O, float* part, LAS unsigned char* lds, int tid) {
    const int lane = tid & 63, wave = __builtin_amdgcn_readfirstlane(tid >> 6), r = lane & 31, h = lane >> 5;
    const int Q0 = 256 * own, tq0 = Q0 + 32 * wave, t_row = tq0 + r, tmax = tq0 + 31;
    const size_t row = (size_t)b * T + t_row;
    LAS unsigned char* vt = lds + wave * NSA_WLDS;
    LAS unsigned* selb = (LAS unsigned*)(lds + MB_SEL);
    LAS unsigned short* rlist = (LAS unsigned short*)(lds + MB_LIST + wave * 512);
    const bf16* zb = z + (size_t)b * T * ZLD;
    float* pbase = part + (size_t)item * 256 * 4 * PART_F;
    const float cs = 0.125f * LOG2E;
    LAS float* kml = (LAS float*)(lds + MB_KM);
    __syncthreads();
    { const int e = tid * 4, n = e >> 6, d = e & 63; *(LAS f32x4*)(kml + e) = *(const f32x4*)(kmean + (size_t)((b * 32 + n) * 256 + head * 64 + d)); }
    __syncthreads();
    int i0 = -1, i1 = -1, i2 = -1;
    {
        u32x4 qrow[8];
        { const u32x4* qp = (const u32x4*)(z + row * ZLD + Z_BQ + head * 64);
#pragma unroll
          for (int c = 0; c < 8; ++c) qrow[c] = qp[c]; }
        float v0 = NEG_INF, v1 = NEG_INF, v2 = NEG_INF;
        for (int n = 0; n < own; ++n) {
            const LAS f32x4* km = (const LAS f32x4*)(kml + n * 64);
            float gsum = 0.f;
#pragma unroll
            for (int c = 0; c < 8; ++c) { const f32x4 ka = km[2 * c], kb2 = km[2 * c + 1]; const u32x4 qq = qrow[c];
                gsum += bflo(qq.x) * ka.x + bfhi(qq.x) * ka.y + bflo(qq.y) * ka.z + bfhi(qq.y) * ka.w + bflo(qq.z) * kb2.x + bfhi(qq.z) * kb2.y + bflo(qq.w) * kb2.z + bfhi(qq.w) * kb2.w; }
            if (gsum > v0) { v2 = v1; i2 = i1; v1 = v0; i1 = i0; v0 = gsum; i0 = n; }
            else if (gsum > v1) { v2 = v1; i2 = i1; v1 = gsum; i1 = n; }
            else if (gsum > v2) { v2 = gsum; i2 = n; }
        }
    }
    if (h == 0) selb[32 * wave + r] = (unsigned)(i0 & 0xff) | ((unsigned)(i1 & 0xff) << 8) | ((unsigned)(i2 & 0xff) << 16);
    {
        bf16x8 qf[4];
        { const bf16* qp = z + row * ZLD + Z_BQ + head * 64 + 8 * h;
#pragma unroll
          for (int ks = 0; ks < 4; ++ks) qf[ks] = *(const bf16x8*)(qp + 16 * ks); }
        f32x16 o0, o1; ZERO16(o0); ZERO16(o1); float m = -1e30f, l = 0.f;
        struct MkOwn { int t_row, tq0; DI bool row(int) const { return true; } DI bool elem(int key) const { return key <= t_row; } DI bool full(int kb) const { return kb + 31 <= tq0; } } mk{t_row, tq0};
        ItMoba itm{1u << own, tmax};
        attn_loop(itm, mk, zb + Z_BK + head * 64, ZLD, zb + Z_BV + head * 64, ZLD, qf, cs, o0, o1, m, l, vt, vt + VT_BYTES, lane);
        const float ltot = l + __shfl_xor(l, 32);
        moba_write_partial(pbase + ((size_t)(32 * wave + r) * 4 + 3) * PART_F, true, h, o0, o1, m, ltot);
    }
    __syncthreads();
#pragma unroll 1
    for (int n = 0; n < own; ++n) {
        int cnt = 0;
#pragma unroll
        for (int j = 0; j < 4; ++j) { const int q = lane + 64 * j; const unsigned sv = selb[q];
            const int slot = ((sv & 0xffu) == (unsigned)n) ? 0 : (((sv >> 8) & 0xffu) == (unsigned)n) ? 1 : (((sv >> 16) & 0xffu) == (unsigned)n) ? 2 : -1;
            const bool pr = slot >= 0; const unsigned long long mk_ = __ballot(pr);
            const int pos = cnt + (int)__builtin_amdgcn_mbcnt_hi((unsigned)(mk_ >> 32), __builtin_amdgcn_mbcnt_lo((unsigned)mk_, 0u));
            if (pr) rlist[pos] = (unsigned short)(q | (slot << 8));
            cnt += __builtin_popcountll(mk_); }
#pragma unroll 1
        for (int rt = (wave - n) & 7; rt * 32 < cnt; rt += 8) {
            const bool active = rt * 32 + r < cnt;
            const unsigned ent = rlist[active ? rt * 32 + r : 0];
            const int q = ent & 0xff, slot = (int)(ent >> 8);
            bf16x8 qf[4];
            { const bf16* qp = zb + (size_t)(Q0 + q) * ZLD + Z_BQ + head * 64 + 8 * h;
#pragma unroll
              for (int ks = 0; ks < 4; ++ks) qf[ks] = *(const bf16x8*)(qp + 16 * ks); }
            f32x16 o0, o1; ZERO16(o0); ZERO16(o1); float m = -1e30f, l = 0.f;
            struct MkAll { bool act; DI bool row(int) const { return act; } DI bool elem(int) const { return true; } DI bool full(int) const { return true; } } mk{active};
            ItMoba itm{1u << n, 0x7fffffff};
            attn_loop(itm, mk, zb + Z_BK + head * 64, ZLD, zb + Z_BV + head * 64, ZLD, qf, cs, o0, o1, m, l, vt, vt + VT_BYTES, lane);
            const float ltot = l + __shfl_xor(l, 32);
            moba_write_partial(pbase + ((size_t)q * 4 + slot) * PART_F, active, h, o0, o1, m, ltot);
        }
    }
    VM_WAIT();
    __syncthreads();
    {
        const float* pq = pbase + (size_t)(32 * wave + r) * 4 * PART_F;
        float mm[4], ll[4];
        { float mr[4], lr[4];
#pragma unroll
          for (int sl = 0; sl < 4; ++sl) { mr[sl] = pq[sl * PART_F + 32]; lr[sl] = pq[sl * PART_F + 33]; }
#pragma unroll
          for (int sl = 0; sl < 4; ++sl) { const bool valid = (sl == 3) || ((sl == 0 ? i0 : sl == 1 ? i1 : i2) >= 0);
              mm[sl] = valid ? mr[sl] : -1e30f; ll[sl] = valid ? lr[sl] : 0.f; } }
        const float M_ = fmaxf(fmaxf(mm[0], mm[1]), fmaxf(mm[2], mm[3]));
        float wgt[4], L = 0.f;
#pragma unroll
        for (int sl = 0; sl < 4; ++sl) { wgt[sl] = ex2(mm[sl] - M_); if (ll[sl] == 0.f) wgt[sl] = 0.f; L += ll[sl] * wgt[sl]; }
        const float inv = (L > 0.f ? 1.f / L : 0.f);
        bf16* op = O + row * 256 + head * 64 + 4 * h;
#pragma unroll
        for (int g4 = 0; g4 < 4; ++g4) {
            u32x2 pua[4], pub[4];
#pragma unroll
            for (int sl = 0; sl < 4; ++sl) { pua[sl] = *(const u32x2*)((const bf16*)(pq + sl * PART_F) + 8 * g4 + 4 * h); pub[sl] = *(const u32x2*)((const bf16*)(pq + sl * PART_F) + 32 + 8 * g4 + 4 * h); }
            f32x4 a = {0.f, 0.f, 0.f, 0.f}, c2 = {0.f, 0.f, 0.f, 0.f};
#pragma unroll
            for (int sl = 0; sl < 4; ++sl) { const bool use = wgt[sl] != 0.f;
                u32x2 ua_ = pua[sl], ub_ = pub[sl];
                ua_.x = use ? ua_.x : 0u; ua_.y = use ? ua_.y : 0u; ub_.x = use ? ub_.x : 0u; ub_.y = use ? ub_.y : 0u;
                const f32x4 pa = {bflo(ua_.x), bfhi(ua_.x), bflo(ua_.y), bfhi(ua_.y)}, pb = {bflo(ub_.x), bfhi(ub_.x), bflo(ub_.y), bfhi(ub_.y)};
                a = a + pa * wgt[sl]; c2 = c2 + pb * wgt[sl]; }
            u32x2 ua, uc; ua.x = pk2(a[0] * inv, a[1] * inv); ua.y = pk2(a[2] * inv, a[3] * inv); uc.x = pk2(c2[0] * inv, c2[1] * inv); uc.y = pk2(c2[2] * inv, c2[3] * inv);
            *(u32x2*)(op + 8 * g4) = ua; *(u32x2*)(op + 32 + 8 * g4) = uc;
        }
    }
}

DI void kmean_item(int it, const bf16* z, float* kmean, LAS unsigned char* lds, int tid) {
    const int b = it >> 5, n = it & 31, col = tid & 255, half = tid >> 8;
    const bf16* p = z + ((size_t)b * T + 256 * n + 128 * half) * ZLD + Z_BK + col;
    float a = 0.f;
#pragma unroll 8
    for (int k = 0; k < 128; ++k) a += bf2f(p[(size_t)k * ZLD]);
    LAS float* red = (LAS float*)lds;
    __syncthreads();
    if (half) red[col] = a;
    __syncthreads();
    if (!half) kmean[(size_t)(b * 32 + n) * 256 + col] = (a + red[col]) * (1.f / 256.f);
    __syncthreads();
}

DI float gelu_tanh(float x) { const float u = 0.7978845608028654f * (x + 0.044715f * x * x * x); const float e = ex2(2.f * LOG2E * u); const float th = 1.f - 2.f * __builtin_amdgcn_rcpf(e + 1.f); return 0.5f * x * (1.f + th); }
DI void compress_item(int it, const bf16* z, const bf16* Wb, const float* bias1p, bf16* kcmp, bf16* vcmp, LAS unsigned char* lds, int tid) {
    const int lane = tid & 63, wave = tid >> 6, r = lane & 31, h = lane >> 5;
    const int kv = it & 1, rtile = it >> 1, kh = wave >> 2, ut = wave & 3;
    const int R0 = 32 * rtile;
    const int bg = R0 >> 9, b = bg >> 1, g = bg & 1, n0 = R0 & 511;
    const bf16* w1t = Wb + (kv ? W_1V : W_1K); const bf16* w2t = Wb + (kv ? W_2V : W_2K);
    bf16* outp = kv ? vcmp : kcmp;
    int n = n0 + r; if (n > 510) n = 510;
    const bf16* ap = z + ((size_t)b * T + 16 * n) * ZLD + (kv ? Z_VC : Z_KC) + g * 64 + 8 * h;
    const bf16* bp = w1t + (size_t)(ut * 32 + r) * 2048 + 8 * h;
    f32x16 acc; ZERO16(acc);
#pragma unroll 8
    for (int kk = 0; kk < 64; ++kk) {
        const int ks = 64 * kh + kk, k0 = 16 * ks, ti = k0 >> 6, d = k0 & 63;
        const bf16x8 a = *(const bf16x8*)(ap + (size_t)ti * ZLD + d);
        const bf16x8 bb = *(const bf16x8*)(bp + k0);
        acc = MFMA32(a, bb, acc);
    }
    constexpr int HROW = 272, PSTR = 129, HID_OFF = 2 * 32 * PSTR * 4;
    LAS float* ps = (LAS float*)lds;
    __syncthreads();
#pragma unroll
    for (int i = 0; i < 16; ++i) ps[(kh * 32 + crow(i, h)) * PSTR + ut * 32 + r] = acc[i];
    __syncthreads();
    { const int u = tid & 127, rq = tid >> 7; float bias = 0.f;
#pragma unroll
      for (int c = 0; c < 8; ++c) bias += bias1p[(kv * 8 + c) * 128 + u];
#pragma unroll
      for (int i = 0; i < 8; ++i) { const int rowl = rq * 8 + i; const float v = ps[rowl * PSTR + u] + ps[(32 + rowl) * PSTR + u] + bias;
          *(LAS bf16*)(lds + HID_OFF + rowl * HROW + u * 2) = (bf16)f2bf(gelu_tanh(v)); } }
    __syncthreads();
    if (wave < 2) {
        const int ot = wave;
        f32x16 c2; ZERO16(c2);
#pragma unroll
        for (int ks = 0; ks < 8; ++ks) {
            const bf16x8 a = *(const LAS bf16x8*)(lds + HID_OFF + r * HROW + (16 * ks + 8 * h) * 2);
            const bf16x8 bb = *(const bf16x8*)(w2t + (size_t)(ot * 32 + r) * 128 + 16 * ks + 8 * h);
            c2 = MFMA32(a, bb, c2);
        }
#pragma unroll
        for (int i = 0; i < 16; ++i) { const int R = R0 + crow(i, h); const bool dead = (R & 511) == 511;
            outp[(size_t)R * 64 + ot * 32 + r] = dead ? (bf16)0 : (bf16)f2bf(c2[i]); }
    }
    __syncthreads();
}

constexpr int DS_S = 0, DS_SEL = 65536, DS_P = DS_SEL + 8 * 1024, DS_DMY = DS_P + 8 * 4096, DSA_LDS_END = DS_DMY + 8 * 256;
DI float relu_i(float x) { const int b = __builtin_bit_cast(int, x); return __builtin_bit_cast(float, b > 0 ? b : 0); }
DI unsigned orderkey(float s) { const unsigned u = __builtin_bit_cast(unsigned, s); return (u & 0x80000000u) ? ~u : (u | 0x80000000u); }
#define DPP_I(v, ctrl) __builtin_amdgcn_update_dpp(0, (v), (ctrl), 0xf, 0xf, false)
DI int row16_sum(int c) { c += DPP_I(c, 0x128); c += DPP_I(c, 0x124); c += DPP_I(c, 0x122); c += DPP_I(c, 0x121); return c; }
DI int wave_sum_i(int c) { c = row16_sum(c); return __builtin_amdgcn_readlane(c, 0) + __builtin_amdgcn_readlane(c, 16) + __builtin_amdgcn_readlane(c, 32) + __builtin_amdgcn_readlane(c, 48); }
#define DPP_F(v, ctrl) __builtin_bit_cast(float, DPP_I(__builtin_bit_cast(int, (v)), (ctrl)))
DI float row16_max(float v) { v = fmaxf(v, DPP_F(v, 0x128)); v = fmaxf(v, DPP_F(v, 0x124)); v = fmaxf(v, DPP_F(v, 0x122)); v = fmaxf(v, DPP_F(v, 0x121)); return v; }
DI float row16_sumf(float v) { v += DPP_F(v, 0x128); v += DPP_F(v, 0x124); v += DPP_F(v, 0x122); v += DPP_F(v, 0x121); return v; }
DI float oct_sumf(float v) {
    v += __builtin_bit_cast(float, DPP_I(__builtin_bit_cast(int, v), 0xB1));
    v += __builtin_bit_cast(float, DPP_I(__builtin_bit_cast(int, v), 0x4E));
    v += __builtin_bit_cast(float, DPP_I(__builtin_bit_cast(int, v), 0x141));
    return v; }
DI unsigned umin_(unsigned a, unsigned b) { return a < b ? a : b; }
DI unsigned umax_(unsigned a, unsigned b) { return a > b ? a : b; }
#define DPP_U(v, ctrl) ((unsigned)DPP_I((int)(v), (ctrl)))
DI unsigned wave_minu(unsigned v) { v = umin_(v, DPP_U(v, 0x128)); v = umin_(v, DPP_U(v, 0x124)); v = umin_(v, DPP_U(v, 0x122)); v = umin_(v, DPP_U(v, 0x121));
    return umin_(umin_((unsigned)__builtin_amdgcn_readlane((int)v, 0), (unsigned)__builtin_amdgcn_readlane((int)v, 16)), umin_((unsigned)__builtin_amdgcn_readlane((int)v, 32), (unsigned)__builtin_amdgcn_readlane((int)v, 48))); }
DI unsigned wave_maxu(unsigned v) { v = umax_(v, DPP_U(v, 0x128)); v = umax_(v, DPP_U(v, 0x124)); v = umax_(v, DPP_U(v, 0x122)); v = umax_(v, DPP_U(v, 0x121));
    return umax_(umax_((unsigned)__builtin_amdgcn_readlane((int)v, 0), (unsigned)__builtin_amdgcn_readlane((int)v, 16)), umax_((unsigned)__builtin_amdgcn_readlane((int)v, 32), (unsigned)__builtin_amdgcn_readlane((int)v, 48))); }
template <int NE>
DI void dsa_select(const unsigned (&ek)[NE], const int (&ei)[NE], unsigned& Tprev, LAS unsigned* selk, LAS int* selw, LAS unsigned* dmy, int& nsel, int lane, int nvalid) {
    unsigned L = Tprev, Kmax;
    { unsigned gm = 0u;
      if constexpr (NE == 36) {
          unsigned g4[4];
#pragma unroll
          for (int q = 0; q < 4; ++q) { unsigned g = ek[9 * q];
#pragma unroll
              for (int i = 1; i < 9; ++i) g = umax_(g, ek[9 * q + i]);
              g4[q] = g; }
          gm = umax_(umax_(g4[0], g4[1]), umax_(g4[2], g4[3]));
          const unsigned L2 = wave_minu(umin_(umin_(g4[0], g4[1]), umin_(g4[2], g4[3])));
          if (L2 > L) L = L2;
      } else {
#pragma unroll
          for (int i = 0; i < NE; ++i) gm = umax_(gm, ek[i]);
      }
      Kmax = wave_maxu(gm); }
    unsigned Tv = 0u; bool exact = false;
    int cHi = 0, cLo = nvalid, cBase = 0; bool compact = false; unsigned a0 = 0u, a1 = 0u, a2 = 0u, a3 = 0u;
    for (int bit = (nvalid > 256) ? 31 : -1; bit >= 0; --bit) {
        const unsigned cand = Tv | (1u << bit);
        if (cand <= L) { Tv = cand; continue; }
        if (cand > Kmax) continue;
        if constexpr (NE == 10) {
            if (bit >= 1) {
                const unsigned c1 = Tv | (1u << (bit - 1)), c3 = cand | (1u << (bit - 1));
                int l1 = 0, l2 = 0, l3 = 0, tmp; unsigned v1 = c1, v2 = cand, v3 = c3;
#define DSA_LT3(x) asm volatile("v_sub_co_u32_e32 %3, vcc, %4, %5\n\tv_addc_co_u32_e32 %0, vcc, 0, %0, vcc\n\tv_sub_co_u32_e32 %3, vcc, %4, %6\n\tv_addc_co_u32_e32 %1, vcc, 0, %1, vcc\n\t" \
                                "v_sub_co_u32_e32 %3, vcc, %4, %7\n\tv_addc_co_u32_e32 %2, vcc, 0, %2, vcc" : "+v"(l1), "+v"(l2), "+v"(l3), "=&v"(tmp) : "v"(x), "v"(v1), "v"(v2), "v"(v3) : "vcc");
#pragma unroll
                for (int i = 0; i < NE; ++i) { DSA_LT3(ek[i]) }
#undef DSA_LT3
                const int pk = wave_sum_i(l1 | (l2 << 10) | (l3 << 20));
                const int n1 = 64 * NE - (pk & 1023), n2 = 64 * NE - ((pk >> 10) & 1023), n3 = 64 * NE - (pk >> 20);
                int nsel_ = 0;
                if (n3 >= 256) { Tv = c3; nsel_ = n3; } else if (n2 >= 256) { Tv = cand; nsel_ = n2; } else if (n1 >= 256) { Tv = c1; nsel_ = n1; }
                --bit;
                if (nsel_ == 256) { exact = true; break; }
                continue;
            }
        }
        int tot;
        if (compact) {
            tot = cBase + __builtin_popcountll(__ballot(a0 >= cand)) + __builtin_popcountll(__ballot(a1 >= cand)) + __builtin_popcountll(__ballot(a2 >= cand)) + __builtin_popcountll(__ballot(a3 >= cand));
        } else {
            int lt0 = 0, lt1 = 0, tmp; unsigned cv = cand;
#define DSA_LT(acc, x) asm volatile("v_sub_co_u32_e32 %1, vcc, %2, %3\n\tv_addc_co_u32_e32 %0, vcc, 0, %0, vcc" : "+v"(acc), "=&v"(tmp) : "v"(x), "v"(cv) : "vcc");
#pragma unroll
            for (int i = 0; i < NE; i += 2) { DSA_LT(lt0, ek[i]) DSA_LT(lt1, ek[i + 1]) }
#undef DSA_LT
            tot = 64 * NE - wave_sum_i(lt0 + lt1);
        }
        if (tot >= 256) { Tv = cand; cLo = tot; if (tot == 256) { exact = true; break; } }
        else cHi = tot;
        if constexpr (NE == 36) {
            if (!compact && bit > 0 && cLo - cHi <= 256) {
                LAS unsigned* tk = selk + 256; const unsigned lo1 = Tv ? Tv : 1u, span = Tv + (1u << bit) - lo1; int ns = 0;
#pragma unroll
                for (int i = 0; i < NE; ++i) { const bool s_ = (ek[i] - lo1) < span; const unsigned long long mk_ = __ballot(s_);
                    const int pos_ = (int)__builtin_amdgcn_mbcnt_hi((unsigned)(mk_ >> 32), __builtin_amdgcn_mbcnt_lo((unsigned)mk_, (unsigned)ns));
                    *(s_ ? tk + pos_ : dmy) = ek[i]; ns += __builtin_popcountll(mk_); }
                { const unsigned r0 = tk[lane], r1 = tk[64 + lane], r2 = tk[128 + lane], r3 = tk[192 + lane];
                  a0 = (lane < ns) ? r0 : 0u; a1 = (64 + lane < ns) ? r1 : 0u; a2 = (128 + lane < ns) ? r2 : 0u; a3 = (192 + lane < ns) ? r3 : 0u; }
                compact = true; cBase = cHi;
            }
        }
    }
    int Xi = 0x7fffffff;
    if (!exact) {
        if (Tv == 0u) Tv = 1u;
        else {
            int cg = 0, ce = 0;
#pragma unroll
            for (int i = 0; i < NE; ++i) { cg += (ek[i] > Tv) ? 1 : 0; ce += (ek[i] == Tv) ? 1 : 0; }
            const int tg = wave_sum_i(cg), te = wave_sum_i(ce), need = 256 - tg;
            if (te != need) {
                int X = 0;
                for (int bit = 12; bit >= 0; --bit) {
                    const int cand = X | (1 << bit);
                    int cnt = 0;
#pragma unroll
                    for (int i = 0; i < NE; ++i) cnt += (ek[i] == Tv && ei[i] < cand) ? 1 : 0;
                    if (wave_sum_i(cnt) < need) X = cand;
                }
                Xi = X;
            }
        }
    }
    int run = 0;
#pragma unroll
    for (int i = 0; i < NE; ++i) { const bool s_ = (ek[i] > Tv) || (ek[i] == Tv && ei[i] <= Xi); const unsigned long long mk_ = __ballot(s_);
        const int pos_ = (int)__builtin_amdgcn_mbcnt_hi((unsigned)(mk_ >> 32), __builtin_amdgcn_mbcnt_lo((unsigned)mk_, (unsigned)run));
        const bool w_ = s_ && pos_ < 256;
        *(w_ ? selk + pos_ : dmy) = ek[i]; *(w_ ? selw + pos_ : (LAS int*)dmy) = ei[i]; run += __builtin_popcountll(mk_); }
    nsel = run > 256 ? 256 : run;
    Tprev = (run >= 256) ? Tv : 0u;
}
DI void dsa_item(int item, const bf16* z, bf16* O, LAS unsigned char* lds, int tid) {
    const int lane = tid & 63, w = __builtin_amdgcn_readfirstlane(tid >> 6);
    const int b = item & 1, tq0 = (item >> 1) * 8, tmax = tq0 + 7, tq = tq0 + w;
    const bf16* zb = z + (size_t)b * T * ZLD;
    const char* zbb = (const char*)zb;
    LAS unsigned* S = (LAS unsigned*)(lds + DS_S);
    LAS int* selw = (LAS int*)(lds + DS_SEL) + w * 256;
    LAS unsigned* selk = (LAS unsigned*)(lds + DS_P) + w * 1024;
    LAS float* pl = (LAS float*)(lds + DS_P) + w * 1024;
    LAS unsigned* dmy = (LAS unsigned*)(lds + DS_DMY) + w * 64 + lane;
    const int qq = lane >> 4, kq = lane >> 4, l15 = lane & 15;
    const int nchunk = (tmax >> 11) + 1;
    unsigned cs0 = 0u, cs1 = 0u, cs2 = 0u, cs3 = 0u; int ci0 = 0, ci1 = 0, ci2 = 0, ci3 = 0; int nsel = 0;
    unsigned Tprev = 0u;
    __syncthreads();
    bf16x8 af0, af1, ag0, ag1;
    { const int qa = l15 >> 2, ha = l15 & 3; const bf16* p = zb + (size_t)(tq0 + qa) * ZLD + Z_IQ + ha * 64 + 8 * kq;
      af0 = *(const bf16x8*)p; af1 = *(const bf16x8*)(p + 32); ag0 = *(const bf16x8*)(p + 4 * ZLD); ag1 = *(const bf16x8*)(p + 4 * ZLD + 32); }
#define DSA_KLOAD(b0, b1, c_, bt_) do { _Pragma("unroll") for (int i = 0; i < 8; ++i) { const int kl_ = (w + 8 * (8 * (bt_) + i)) * 16 + l15; \
        const unsigned ko_ = ((unsigned)((c_) * 2048 + kl_) * (unsigned)ZLD + (unsigned)(Z_IK + 8 * kq)) * 2u; b0[i] = *(const bf16x8*)(zbb + ko_); b1[i] = *(const bf16x8*)(zbb + ko_ + 64u); } } while (0)
#define DSA_KSCORE(b0, b1, c_, bt_) do { _Pragma("unroll") for (int i = 0; i < 8; ++i) { const int kl_ = (w + 8 * (8 * (bt_) + i)) * 16 + l15; \
        f32x4 cl = {0.f, 0.f, 0.f, 0.f}, ch = {0.f, 0.f, 0.f, 0.f}; \
        cl = MFMA16(af0, b0[i], cl); cl = MFMA16(af1, b1[i], cl); ch = MFMA16(ag0, b0[i], ch); ch = MFMA16(ag1, b1[i], ch); \
        const float sl = iwl0 * relu_i(cl[0]) + iwl1 * relu_i(cl[1]) + iwl2 * relu_i(cl[2]) + iwl3 * relu_i(cl[3]); \
        const float sh = iwh0 * relu_i(ch[0]) + iwh1 * relu_i(ch[1]) + iwh2 * relu_i(ch[2]) + iwh3 * relu_i(ch[3]); \
        S[qq * 2048 + kl_] = orderkey(sl); S[(4 + qq) * 2048 + kl_] = orderkey(sh); } } while (0)
    bf16x8 pb0[8], pb1[8];
    DSA_KLOAD(pb0, pb1, 0, 0);
#pragma unroll 1
    for (int c = 0; c < nchunk; ++c) {
        {
            float iwl0, iwl1, iwl2, iwl3, iwh0, iwh1, iwh2, iwh3;
            { const u32x2 a = *(const u32x2*)(zb + (size_t)(tq0 + qq) * ZLD + Z_IW), cc = *(const u32x2*)(zb + (size_t)(tq0 + 4 + qq) * ZLD + Z_IW);
              iwl0 = bflo(a.x); iwl1 = bfhi(a.x); iwl2 = bflo(a.y); iwl3 = bfhi(a.y); iwh0 = bflo(cc.x); iwh1 = bfhi(cc.x); iwh2 = bflo(cc.y); iwh3 = bfhi(cc.y); }
            bf16x8 qb0[8], qb1[8];
            const bool second = c * 2048 + 1024 <= tmax;
            if (second) { DSA_KLOAD(qb0, qb1, c, 1); DSA_KSCORE(pb0, pb1, c, 0); DSA_KSCORE(qb0, qb1, c, 1); }
            else DSA_KSCORE(pb0, pb1, c, 0);
        }
        if (c + 1 < nchunk) DSA_KLOAD(pb0, pb1, c + 1, 0);
        __syncthreads();
        unsigned sc[32];
        const int kbase = c * 2048 + lane * 4;
#pragma unroll
        for (int j = 0; j < 8; ++j) { const u32x4 v = *(const LAS u32x4*)(S + w * 2048 + j * 256 + lane * 4); const int key = kbase + j * 256;
            sc[j * 4 + 0] = (key + 0 <= tq) ? v.x : 0u; sc[j * 4 + 1] = (key + 1 <= tq) ? v.y : 0u;
            sc[j * 4 + 2] = (key + 2 <= tq) ? v.z : 0u; sc[j * 4 + 3] = (key + 3 <= tq) ? v.w : 0u; }
        __syncthreads();
        if (c * 2048 <= tq) {
            bool done = false;
            if (Tprev != 0u) {
                LAS unsigned* tk = selk + 256; LAS int* ti = (LAS int*)(selk + 640);
                int ns = 0;
#pragma unroll
                for (int i = 0; i < 32; ++i) { const bool s_ = sc[i] >= Tprev; const unsigned long long mk_ = __ballot(s_);
                    const int pos_ = (int)__builtin_amdgcn_mbcnt_hi((unsigned)(mk_ >> 32), __builtin_amdgcn_mbcnt_lo((unsigned)mk_, (unsigned)ns));
                    const bool w_ = s_ && pos_ < 384;
                    *(w_ ? tk + pos_ : dmy) = sc[i]; *(w_ ? ti + pos_ : (LAS int*)dmy) = kbase + (i >> 2) * 256 + (i & 3); ns += __builtin_popcountll(mk_); }
                if (ns <= 384) {
                    unsigned ek[10]; int ei[10];
                    ek[0] = cs0; ek[1] = cs1; ek[2] = cs2; ek[3] = cs3; ei[0] = ci0; ei[1] = ci1; ei[2] = ci2; ei[3] = ci3;
#pragma unroll
                    for (int j = 0; j < 6; ++j) { const int p_ = j * 64 + lane; const unsigned rk_ = tk[p_]; const int ri_ = ti[p_]; ek[4 + j] = (p_ < ns) ? rk_ : 0u; ei[4 + j] = (p_ < ns) ? ri_ : 0; }
                    dsa_select<10>(ek, ei, Tprev, selk, selw, dmy, nsel, lane, 640);
                    done = true;
                }
            }
            if (!done) {
                unsigned ek[36]; int ei[36];
                ek[0] = cs0; ek[1] = cs1; ek[2] = cs2; ek[3] = cs3; ei[0] = ci0; ei[1] = ci1; ei[2] = ci2; ei[3] = ci3;
#pragma unroll
                for (int i = 0; i < 32; ++i) { ek[4 + i] = sc[i]; ei[4 + i] = kbase + (i >> 2) * 256 + (i & 3); }
                dsa_select<36>(ek, ei, Tprev, selk, selw, dmy, nsel, lane, (c == 0) ? ((tq < 2047 ? tq : 2047) + 1) : 2304);
            }
            { const unsigned r0 = selk[lane], r1 = selk[64 + lane], r2 = selk[128 + lane], r3 = selk[192 + lane];
              cs0 = (lane < nsel) ? r0 : 0u; cs1 = (64 + lane < nsel) ? r1 : 0u; cs2 = (128 + lane < nsel) ? r2 : 0u; cs3 = (192 + lane < nsel) ? r3 : 0u; }
            ci0 = selw[lane]; ci1 = selw[64 + lane]; ci2 = selw[128 + lane]; ci3 = selw[192 + lane];
        }
    }
    {
        const float cs = 0.125f * LOG2E;
        bf16x8 qa0 = {0, 0, 0, 0, 0, 0, 0, 0}, qa1 = {0, 0, 0, 0, 0, 0, 0, 0};
        if (l15 < 4) { const bf16* p = zb + (size_t)tq * ZLD + Z_AQ + l15 * 64 + 8 * kq; qa0 = *(const bf16x8*)p; qa1 = *(const bf16x8*)(p + 32); }
        float mx0 = NEG_INF, mx1 = NEG_INF, mx2 = NEG_INF, mx3 = NEG_INF;
        const int kg = lane & 7, dc = lane >> 3;
#define DSA_AKLOAD(k0, k1, tg_) do { _Pragma("unroll") for (int t4 = 0; t4 < 4; ++t4) { const int jl_ = ((tg_) * 4 + t4) * 16 + l15; const int kraw_ = selw[jl_]; const int kidx_ = (jl_ < nsel) ? kraw_ : 0; \
        const unsigned ko_ = ((unsigned)kidx_ * (unsigned)ZLD + (unsigned)(Z_AK + 8 * kq)) * 2u; k0[t4] = *(const bf16x8*)(zbb + ko_); k1[t4] = *(const bf16x8*)(zbb + ko_ + 64u); } } while (0)
#define DSA_AKSCORE(k0, k1, tg_) do { _Pragma("unroll") for (int t4 = 0; t4 < 4; ++t4) { f32x4 c_ = {0.f, 0.f, 0.f, 0.f}; c_ = MFMA16(qa0, k0[t4], c_); c_ = MFMA16(qa1, k1[t4], c_); \
        const int jl_ = ((tg_) * 4 + t4) * 16 + l15; const bool valid_ = jl_ < nsel; \
        f32x4 sv_; sv_.x = valid_ ? c_[0] * cs : NEG_INF; sv_.y = valid_ ? c_[1] * cs : NEG_INF; sv_.z = valid_ ? c_[2] * cs : NEG_INF; sv_.w = valid_ ? c_[3] * cs : NEG_INF; \
        if (lane < 16) { *(LAS f32x4*)(pl + jl_ * 4) = sv_; mx0 = fmaxf(mx0, sv_.x); mx1 = fmaxf(mx1, sv_.y); mx2 = fmaxf(mx2, sv_.z); mx3 = fmaxf(mx3, sv_.w); } } } while (0)
#define DSA_VLOAD(vv, j0_) do { _Pragma("unroll") for (int i = 0; i < 8; ++i) { const int jl_ = (j0_) + 8 * i + kg; const int kraw_ = selw[jl_]; const int kidx_ = (jl_ < nsel) ? kraw_ : 0; \
        vv[i] = *(const u32x4*)(zbb + ((unsigned)kidx_ * (unsigned)ZLD + (unsigned)(Z_AV + 8 * dc)) * 2u); } } while (0)
        u32x4 va[8], vb[8];
        {
            bf16x8 ka0[4], ka1[4], kb0[4], kb1[4];
            DSA_AKLOAD(ka0, ka1, 0);
            if (64 < nsel) DSA_AKLOAD(kb0, kb1, 1);
            DSA_AKSCORE(ka0, ka1, 0);
            if (128 < nsel) DSA_AKLOAD(ka0, ka1, 2);
            if (64 < nsel) DSA_AKSCORE(kb0, kb1, 1);
            if (192 < nsel) DSA_AKLOAD(kb0, kb1, 3);
            DSA_VLOAD(va, 0);
            if (128 < nsel) DSA_AKSCORE(ka0, ka1, 2);
            if (64 < nsel) DSA_VLOAD(vb, 64);
            if (192 < nsel) DSA_AKSCORE(kb0, kb1, 3);
        }
        float mh[4], lh[4];
        mh[0] = fmaxf(__builtin_bit_cast(float, __builtin_amdgcn_readlane(__builtin_bit_cast(int, row16_max(mx0)), 0)), -1e30f);
        mh[1] = fmaxf(__builtin_bit_cast(float, __builtin_amdgcn_readlane(__builtin_bit_cast(int, row16_max(mx1)), 0)), -1e30f);
        mh[2] = fmaxf(__builtin_bit_cast(float, __builtin_amdgcn_readlane(__builtin_bit_cast(int, row16_max(mx2)), 0)), -1e30f);
        mh[3] = fmaxf(__builtin_bit_cast(float, __builtin_amdgcn_readlane(__builtin_bit_cast(int, row16_max(mx3)), 0)), -1e30f);
        LAS unsigned char* vtile = lds + DS_S + w * 8192;
        LAS unsigned short* pbl = (LAS unsigned short*)(vtile + 32 * VROWB);
        { float l0 = 0.f, l1 = 0.f, l2 = 0.f, l3 = 0.f;
#pragma unroll
          for (int rr = 0; rr < 4; ++rr) { const int jl = rr * 64 + lane; f32x4 sv = {0.f, 0.f, 0.f, 0.f};
              if (jl < nsel) { sv = *(const LAS f32x4*)(pl + jl * 4);
                  sv.x = ex2(sv.x - mh[0]); sv.y = ex2(sv.y - mh[1]); sv.z = ex2(sv.z - mh[2]); sv.w = ex2(sv.w - mh[3]);
                  l0 += sv.x; l1 += sv.y; l2 += sv.z; l3 += sv.w; }
              const unsigned p01 = pk2(sv.x, sv.y), p23 = pk2(sv.z, sv.w);
              pbl[jl] = (unsigned short)p01; pbl[256 + jl] = (unsigned short)(p01 >> 16); pbl[512 + jl] = (unsigned short)p23; pbl[768 + jl] = (unsigned short)(p23 >> 16); }
          l0 = row16_sumf(l0); l1 = row16_sumf(l1); l2 = row16_sumf(l2); l3 = row16_sumf(l3);
#define RL4(v) (__builtin_bit_cast(float, __builtin_amdgcn_readlane(__builtin_bit_cast(int, v), 0)) + __builtin_bit_cast(float, __builtin_amdgcn_readlane(__builtin_bit_cast(int, v), 16)) + \
                __builtin_bit_cast(float, __builtin_amdgcn_readlane(__builtin_bit_cast(int, v), 32)) + __builtin_bit_cast(float, __builtin_amdgcn_readlane(__builtin_bit_cast(int, v), 48)))
          lh[0] = RL4(l0); lh[1] = RL4(l1); lh[2] = RL4(l2); lh[3] = RL4(l3);
#undef RL4
        }
        f32x4 oacc[4];
#pragma unroll
        for (int dt = 0; dt < 4; ++dt) oacc[dt] = (f32x4){0.f, 0.f, 0.f, 0.f};
        const int pn = l15 < 4 ? l15 : 3, qd = l15 >> 2, pd = lane & 3;
#define DSA_PVHALF(vv, i0_, jb_) do { \
        _Pragma("unroll") for (int i = 0; i < 4; ++i) *(LAS u32x4*)(vtile + (8 * i + kg) * VROWB + dc * 16) = vv[(i0_) + i]; \
        u32x2 plo_ = *(const LAS u32x2*)(pbl + pn * 256 + (jb_) + 4 * kq), phi_ = *(const LAS u32x2*)(pbl + pn * 256 + (jb_) + 16 + 4 * kq); \
        u32x4 pw_; pw_.x = l15 < 4 ? plo_.x : 0u; pw_.y = l15 < 4 ? plo_.y : 0u; pw_.z = l15 < 4 ? phi_.x : 0u; pw_.w = l15 < 4 ? phi_.y : 0u; \
        const bf16x8 pf_ = __builtin_bit_cast(bf16x8, pw_); \
        _Pragma("unroll") for (int dt = 0; dt < 4; ++dt) { \
            const s16x4 lo_ = vtr(vtile + (4 * kq + qd) * VROWB + (16 * dt + 4 * pd) * 2), hi_ = vtr(vtile + (16 + 4 * kq + qd) * VROWB + (16 * dt + 4 * pd) * 2); \
            const bf16x8 vf_ = __builtin_shufflevector(lo_, hi_, 0, 1, 2, 3, 4, 5, 6, 7); \
            oacc[dt] = MFMA16(vf_, pf_, oacc[dt]); } } while (0)
#define DSA_VACC(vv, j0_) do { DSA_PVHALF(vv, 0, (j0_)); DSA_PVHALF(vv, 4, (j0_) + 32); } while (0)
        DSA_VACC(va, 0);
        if (128 < nsel) DSA_VLOAD(va, 128);
        if (64 < nsel) DSA_VACC(vb, 64);
        if (192 < nsel) DSA_VLOAD(vb, 192);
        if (128 < nsel) DSA_VACC(va, 128);
        if (192 < nsel) DSA_VACC(vb, 192);
        if (l15 < 4) {
            const float lsum = l15 == 0 ? lh[0] : l15 == 1 ? lh[1] : l15 == 2 ? lh[2] : lh[3];
            const float f = lsum > 0.f ? 1.f / lsum : 0.f;
            int l15o = l15; asm volatile("" : "+v"(l15o));
            bf16* op = O + ((size_t)b * T + tq) * 256 + l15o * 64 + 4 * kq;
#pragma unroll
            for (int dt = 0; dt < 4; ++dt) { u32x2 o; o.x = pk2(oacc[dt][0] * f, oacc[dt][1] * f); o.y = pk2(oacc[dt][2] * f, oacc[dt][3] * f); *(u32x2*)(op + 16 * dt) = o; }
        }
    }
    __syncthreads();
}


#ifndef N_LAUNCH_SPLIT
#define N_LAUNCH_SPLIT 0
#endif
constexpr int PH_PER_LAYER = 10, PH_TOTAL = DEPTH * PH_PER_LAYER + 1;

__global__ void __launch_bounds__(NWAVES * 64, 2) fwd_kernel(Args args) {
    extern __shared__ __attribute__((aligned(16))) unsigned char lds_raw[];
    LAS unsigned char* lds = (LAS unsigned char*)lds_raw;
    volatile LAS unsigned* MISC = (volatile LAS unsigned*)(lds + MISC_OFF);
#define G ((int)gridDim.x)
#define bx ((int)blockIdx.x)
#define gw ((int)blockIdx.x * NWAVES + wave)
#define NGW ((int)gridDim.x * NWAVES)
    for (int u = threadIdx.x; u < (LDS_BYTES - LDSCTL_OFF) / 4; u += NWAVES * 64) ((LAS unsigned*)(lds + LDSCTL_OFF))[u] = 0u;
    __syncthreads();
    XcdBarrier bar; bar.bar = (unsigned*)(args.ws + WS_CTL) + CW_BAR; bar.x = 0; bar.st = nullptr;
    if (!N_LAUNCH_SPLIT) bar = xcd_barrier_post((unsigned*)(args.ws + WS_CTL) + CW_BAR, MISC + 8);

#define x_in (args.in[0])
#define out (args.out)
#define cosT ((float*)(args.ws + WS_COS))
#define sinT ((float*)(args.ws + WS_SIN))
#define kmean ((float*)(args.ws + WS_KMEAN))
#define kcmp ((bf16*)(args.ws + WS_KCMP))
#define vcmp ((bf16*)(args.ws + WS_VCMP))
#define bias1p ((float*)(args.ws + WS_BIAS1))
#define Wb ((bf16*)(args.ws + WS_W))
#define H ((bf16*)(args.ws + WS_H))
#define Z ((bf16*)(args.ws + WS_Z))
#define HID ((bf16*)(args.ws + WS_HID))
#define GB ((bf16*)(args.ws + WS_GB))
#define MF ((float*)(args.ws + WS_MF))
#define XB ((bf16*)(args.ws + WS_XB))
#define SS ((float*)(args.ws + WS_SS))
#define RLP ((G == 256) ? (const LAS float*)(lds + LDSCTL_OFF + 2048) : (const LAS float*)nullptr)
#define RINV_FILL() do { if (G == 256) { LAS float* RL_ = (LAS float*)(lds + LDSCTL_OFF + 2048); const int rb_ = (bx & 7) * 2048; \
        for (int rr_ = tid; rr_ < 2048; rr_ += NWAVES * 64) { const f32x4* p_ = (const f32x4*)(SS + (size_t)(rb_ + rr_) * 16); const f32x4 s4_ = (p_[0] + p_[1]) + (p_[2] + p_[3]); \
            RL_[rr_] = __builtin_amdgcn_rsqf(((s4_[0] + s4_[1]) + (s4_[2] + s4_[3])) * (1.f / D) + NORM_EPS); } \
        __syncthreads(); } } while (0)
#define CQN ((bf16*)(args.ws + WS_CQN))
#define OA ((bf16*)(args.ws + WS_O))
#define OB ((bf16*)(args.ws + WS_O) + (size_t)M * 256)
#define OC ((bf16*)(args.ws + WS_O) + (size_t)M * 512)
    const int lo = args.ph_lo, hi = args.ph_hi;
    int seq = 0;
#define PH_ON (seq >= lo && seq < hi)
#define PH_END do { if (PH_ON && seq + 1 < hi) xcd_barrier(bar); ++seq; } while (0)

    if (lo == 0) rope_table(cosT, sinT, bx * (NWAVES * 64) + (int)threadIdx.x, G * NWAVES * 64);
#pragma unroll 1
    for (int l = 0; l < DEPTH; ++l) {
#pragma unroll 1
        for (int f = 0; f < 2; ++f) {
            if (f == 0) {
                if (PH_ON) { int tid = threadIdx.x; asm volatile("" : "+v"(tid)); const int lane = tid & 63, wave = __builtin_amdgcn_readfirstlane(tid >> 6); (void)lane; (void)wave;
                    convert_weights(args, l, Wb, bias1p, lds, gw, NGW, wave, lane, tid);
                    if (l == 0) { int m = gw; for (; m + 3 * NGW < M; m += 4 * NGW) xb_init_rows4(x_in, XB, SS, (size_t)m, (size_t)NGW, lane); for (; m < M; m += NGW) xb_init_rows4(x_in, XB, SS, (size_t)m, 0, lane); }
                }
                PH_END;
            }
            if (PH_ON) { int tid = threadIdx.x; asm volatile("" : "+v"(tid)); const int lane = tid & 63, wave = __builtin_amdgcn_readfirstlane(tid >> 6); (void)lane; (void)wave;
                pg8::Gemm g{XB, Wb + (f ? W_UP2 : W_UP1), M, 2 * DFF, D}; pg8::StaticOrder S; S.init(M, 2 * DFF, G, bx);
                RINV_FILL();
                pg8::EpiSwiGLU E{HID, DFF, SS, RLP};
                pg8::gemm_phase<pg8::EpiSwiGLU, pg8::StaticOrder, true, true>(lds, g, S, E);
            }
            PH_END;
            if (PH_ON) { int tid = threadIdx.x; asm volatile("" : "+v"(tid)); const int lane = tid & 63, wave = __builtin_amdgcn_readfirstlane(tid >> 6); (void)lane; (void)wave;
                pg8::Gemm g{HID, Wb + (f ? W_DN2 : W_DN1), M, D, DFF}; pg8::StaticOrder S; S.init(M, D, G, bx);
                pg8::EpiResid E{XB, XB, 0.5f, SS};
                pg8::gemm_phase<pg8::EpiResid, pg8::StaticOrder, true, true>(lds, g, S, E);
            }
            PH_END;
            if (f == 0) {
                if (PH_ON) { int tid = threadIdx.x; asm volatile("" : "+v"(tid)); const int lane = tid & 63, wave = __builtin_amdgcn_readfirstlane(tid >> 6); (void)lane; (void)wave;
                    pg8::Gemm g{XB, Wb + W_IN, M, ZLD, D}; pg8::StaticOrder S; S.init(M, ZLD, G, bx);
                    RINV_FILL();
                    pg8::EpiZin E{Z, CQN, cosT, sinT, SS, RLP};
                    pg8::gemm_phase<pg8::EpiZin, pg8::StaticOrder, true, true>(lds, g, S, E);
                }
                PH_END;
                if (PH_ON) { int tid = threadIdx.x; asm volatile("" : "+v"(tid)); const int lane = tid & 63, wave = __builtin_amdgcn_readfirstlane(tid >> 6); (void)lane; (void)wave;
                    constexpr int N_CMP = 128, N_KM = 64, N_DSA = M / 8, N_IT = N_CMP + N_KM + N_DSA;
                    {
                        const bool perx = (G == 256);
                        unsigned* qctr = (unsigned*)(args.ws + WS_CTL) + 8192 + (l * 8 + (perx ? (bx & 7) : 0)) * 16;
                        const int qlim = perx ? N_IT / 8 : N_IT;
                        for (;;) {
                            __syncthreads();
                            if (tid == 0) MISC[16] = atomicAdd(qctr, 1u);
                            __syncthreads();
                            const int U = (int)MISC[16];
                            if (U >= qlim) break;
                            const int x = perx ? (bx & 7) : U / (N_IT / 8), uu = perx ? U : U % (N_IT / 8);
                            const int it = (uu < (N_CMP + N_KM) / 8) ? x + 8 * uu : N_CMP + N_KM + x + 8 * (N_DSA / 8 - 1 - (uu - (N_CMP + N_KM) / 8));
                            if (it < N_CMP) compress_item(it, Z, Wb, bias1p, kcmp, vcmp, lds, tid);
                            else if (it < N_CMP + N_KM) kmean_item(it - N_CMP, Z, kmean, lds, tid);
                            else dsa_item(it - N_CMP - N_KM, Z, OA, lds, tid);
                        }
                    }
                }
                PH_END;
                if (PH_ON) { int tid = threadIdx.x; asm volatile("" : "+v"(tid)); const int lane = tid & 63, wave = __builtin_amdgcn_readfirstlane(tid >> 6); (void)lane; (void)wave;
                    LAS unsigned char* wl = lds + wave * NSA_WLDS;
                    {
                        const bool perx = (G == 256);
                        unsigned* qbase = (unsigned*)(args.ws + WS_CTL) + 9216 + l * 8 * 16;
                        unsigned* qctr = qbase + (perx ? (bx & 7) : 0) * 16;
                        const int qlim = perx ? 96 : 768;
                        bool own_done = false;
                        for (;;) {
                            __syncthreads();
                            if (tid == 0) {
                                unsigned u_ = 0xffffffffu, q_ = (unsigned)(bx & 7);
                                if (!own_done) { u_ = atomicAdd(qctr, 1u); if (u_ >= (unsigned)qlim) own_done = true; }
                                if (own_done && perx) {
                                    unsigned c_[8];
#pragma unroll
                                    for (int q = 0; q < 8; ++q) c_[q] = __hip_atomic_load(qbase + q * 16, __ATOMIC_RELAXED, __HIP_MEMORY_SCOPE_AGENT);
                                    unsigned best = 0u; q_ = 8u;
#pragma unroll
                                    for (int q = 0; q < 8; ++q) { const unsigned rem = c_[q] < 96u ? 96u - c_[q] : 0u; if (rem > best) { best = rem; q_ = (unsigned)q; } }
                                    u_ = (q_ < 8u) ? atomicAdd(qbase + q_ * 16, 1u) : 0xffffffffu;
                                }
                                MISC[16] = u_; MISC[17] = q_;
                            }
                            __syncthreads();
                            const int U = (int)MISC[16]; const int qsel = (int)MISC[17];
                            if (perx) { if (qsel >= 8) break; if ((unsigned)U >= 96u) continue; }
                            else if (U >= qlim || U < 0) break;
                            const int x = perx ? qsel : U / 96, uu = perx ? U : U % 96;
                            if (uu < 64) { const int par = x >> 2, bg = x & 3;
                                const int tile = (uu < 32) ? 127 - par - 2 * uu : 62 + par - 2 * (uu - 32);
                                nsa_block_unit(bg >> 1, bg & 1, 64 * tile, Z, CQN, kcmp, vcmp, OC, lds, tid); }
                            else { const int own = 31 - (uu - 64);
                                moba_block_item(x >> 2, x & 3, own, own * 8 + x, Z, kmean, OB, (float*)(args.ws + WS_PART), lds, tid); }
                        }
                    }
                }
                PH_END;
                for (int c = 0; c < 6; ++c) {
                    if (PH_ON) { int tid = threadIdx.x; asm volatile("" : "+v"(tid)); (void)tid;
                        if (c == 0) RINV_FILL();
                        const int i = c >> 1;
                        pg8::Gemm g; g.M = M; g.N = D;
                        if ((c & 1) == 0) { g.A = XB; g.Bt = Wb + W_G + (size_t)i * D * D; g.K = D; }
                        else if (i == 0) { g.A = OA; g.Bt = Wb + W_A; g.K = 256; }
                        else if (i == 1) { g.A = OB; g.Bt = Wb + W_B; g.K = 256; }
                        else { g.A = OC; g.Bt = Wb + W_C; g.K = 512; }
                        pg8::StaticOrder S; S.init(M, D, G, bx);
                        if ((c & 1) == 0) { pg8::EpiMerge<0> E{GB, MF, SS, RLP}; pg8::gemm_phase<pg8::EpiMerge<0>, pg8::StaticOrder, true, true>(lds, g, S, E); }
                        else if (i == 0) { pg8::EpiMerge<1> E{GB, MF, SS, RLP}; pg8::gemm_phase<pg8::EpiMerge<1>, pg8::StaticOrder, true, true>(lds, g, S, E); }
                        else if (i == 1) { pg8::EpiMerge<2> E{GB, MF, SS, RLP}; pg8::gemm_phase<pg8::EpiMerge<2>, pg8::StaticOrder, true, true>(lds, g, S, E); }
                        else { pg8::EpiMerge<3> E{GB, MF, SS, RLP}; pg8::gemm_phase<pg8::EpiMerge<3>, pg8::StaticOrder, true, true>(lds, g, S, E); }
                        VM_WAIT(); __syncthreads();
                    }
                }
                PH_END;
                if (PH_ON) { int tid = threadIdx.x; asm volatile("" : "+v"(tid)); const int lane = tid & 63, wave = __builtin_amdgcn_readfirstlane(tid >> 6); (void)lane; (void)wave;
                    pg8::Gemm g{GB, Wb + W_O, M, D, D}; pg8::StaticOrder S; S.init(M, D, G, bx);
                    pg8::EpiResid E{XB, XB, 1.0f, SS};
                    pg8::gemm_phase<pg8::EpiResid, pg8::StaticOrder, true, true>(lds, g, S, E);
                }
                PH_END;
            }
        }
    }
    if (PH_ON) { int tid = threadIdx.x; asm volatile("" : "+v"(tid)); const int lane = tid & 63, wave = __builtin_amdgcn_readfirstlane(tid >> 6); (void)lane; (void)wave; for (int m = gw; m < M; m += NGW) rms_row_b2f(XB + (size_t)m * D, args.in[21], out + (size_t)m * D, lane); }
#undef PH_ON
#undef PH_END
#undef x_in
#undef out
#undef cosT
#undef sinT
#undef kmean
#undef kcmp
#undef vcmp
#undef bias1p
#undef Wb
#undef H
#undef Z
#undef HID
#undef GB
#undef MF
#undef CQN
#undef OA
#undef OB
#undef OC
#undef gw
#undef NGW
#undef G
#undef bx
}

extern "C" void kernel_launch(void* const* d_in, const int* in_sizes, int n_in, void* d_out, int out_size, void* d_ws, size_t ws_size, hipStream_t stream) {
    static int grid = 0;
    if (grid == 0) {
        if (n_in != 22 || out_size != M * D || ws_size < WS_END) { fprintf(stderr, "kernel_launch: unexpected shapes (n_in %d, out %d, ws %zu, need %zu)\n", n_in, out_size, ws_size, (size_t)WS_END); grid = -1; return; }
        int dev = 0, cus = 0, per_cu = 0;
        if (hipGetDevice(&dev) != hipSuccess || hipDeviceGetAttribute(&cus, hipDeviceAttributeMultiprocessorCount, dev) != hipSuccess) { grid = -1; return; }
        if (hipFuncSetAttribute((const void*)fwd_kernel, hipFuncAttributeMaxDynamicSharedMemorySize, LDS_BYTES) != hipSuccess) { fprintf(stderr, "kernel_launch: hipFuncSetAttribute failed\n"); grid = -1; return; }
        if (hipOccupancyMaxActiveBlocksPerMultiprocessor(&per_cu, (const void*)fwd_kernel, NWAVES * 64, LDS_BYTES) != hipSuccess || per_cu < 1)
            fprintf(stderr, "kernel_launch: occupancy query reports %d workgroups per CU\n", per_cu);
        (void)hipGetLastError();
        grid = cus;
    }
    if (grid < 0) return;
    if (hipMemsetAsync((char*)d_ws + WS_CTL, 0, CTL_ZERO_BYTES, stream) != hipSuccess) return;
    Args a{};
    for (int i = 0; i < 22; ++i) a.in[i] = (const float*)d_in[i];
    a.out = (float*)d_out; a.ws = (unsigned char*)d_ws;
#if N_LAUNCH_SPLIT
    for (int p = 0; p < PH_TOTAL; ++p) { a.ph_lo = p; a.ph_hi = p + 1; hipLaunchKernelGGL(fwd_kernel, dim3(grid), dim3(NWAVES * 64), LDS_BYTES, stream, a); }
#else
    a.ph_lo = 0; a.ph_hi = PH_TOTAL;
    hipLaunchKernelGGL(fwd_kernel, dim3(grid), dim3(NWAVES * 64), LDS_BYTES, stream, a);
#endif
}
```

```cpp
#include <hip/hip_runtime.h>
#include <cstdio>
#include <cstdint>

constexpr int BATCH = 2, T = 8192, D = 1024, DEPTH = 4, DFF = 2816, M = BATCH * T;
constexpr int IN_COLS = 5852;
constexpr float NORM_EPS = 1e-6f;
constexpr int ZLD = 2816;
constexpr int Z_AQ = 0, Z_AK = 256, Z_IQ = 320, Z_IK = 576, Z_BQ = 640, Z_BK = 896, Z_CQ = 1152, Z_KS = 1664, Z_KW = 1792, Z_ROPE_END = 1920;
constexpr int Z_AV = 1920, Z_BV = 1984, Z_KC = 2240, Z_VC = 2368, Z_VS = 2496, Z_VW = 2624, Z_IW = 2752, Z_CG = 2756, Z_END = 2780;
constexpr int O_A = 0, O_B = 256, O_C = 512;

namespace pg8 {
#define PG8_LAS __attribute__((address_space(3)))
typedef unsigned short bf16_t;
typedef short bf16x8 __attribute__((ext_vector_type(8)));
typedef float f32x4 __attribute__((ext_vector_type(4)));
typedef unsigned u32x4 __attribute__((ext_vector_type(4)));
constexpr int BM = 256, BK = 64, HALF = 128, HTB = HALF * BK * 2  , STAGE_BYTES = 8 * HTB, NXCD = 8, WGM = 8;

__host__ __device__ __forceinline__ int lds_byte(int r, int c) { const int st = (r >> 4) * 2 + (c >> 5), rr = r & 15, cc = c & 31, ob = rr * 64 + cc * 2; return st * 1024 + (ob ^ (((ob >> 9) & 1) << 5)); }
__host__ __device__ __forceinline__ void stage_rc(int b, int& R, int& C) { const int st = b / 1024, sb = b % 1024, swz = sb ^ (((sb >> 9) & 1) << 5); R = (st >> 1) * 16 + swz / 64; C = (st & 1) * 32 + (swz % 64) / 2; }
__host__ __device__ __forceinline__ int perm32(int rho) { const int n = rho >> 4, i = rho & 15; return 8 * (i >> 2) + 4 * n + (i & 3); }

struct Unit { int pm, pn; };
struct Gemm { const bf16_t* A; const bf16_t* Bt; int M, N, K; };

struct StaticOrder {
    int nM, nN, nwg, G, c;
    __host__ __device__ void init(int M, int N, int G_, int c_) { nM = M / BM; nN = N / BM; nwg = nM * nN; G = G_; c = c_; }
    __host__ __device__ bool next(int i, Unit& u) const {
        const long L = (long)i * G + c; if (L >= nwg) return false;
        int wgid = (int)L; { const int q = nwg / NXCD, r = nwg % NXCD, xcd = wgid % NXCD, off = wgid / NXCD; wgid = (xcd < r ? xcd * (q + 1) : r * (q + 1) + (xcd - r) * q) + off; }
        const int nig = WGM * nN, gid = wgid / nig, fm = gid * WGM, gsz = (nM - fm) < WGM ? (nM - fm) : WGM;
        u.pm = fm + ((wgid % nig) % gsz); u.pn = (wgid % nig) / gsz; return true;
    }
    __device__ __forceinline__ void a_ready(const Unit&) const {}
    __device__ __forceinline__ void done(const Unit&) const {}
};

typedef float f32x2_ __attribute__((ext_vector_type(2)));
typedef __bf16 bf16x2_ __attribute__((ext_vector_type(2)));
__device__ __forceinline__ unsigned cvt_pk_bf16(float lo, float hi) { f32x2_ v = {lo, hi}; bf16x2_ b = __builtin_convertvector(v, bf16x2_); return __builtin_bit_cast(unsigned, b); }
__device__ __forceinline__ float bf_lo(unsigned u) { return __builtin_bit_cast(float, u << 16); }
__device__ __forceinline__ float bf_hi(unsigned u) { return __builtin_bit_cast(float, u & 0xffff0000u); }
__device__ __forceinline__ float fast_sigmoid(float v) { return __builtin_amdgcn_rcpf(1.f + __builtin_amdgcn_exp2f(-1.4426950408889634f * v)); }
typedef unsigned u32x2 __attribute__((ext_vector_type(2)));

__device__ __forceinline__ void row_rinv8(const float* ss, const PG8_LAS float* rl, int row0, int fq, int lane, float (&rinv)[8]) {
    if (rl) {
#pragma unroll
        for (int ri = 0; ri < 8; ++ri) rinv[ri] = rl[(row0 + (ri >> 2) * HALF + (ri & 3) * 16) & 2047];
        return; }
    float mine[2];
#pragma unroll
    for (int t = 0; t < 2; ++t) { const int row = row0 + (fq >> 1) * HALF + (2 * (fq & 1) + t) * 16; const f32x4* p = (const f32x4*)(ss + (size_t)row * 16);
        const f32x4 s4 = (p[0] + p[1]) + (p[2] + p[3]); mine[t] = __builtin_amdgcn_rsqf(((s4[0] + s4[1]) + (s4[2] + s4[3])) * (1.f / D) + NORM_EPS); }
#pragma unroll
    for (int ri = 0; ri < 8; ++ri) rinv[ri] = __shfl(mine[ri & 1], (lane & 15) + 16 * (ri >> 1));
}
struct EpiSwiGLU {
    static constexpr bool PERM = true, AFTER_DRAIN = false;
    bf16_t* H; int ldh; const float* ss; const PG8_LAS float* rl;
    __device__ __forceinline__ void operator()(const f32x4 (&acc)[2][2][4][2], const Unit& u, int wr, int wc, int fr, int fq) const {
        const int row0 = u.pm * BM + wr * 64 + fr, col0 = u.pn * BM + wc * 32 + 8 * fq;
        float rinv[8]; row_rinv8(ss, rl, row0, fq, fq * 16 + fr, rinv);
#pragma unroll
        for (int ai = 0; ai < 2; ++ai)
#pragma unroll
            for (int m = 0; m < 4; ++m) { const unsigned rowb = (unsigned)(row0 + ai * HALF + m * 16) * (unsigned)ldh * 2u; const float ri = rinv[ai * 4 + m];
                u32x2 ob[2];
#pragma unroll
                for (int bj = 0; bj < 2; ++bj) { const f32x4 v0 = acc[ai][bj][m][0] * ri, v1 = acc[ai][bj][m][1] * ri;
                    const float h0 = v0[0] * fast_sigmoid(v0[0]) * v0[1], h1 = v0[2] * fast_sigmoid(v0[2]) * v0[3];
                    const float h2 = v1[0] * fast_sigmoid(v1[0]) * v1[1], h3 = v1[2] * fast_sigmoid(v1[2]) * v1[3];
                    ob[bj].x = cvt_pk_bf16(h0, h1); ob[bj].y = cvt_pk_bf16(h2, h3); }
                const bool odd = fq & 1;
                const u32x2 snd = odd ? ob[0] : ob[1];
                u32x2 rcv; rcv.x = (unsigned)__shfl_xor((int)snd.x, 16); rcv.y = (unsigned)__shfl_xor((int)snd.y, 16);
                u32x4 o4; o4.x = odd ? rcv.x : ob[0].x; o4.y = odd ? rcv.y : ob[0].y; o4.z = odd ? ob[1].x : rcv.x; o4.w = odd ? ob[1].y : rcv.y;
                const unsigned colo = (unsigned)(((col0 - (odd ? 8 : 0)) + (odd ? HALF : 0)) >> 1) * 2u;
                *(u32x4*)((char*)H + rowb + colo) = o4; }
    }
};
struct EpiResid {
    static constexpr bool PERM = true, AFTER_DRAIN = false;
    const bf16_t* src; bf16_t* dst; float scale; float* ss;
    __device__ __forceinline__ void operator()(const f32x4 (&acc)[2][2][4][2], const Unit& u, int wr, int wc, int fr, int fq) const {
        const int row0 = u.pm * BM + wr * 64 + fr, col0 = u.pn * BM + wc * 32 + 8 * fq;
#pragma unroll
        for (int ai = 0; ai < 2; ++ai)
#pragma unroll
            for (int m = 0; m < 4; ++m) { const int row = row0 + ai * HALF + m * 16; const unsigned ro = ((unsigned)row * (unsigned)D + (unsigned)col0) * 2u; float sq = 0.f;
#pragma unroll
                for (int bj = 0; bj < 2; ++bj) { const unsigned o = ro + (unsigned)(bj * HALF) * 2u; f32x4 v0 = acc[ai][bj][m][0] * scale, v1 = acc[ai][bj][m][1] * scale;
                    const u32x4 so = *(const u32x4*)((const char*)src + o);
                    v0[0] += bf_lo(so.x); v0[1] += bf_hi(so.x); v0[2] += bf_lo(so.y); v0[3] += bf_hi(so.y); v1[0] += bf_lo(so.z); v1[1] += bf_hi(so.z); v1[2] += bf_lo(so.w); v1[3] += bf_hi(so.w);
                    sq += ((v0[0] * v0[0] + v0[1] * v0[1]) + (v0[2] * v0[2] + v0[3] * v0[3])) + ((v1[0] * v1[0] + v1[1] * v1[1]) + (v1[2] * v1[2] + v1[3] * v1[3]));
                    u32x4 r; r.x = cvt_pk_bf16(v0[0], v0[1]); r.y = cvt_pk_bf16(v0[2], v0[3]); r.z = cvt_pk_bf16(v1[0], v1[1]); r.w = cvt_pk_bf16(v1[2], v1[3]);
                    *(u32x4*)((char*)dst + o) = r; }
                sq += __shfl_xor(sq, 16); sq += __shfl_xor(sq, 32);
                if (fq == 0) ss[(size_t)row * 16 + u.pn * 4 + wc] = sq; }
    }
};
struct EpiZin {
    static constexpr bool PERM = true, AFTER_DRAIN = false;
    bf16_t* Z; bf16_t* CQN; const float* cosT; const float* sinT; const float* ss; const PG8_LAS float* rl;
    __device__ __forceinline__ void operator()(const f32x4 (&acc)[2][2][4][2], const Unit& u, int wr, int wc, int fr, int fq) const {
        const int row0 = u.pm * BM + wr * 64 + fr, col0 = u.pn * BM + wc * 32 + 8 * fq;
        float rinv[8]; row_rinv8(ss, rl, row0, fq, fq * 16 + fr, rinv);
#pragma unroll
        for (int ai = 0; ai < 2; ++ai)
#pragma unroll
            for (int m = 0; m < 4; ++m) { const int row = row0 + ai * HALF + m * 16; const int pos = row & (T - 1); const float ri = rinv[ai * 4 + m];
#pragma unroll
                for (int bj = 0; bj < 2; ++bj) { const int col = col0 + bj * HALF; f32x4 v0 = acc[ai][bj][m][0] * ri, v1 = acc[ai][bj][m][1] * ri;
                    if (col < Z_ROPE_END) {
                        if (col >= Z_CQ && col < Z_KS) { u32x4 r; r.x = cvt_pk_bf16(v0[0], v0[1]); r.y = cvt_pk_bf16(v0[2], v0[3]); r.z = cvt_pk_bf16(v1[0], v1[1]); r.w = cvt_pk_bf16(v1[2], v1[3]);
                            *(u32x4*)((char*)CQN + ((unsigned)row * 512u + (unsigned)(col - Z_CQ)) * 2u) = r; }
                        const int i0 = (col & 63) >> 1;
                        const f32x4 c = *(const f32x4*)(cosT + pos * 32 + i0), s = *(const f32x4*)(sinT + pos * 32 + i0);
                        f32x4 w0, w1;
                        w0[0] = v0[0] * c[0] - v0[1] * s[0]; w0[1] = v0[0] * s[0] + v0[1] * c[0];
                        w0[2] = v0[2] * c[1] - v0[3] * s[1]; w0[3] = v0[2] * s[1] + v0[3] * c[1];
                        w1[0] = v1[0] * c[2] - v1[1] * s[2]; w1[1] = v1[0] * s[2] + v1[1] * c[2];
                        w1[2] = v1[2] * c[3] - v1[3] * s[3]; w1[3] = v1[2] * s[3] + v1[3] * c[3];
                        v0 = w0; v1 = w1;
                    } else if (col >= Z_IW) {
#pragma unroll
                        for (int e = 0; e < 4; ++e) { if (col + e >= Z_CG) v0[e] = fast_sigmoid(v0[e]); if (col + 4 + e >= Z_CG) v1[e] = fast_sigmoid(v1[e]); }
                    }
                    u32x4 r; r.x = cvt_pk_bf16(v0[0], v0[1]); r.y = cvt_pk_bf16(v0[2], v0[3]); r.z = cvt_pk_bf16(v1[0], v1[1]); r.w = cvt_pk_bf16(v1[2], v1[3]);
                    *(u32x4*)((char*)Z + ((unsigned)row * (unsigned)ZLD + (unsigned)col) * 2u) = r; } asm volatile("" ::: "memory"); }
    }
};
template <int MODE> struct EpiMerge {
    static constexpr bool PERM = true, AFTER_DRAIN = false;
    bf16_t* Gb; float* Mf; const float* ss; const PG8_LAS float* rl;
    __device__ __forceinline__ void operator()(const f32x4 (&acc)[2][2][4][2], const Unit& u, int wr, int wc, int fr, int fq) const {
        const int row0 = u.pm * BM + wr * 64 + fr, col0 = u.pn * BM + wc * 32 + 8 * fq;
        float rinv[8];
        if constexpr (MODE == 0) row_rinv8(ss, rl, row0, fq, fq * 16 + fr, rinv);
#pragma unroll
        for (int ai = 0; ai < 2; ++ai)
#pragma unroll
            for (int m = 0; m < 4; ++m) { const unsigned ro = ((unsigned)(row0 + ai * HALF + m * 16) * (unsigned)D + (unsigned)col0) * 2u;
#pragma unroll
                for (int bj = 0; bj < 2; ++bj) { const unsigned o = ro + (unsigned)(bj * HALF) * 2u; f32x4 v0 = acc[ai][bj][m][0], v1 = acc[ai][bj][m][1];
                    if constexpr (MODE == 0) {
#pragma unroll
                        for (int e = 0; e < 4; ++e) { v0[e] = fast_sigmoid(v0[e] * rinv[ai * 4 + m]); v1[e] = fast_sigmoid(v1[e] * rinv[ai * 4 + m]); }
                        u32x4 r; r.x = cvt_pk_bf16(v0[0], v0[1]); r.y = cvt_pk_bf16(v0[2], v0[3]); r.z = cvt_pk_bf16(v1[0], v1[1]); r.w = cvt_pk_bf16(v1[2], v1[3]);
                        *(u32x4*)((char*)Gb + o) = r;
                    } else {
                        const u32x4 g = *(const u32x4*)((const char*)Gb + o);
                        v0[0] *= bf_lo(g.x); v0[1] *= bf_hi(g.x); v0[2] *= bf_lo(g.y); v0[3] *= bf_hi(g.y);
                        v1[0] *= bf_lo(g.z); v1[1] *= bf_hi(g.z); v1[2] *= bf_lo(g.w); v1[3] *= bf_hi(g.w);
                        bf16_t* Mb = (bf16_t*)Mf;
                        if constexpr (MODE >= 2) { const u32x4 mo = *(const u32x4*)((const char*)Mb + o);
                            v0[0] += bf_lo(mo.x); v0[1] += bf_hi(mo.x); v0[2] += bf_lo(mo.y); v0[3] += bf_hi(mo.y); v1[0] += bf_lo(mo.z); v1[1] += bf_hi(mo.z); v1[2] += bf_lo(mo.w); v1[3] += bf_hi(mo.w); }
                        u32x4 r; r.x = cvt_pk_bf16(v0[0], v0[1]); r.y = cvt_pk_bf16(v0[2], v0[3]); r.z = cvt_pk_bf16(v1[0], v1[1]); r.w = cvt_pk_bf16(v1[2], v1[3]);
                        if constexpr (MODE == 3) *(u32x4*)((char*)Gb + o) = r; else *(u32x4*)((char*)Mb + o) = r;
                    } } }
    }
};

template <class Epi, class Sched, bool ALIGN_EPI = false, bool SP2 = false>
__device__ __forceinline__ void gemm_phase(PG8_LAS unsigned char* lds, const Gemm g, const Sched& S, const Epi& E) {
    int tid_o = threadIdx.x; asm volatile("" : "+v"(tid_o)); const int tid = tid_o, wid = __builtin_amdgcn_readfirstlane(tid >> 6), lane = tid & 63, wr = wid >> 2, wc = wid & 3, fr = lane & 15, fq = lane >> 4;
    const int K = g.K, nt = K / BK;
    unsigned voffA[2], voffB[2];
#pragma unroll
    for (int i = 0; i < 2; ++i) { int R, C; stage_rc(tid * 16 + i * 8192, R, C); const int Rb = Epi::PERM ? ((R & ~31) + perm32(R & 31)) : R;
        voffA[i] = (unsigned)(R * K + C) * 2u; voffB[i] = (unsigned)(Rb * K + C) * 2u; }
    const size_t kstep = (size_t)(BK * 2);
    const size_t hstep = (size_t)HALF * K * 2;
    const size_t tstep = 2 * hstep;
    const unsigned ldsw = (unsigned)wid * 1024u;
    const int aoff = lds_byte(wr * 64 + fr, fq * 8), boff = lds_byte(wc * 32 + fr, fq * 8);
#define PG8_SA(b, h) (((b) * 2 + (h)) * HTB)
#define PG8_SB(b, h) ((4 + (b) * 2 + (h)) * HTB)
#define PG8_STAGE(bufoff, gbase, voff) do { _Pragma("unroll") for (int _i = 0; _i < 2; ++_i) \
        __builtin_amdgcn_global_load_lds((const unsigned*)((const char*)(gbase) + (voff)[_i]), (PG8_LAS unsigned*)(lds + (bufoff) + ldsw + _i * 8192), 16, 0, 0); } while (0)
#define PG8_LDA(dst, b, h) do { _Pragma("unroll") for (int m = 0; m < 4; ++m) _Pragma("unroll") for (int k = 0; k < 2; ++k) dst[m][k] = *(const PG8_LAS bf16x8*)(lds + PG8_SA(b, h) + aoff + m * 2048 + k * 1024); } while (0)
#define PG8_LDB(dst, b, h) do { _Pragma("unroll") for (int n = 0; n < 2; ++n) _Pragma("unroll") for (int k = 0; k < 2; ++k) dst[n][k] = *(const PG8_LAS bf16x8*)(lds + PG8_SB(b, h) + boff + n * 2048 + k * 1024); } while (0)
#define PG8_MMA(ai, bj, At, Bt) do { __builtin_amdgcn_s_setprio(1); _Pragma("unroll") for (int m = 0; m < 4; ++m) _Pragma("unroll") for (int n = 0; n < 2; ++n) _Pragma("unroll") for (int k = 0; k < 2; ++k) \
        acc[ai][bj][m][n] = __builtin_amdgcn_mfma_f32_16x16x32_bf16(Bt[n][k], At[m][k], acc[ai][bj][m][n], 0, 0, 0); __builtin_amdgcn_s_setprio(0); } while (0)
#define PG8_WAIT_V(n) asm volatile("s_waitcnt vmcnt(" #n ")" ::: "memory")
#define PG8_WAIT_L(n) asm volatile("s_waitcnt lgkmcnt(" #n ")" ::: "memory")
#define PG8_BAR __builtin_amdgcn_s_barrier()
#define PG8_SCHED __builtin_amdgcn_sched_barrier(0)
    Unit cur, nxt; int ui = 0;
    if (!S.next(0, cur)) return;
    f32x4 acc[2][2][4][2];
#pragma unroll
    for (int a = 0; a < 2; ++a)
#pragma unroll
        for (int b = 0; b < 2; ++b)
#pragma unroll
            for (int m = 0; m < 4; ++m)
#pragma unroll
                for (int n = 0; n < 2; ++n) acc[a][b][m][n] = (f32x4){0.f, 0.f, 0.f, 0.f};
    bf16x8 At[4][2], B0[2][2], B1[2][2];
    const char* cA = (const char*)g.A + (size_t)cur.pm * tstep; const char* cB = (const char*)g.Bt + (size_t)cur.pn * tstep;
    S.a_ready(cur);
    if constexpr (SP2) {
        PG8_STAGE(PG8_SB(0, 0), cB, voffB); PG8_STAGE(PG8_SB(0, 1), cB + hstep, voffB); PG8_STAGE(PG8_SA(0, 0), cA, voffA); PG8_STAGE(PG8_SA(0, 1), cA + hstep, voffA);
        if (wr == 1) PG8_BAR;
        PG8_WAIT_V(2); PG8_BAR;
        PG8_STAGE(PG8_SB(1, 0), cB + kstep, voffB); PG8_STAGE(PG8_SA(1, 0), cA + kstep, voffA); PG8_STAGE(PG8_SB(1, 1), cB + hstep + kstep, voffB);
        PG8_WAIT_V(6); PG8_BAR;
    } else {
        PG8_STAGE(PG8_SB(0, 0), cB, voffB); PG8_STAGE(PG8_SA(0, 0), cA, voffA); PG8_STAGE(PG8_SB(0, 1), cB + hstep, voffB); PG8_STAGE(PG8_SA(0, 1), cA + hstep, voffA);
        if (wr == 1) PG8_BAR;
        PG8_WAIT_V(4); PG8_BAR;
        PG8_STAGE(PG8_SB(1, 0), cB + kstep, voffB); PG8_STAGE(PG8_SA(1, 0), cA + kstep, voffA); PG8_STAGE(PG8_SB(1, 1), cB + hstep + kstep, voffB);
        PG8_WAIT_V(6); PG8_BAR;
    }
    for (;;) {
        const bool has_next = S.next(ui + 1, nxt);
        const char* nA = has_next ? (const char*)g.A + (size_t)nxt.pm * tstep : cA; const char* nB = has_next ? (const char*)g.Bt + (size_t)nxt.pn * tstep : cB;
        for (int t = 0; t < nt; t += 2) {
            const bool last = (t == nt - 2);
            const char* a1 = cA + (size_t)(t + 1) * kstep;
            const char* a2 = last ? nA : cA + (size_t)(t + 2) * kstep; const char* b2 = last ? nB : cB + (size_t)(t + 2) * kstep;
            const char* a3 = a2 + kstep; const char* b3 = b2 + kstep;
            if (last && has_next) S.a_ready(nxt);
            if constexpr (SP2) {
            PG8_LDB(B0, 0, 0); PG8_LDB(B1, 0, 1); PG8_SCHED; PG8_LDA(At, 0, 0); PG8_STAGE(PG8_SA(1, 1), a1 + hstep, voffA);
            PG8_WAIT_V(8); PG8_WAIT_L(0); PG8_BAR; PG8_MMA(0, 0, At, B0); PG8_MMA(0, 1, At, B1); PG8_BAR; PG8_SCHED;
            PG8_LDA(At, 0, 1); PG8_STAGE(PG8_SB(0, 0), b2, voffB); PG8_STAGE(PG8_SB(0, 1), b2 + hstep, voffB); PG8_STAGE(PG8_SA(0, 0), a2, voffA);
            PG8_WAIT_V(8); PG8_WAIT_L(0); PG8_BAR; PG8_MMA(1, 0, At, B0); PG8_MMA(1, 1, At, B1); PG8_BAR; PG8_SCHED;
            PG8_LDB(B0, 1, 0); PG8_LDB(B1, 1, 1); PG8_SCHED; PG8_LDA(At, 1, 0); PG8_STAGE(PG8_SA(0, 1), a2 + hstep, voffA);
            PG8_WAIT_V(8); PG8_WAIT_L(0); PG8_BAR; PG8_MMA(0, 0, At, B0); PG8_MMA(0, 1, At, B1); PG8_BAR; PG8_SCHED;
            PG8_LDA(At, 1, 1); PG8_STAGE(PG8_SB(1, 0), b3, voffB); PG8_STAGE(PG8_SB(1, 1), b3 + hstep, voffB); PG8_STAGE(PG8_SA(1, 0), a3, voffA);
            PG8_WAIT_V(8); PG8_WAIT_L(0); PG8_BAR; PG8_MMA(1, 0, At, B0); PG8_MMA(1, 1, At, B1); PG8_BAR; PG8_SCHED;
            } else {
            PG8_LDB(B0, 0, 0); PG8_SCHED; PG8_LDA(At, 0, 0); PG8_STAGE(PG8_SA(1, 1), a1 + hstep, voffA);
            PG8_WAIT_L(8); PG8_BAR; PG8_WAIT_L(0); PG8_MMA(0, 0, At, B0); PG8_BAR; PG8_SCHED;
            PG8_LDB(B1, 0, 1); PG8_STAGE(PG8_SB(0, 0), b2, voffB);
            PG8_BAR; PG8_WAIT_L(0); PG8_MMA(0, 1, At, B1); PG8_BAR;
            PG8_LDA(At, 0, 1); PG8_STAGE(PG8_SA(0, 0), a2, voffA);
            PG8_BAR; PG8_WAIT_L(0); PG8_MMA(1, 0, At, B0); PG8_BAR; PG8_SCHED;
            PG8_STAGE(PG8_SB(0, 1), b2 + hstep, voffB);
            PG8_WAIT_V(6); PG8_BAR; PG8_MMA(1, 1, At, B1); PG8_BAR;
            PG8_LDB(B0, 1, 0); PG8_SCHED; PG8_LDA(At, 1, 0); PG8_STAGE(PG8_SA(0, 1), a2 + hstep, voffA);
            PG8_WAIT_L(8); PG8_BAR; PG8_WAIT_L(0); PG8_MMA(0, 0, At, B0); PG8_BAR; PG8_SCHED;
            PG8_LDB(B1, 1, 1); PG8_STAGE(PG8_SB(1, 0), b3, voffB);
            PG8_BAR; PG8_WAIT_L(0); PG8_MMA(0, 1, At, B1); PG8_BAR;
            PG8_LDA(At, 1, 1); PG8_STAGE(PG8_SA(1, 0), a3, voffA);
            PG8_BAR; PG8_WAIT_L(0); PG8_MMA(1, 0, At, B0); PG8_BAR; PG8_SCHED;
            PG8_STAGE(PG8_SB(1, 1), b3 + hstep, voffB);
            PG8_WAIT_V(6); PG8_BAR; PG8_MMA(1, 1, At, B1); PG8_BAR;
            }
        }
        if constexpr (ALIGN_EPI) { if (wr == 0) PG8_BAR; }
        if constexpr (!Epi::AFTER_DRAIN) { E(acc, cur, wr, wc, fr, fq); S.done(cur); }
        if (!has_next) break;
#pragma unroll
        for (int a = 0; a < 2; ++a)
#pragma unroll
            for (int b = 0; b < 2; ++b)
#pragma unroll
                for (int m = 0; m < 4; ++m)
#pragma unroll
                    for (int n = 0; n < 2; ++n) acc[a][b][m][n] = (f32x4){0.f, 0.f, 0.f, 0.f};
        cur = nxt; cA = nA; cB = nB; ++ui;
        if constexpr (ALIGN_EPI) { if (wr == 1) PG8_BAR; }
    }
    PG8_WAIT_V(0);
    if constexpr (!ALIGN_EPI) { if (wr == 0) PG8_BAR; }
    PG8_BAR;
    if constexpr (Epi::AFTER_DRAIN) { E.fused(acc, cur, wr, wc, fr, fq, lds, wid, lane); S.done(cur); }
#undef PG8_SA
#undef PG8_SB
#undef PG8_STAGE
#undef PG8_LDA
#undef PG8_LDB
#undef PG8_MMA
#undef PG8_WAIT_V
#undef PG8_WAIT_L
#undef PG8_BAR
#undef PG8_SCHED
}
}

#define LAS __attribute__((address_space(3)))
#define DI __device__ __forceinline__
typedef unsigned short bf16;
typedef short bf16x8 __attribute__((ext_vector_type(8)));
typedef short s16x4 __attribute__((ext_vector_type(4)));
typedef float f32x2 __attribute__((ext_vector_type(2)));
typedef float f32x4 __attribute__((ext_vector_type(4)));
typedef float f32x16 __attribute__((ext_vector_type(16)));
typedef unsigned u32x2 __attribute__((ext_vector_type(2)));
typedef unsigned u32x4 __attribute__((ext_vector_type(4)));
typedef __bf16 bf16x2_t __attribute__((ext_vector_type(2)));
typedef __attribute__((address_space(1))) unsigned gu32;
#define RLX_AGENT __ATOMIC_RELAXED, __HIP_MEMORY_SCOPE_AGENT
#define LDS_WAIT() asm volatile("s_waitcnt lgkmcnt(0)" ::: "memory")
#define VM_WAIT() asm volatile("s_waitcnt vmcnt(0)" ::: "memory")
#define MFMA32(a, b, c) __builtin_amdgcn_mfma_f32_32x32x16_bf16((a), (b), (c), 0, 0, 0)
#define MFMA16(a, b, c) __builtin_amdgcn_mfma_f32_16x16x32_bf16((a), (b), (c), 0, 0, 0)
constexpr float LOG2E = 1.4426950408889634f;
constexpr float NEG_INF = -__builtin_inff();
DI unsigned f2bf(float f) { unsigned u = __builtin_bit_cast(unsigned, f); return (u + 0x7fffu + ((u >> 16) & 1u)) >> 16; }
DI unsigned pk2(float lo, float hi) { f32x2 v = {lo, hi}; bf16x2_t b = __builtin_convertvector(v, bf16x2_t); return __builtin_bit_cast(unsigned, b); }
DI float bflo(unsigned u) { return __builtin_bit_cast(float, u << 16); }
DI float bfhi(unsigned u) { return __builtin_bit_cast(float, u & 0xffff0000u); }
DI float bf2f(bf16 v) { return __builtin_bit_cast(float, (unsigned)v << 16); }
DI float ex2(float x) { return __builtin_amdgcn_exp2f(x); }
DI int crow(int reg, int h) { return (reg & 3) + 8 * (reg >> 2) + 4 * h; }
DI float wave_sum(float v) {
#pragma unroll
    for (int o = 1; o < 64; o <<= 1) v += __shfl_xor(v, o);
    return v;
}
DI float wave_max(float v) {
#pragma unroll
    for (int o = 1; o < 64; o <<= 1) v = fmaxf(v, __shfl_xor(v, o));
    return v;
}

constexpr size_t MiB = 1u << 20;
constexpr size_t WS_CTL = 0, CTL_ZERO_BYTES = 64 * 1024;
constexpr size_t WS_COS = 1 * MiB, WS_SIN = 2 * MiB;
constexpr size_t WS_KMEAN = 3 * MiB, WS_KCMP = 3 * MiB + 128 * 1024, WS_VCMP = 3 * MiB + 384 * 1024, WS_BIAS1 = 3 * MiB + 640 * 1024;
constexpr size_t WS_W = 4 * MiB, WS_H = 60 * MiB, WS_O = 92 * MiB, WS_Z = 124 * MiB, WS_HID = WS_Z, WS_GB = WS_Z, WS_MF = 156 * MiB, WS_CQN = 220 * MiB, WS_PART = 240 * MiB, WS_XB = 320 * MiB, WS_SS = 352 * MiB, WS_END = 353 * MiB;
constexpr size_t W_UP1 = 0, W_DN1 = W_UP1 + (size_t)2 * DFF * D, W_UP2 = W_DN1 + (size_t)D * DFF, W_DN2 = W_UP2 + (size_t)2 * DFF * D, W_IN = W_DN2 + (size_t)D * DFF,
                 W_G = W_IN + (size_t)ZLD * D, W_A = W_G + (size_t)3 * D * D, W_B = W_A + (size_t)D * 256, W_C = W_B + (size_t)D * 256, W_O = W_C + (size_t)D * 512,
                 W_1K = W_O + (size_t)D * D, W_1V = W_1K + (size_t)128 * 2048, W_2K = W_1V + (size_t)128 * 2048, W_2V = W_2K + (size_t)64 * 128, W_END = W_2V + (size_t)64 * 128;
static_assert(W_END * 2 <= 56 * MiB, "weights region");
constexpr int CW_BAR = 1024;

constexpr int RING_BYTES = 131072;
constexpr int LDSCTL_OFF = RING_BYTES, MISC_OFF = LDSCTL_OFF + 320;
constexpr int LDS_BYTES = 147456;
constexpr int NWAVES = 8;

#define XB_TMO      128
#define XB_XCNT(j)  (256  + 64 * (j))
#define XB_XSUB(j)  (1280 + 64 * (j))
#define XB_XGEN(j)  (2304 + 64 * (j))
#define XB_TOP      3328
#define XB_TOPGEN   3392
#define XCD_BAR_WORDS 3456
#define XB_SPIN_CAP (1u << 18)

__device__ __forceinline__ unsigned xb_ld(unsigned* p)              { return __hip_atomic_load(p, __ATOMIC_RELAXED, __HIP_MEMORY_SCOPE_AGENT); }
__device__ __forceinline__ unsigned xb_add(unsigned* p, unsigned v) { return __hip_atomic_fetch_add(p, v, __ATOMIC_RELAXED, __HIP_MEMORY_SCOPE_AGENT); }
__device__ __forceinline__ unsigned xb_xcc_id() { return (unsigned)__builtin_amdgcn_s_getreg((3 << 11) | 20) & 0xFu; }
#define XB_SPIN(cond, bar) do { unsigned _sp = 0; while (cond) { __builtin_amdgcn_s_sleep(1); \
    if ((++_sp & 255u) == 0u) { if (xb_ld(&(bar)[XB_TMO])) break; if (_sp > XB_SPIN_CAP) { atomicAdd(&(bar)[XB_TMO], 1u); break; } } } } while (0)

struct XcdBarrier {
    unsigned* bar; unsigned x;
    volatile LAS unsigned* st;
};

__device__ __forceinline__ XcdBarrier xcd_barrier_post(unsigned* bar, volatile LAS unsigned* st) {
    XcdBarrier b; b.bar = bar; b.x = xb_xcc_id(); b.st = st;
    if (threadIdx.x == 0) (void)xb_add(&bar[XB_XCNT(b.x)], 1u);
    return b;
}
__device__ __forceinline__ void xcd_barrier_complete(unsigned* bar, unsigned x, unsigned& nloc, unsigned& nx) {
    const unsigned G = gridDim.x * gridDim.y * gridDim.z;
    unsigned sum, cnt, mine, sp = 0u;
    for (;;) {
        sum = 0u; cnt = 0u; mine = 0u;
#pragma unroll
        for (unsigned j = 0; j < 16; ++j) { const unsigned c = xb_ld(&bar[XB_XCNT(j)]); sum += c; cnt += (c > 0u) ? 1u : 0u; mine = (j == x) ? c : mine; }
        if (sum == G) break;
        __builtin_amdgcn_s_sleep(1);
        if ((++sp & 255u) == 0u) { if (xb_ld(&bar[XB_TMO])) break; if (sp > XB_SPIN_CAP) { atomicAdd(&bar[XB_TMO], 1u); break; } }
    }
    nloc = mine > 0u ? mine : 1u; nx = cnt > 0u ? cnt : 1u;
}

__device__ __forceinline__ void xcd_barrier(const XcdBarrier& b) {
    asm volatile("s_waitcnt vmcnt(0)" ::: "memory");
    __syncthreads();
    if (threadIdx.x == 0) {
        unsigned* bar = b.bar;
        __builtin_amdgcn_s_waitcnt(0);
        unsigned nloc = b.st[0], nx = b.st[1];
        if (nloc == 0u) { xcd_barrier_complete(bar, b.x, nloc, nx); b.st[0] = nloc; b.st[1] = nx; }
        const unsigned old = xb_add(&bar[XB_XSUB(b.x)], 1u);
        const unsigned gen = old / nloc;
        if (old + 1u == (gen + 1u) * nloc) {
            __builtin_amdgcn_fence(__ATOMIC_RELEASE, "agent");
            asm volatile("s_waitcnt vmcnt(0)" ::: "memory");
            const unsigned og = xb_add(&bar[XB_TOP], 1u);
            const unsigned tg = og / nx;
            if (og + 1u == (tg + 1u) * nx) xb_add(&bar[XB_TOPGEN], 1u);
            else XB_SPIN(xb_ld(&bar[XB_TOPGEN]) == tg, bar);
            __builtin_amdgcn_fence(__ATOMIC_ACQUIRE, "agent");
            xb_add(&bar[XB_XGEN(b.x)], 1u);
            asm volatile("s_waitcnt vmcnt(0)" ::: "memory");
        } else {
            XB_SPIN(xb_ld(&bar[XB_XGEN(b.x)]) == gen, bar);
            __builtin_amdgcn_fence(__ATOMIC_ACQUIRE, "agent");
            asm volatile("s_waitcnt vmcnt(0)" ::: "memory");
        }
    }
    __syncthreads();
}


DI int zcol_to_orig(int n) {
    if (n < Z_ROPE_END) { const int hh = n >> 6, w = n & 63, e = (w >> 1) + 32 * (w & 1); int base;
        if (hh < 4) base = hh * 64; else if (hh == 4) base = 256; else if (hh < 9) base = 384 + (hh - 5) * 64; else if (hh == 9) base = 640;
        else if (hh < 14) base = 708 + (hh - 10) * 64; else if (hh < 18) base = 964 + (hh - 14) * 64; else if (hh < 26) base = 1476 + (hh - 18) * 64;
        else if (hh < 28) base = 2244 + (hh - 26) * 64; else base = 2500 + (hh - 28) * 64;
        return base + e; }
    if (n < Z_BV) return 320 + (n - Z_AV);
    if (n < Z_KC) return 1220 + (n - Z_BV);
    if (n < Z_VC) return 1988 + (n - Z_KC);
    if (n < Z_VS) return 2116 + (n - Z_VC);
    if (n < Z_VW) return 2372 + (n - Z_VS);
    if (n < Z_IW) return 2628 + (n - Z_VW);
    if (n < Z_CG) return 704 + (n - Z_IW);
    if (n < Z_END) return 2756 + (n - Z_CG);
    return -1;
}
struct MapPlain { const float* W; DI const float* operator()(int n) const { return W + n; } };
struct MapGateUp { const float* Wg; const float* Wu; DI const float* operator()(int n) const { return ((n & 1) ? Wu : Wg) + (n >> 1); } };
struct MapZin { const float* W; DI const float* operator()(int n) const { const int oc = zcol_to_orig(n); return oc < 0 ? nullptr : W + oc; } };
struct MapW2K { const float* W; DI const float* operator()(int n) const { return W + (n >> 1) + 32 * (n & 1); } };
template <class Map>
DI void tr_item(const Map& mp, int ld, int K, int nblk, bf16* WT, LAS float* scr, int item, int lane) {
    const int kb = item / nblk, nb = item % nblk, k0 = 64 * kb, n0 = 32 * nb;
    if (mp.kind <= 1) {
        const int rr = lane >> 3, c4 = lane & 7;
        const float* src = (mp.kind == 0) ? mp.W0 + n0 + 4 * c4 : ((c4 < 4) ? mp.W0 : mp.W1) + (n0 >> 1) + 4 * (c4 & 3);
        f32x4 v[8];
#pragma unroll
        for (int i = 0; i < 8; ++i) v[i] = *(const f32x4*)(src + (size_t)(k0 + 8 * i + rr) * ld);
#pragma unroll
        for (int i = 0; i < 8; ++i) { LAS float* d = scr + (8 * i + rr) * 33;
            if (mp.kind == 0) { d[4 * c4] = v[i].x; d[4 * c4 + 1] = v[i].y; d[4 * c4 + 2] = v[i].z; d[4 * c4 + 3] = v[i].w; }
            else { const int nl = 8 * (c4 & 3) + (c4 >> 2); d[nl] = v[i].x; d[nl + 2] = v[i].y; d[nl + 4] = v[i].z; d[nl + 6] = v[i].w; } }
    } else {
        const float* colp = mp(n0 + (lane & 31));
#pragma unroll 8
        for (int i = 0; i < 32; ++i) { const int kk = 2 * i + (lane >> 5); scr[kk * 33 + (lane & 31)] = colp ? colp[(size_t)(k0 + kk) * ld] : 0.f; }
    }
    LDS_WAIT(); asm volatile("" ::: "memory");
    const int c = lane & 7;
    f32x4 ga = {1.f, 1.f, 1.f, 1.f}, gb = {1.f, 1.f, 1.f, 1.f};
    if (mp.gk) { ga = *(const f32x4*)(mp.gk + k0 + 8 * c); gb = *(const f32x4*)(mp.gk + k0 + 8 * c + 4); }
#pragma unroll
    for (int j = 0; j < 4; ++j) { const int n = (lane >> 3) + 8 * j; const LAS float* s = scr + (8 * c) * 33 + n;
        u32x4 o; o.x = pk2(s[0 * 33] * ga.x, s[1 * 33] * ga.y); o.y = pk2(s[2 * 33] * ga.z, s[3 * 33] * ga.w); o.z = pk2(s[4 * 33] * gb.x, s[5 * 33] * gb.y); o.w = pk2(s[6 * 33] * gb.z, s[7 * 33] * gb.w);
        *(u32x4*)(WT + (size_t)(n0 + n) * K + k0 + 8 * c) = o; }
    LDS_WAIT(); asm volatile("" ::: "memory");
}
DI void rms_row_bf16(const float* xrow, const float* g, bf16* orow, bf16* xbrow, int lane) {
    const f32x4* xr = (const f32x4*)xrow + lane; const f32x4* gr = (const f32x4*)g + lane;
    f32x4 v[4]; float s = 0.f;
#pragma unroll
    for (int j = 0; j < 4; ++j) { v[j] = xr[64 * j]; s += (v[j].x * v[j].x + v[j].y * v[j].y) + (v[j].z * v[j].z + v[j].w * v[j].w); }
    const float rstd = 1.f / sqrtf(wave_sum(s) * (1.f / D) + NORM_EPS);
    unsigned long long* o8 = (unsigned long long*)orow + lane; unsigned long long* x8 = (unsigned long long*)xbrow + lane;
#pragma unroll
    for (int j = 0; j < 4; ++j) { const f32x4 gg = gr[64 * j];
        x8[64 * j] = (unsigned long long)pk2(v[j].x, v[j].y) | ((unsigned long long)pk2(v[j].z, v[j].w) << 32);
        o8[64 * j] = (unsigned long long)pk2(v[j].x * rstd * gg.x, v[j].y * rstd * gg.y) | ((unsigned long long)pk2(v[j].z * rstd * gg.z, v[j].w * rstd * gg.w) << 32); }
}
DI void rms_rows4_bf16(const float* x, const float* g, bf16* o, bf16* xb, size_t m0, size_t stride, int lane) {
    f32x4 v[4][4]; float ss[4];
#pragma unroll
    for (int q = 0; q < 4; ++q) { const f32x4* xr = (const f32x4*)(x + (m0 + q * stride) * D) + lane;
#pragma unroll
        for (int j = 0; j < 4; ++j) v[q][j] = xr[64 * j]; }
#pragma unroll
    for (int q = 0; q < 4; ++q) { float a = 0.f;
#pragma unroll
        for (int j = 0; j < 4; ++j) a += (v[q][j].x * v[q][j].x + v[q][j].y * v[q][j].y) + (v[q][j].z * v[q][j].z + v[q][j].w * v[q][j].w);
        ss[q] = a; }
#pragma unroll
    for (int of = 1; of < 64; of <<= 1) {
#pragma unroll
        for (int q = 0; q < 4; ++q) ss[q] += __shfl_xor(ss[q], of); }
    const f32x4* gr = (const f32x4*)g + lane;
#pragma unroll
    for (int q = 0; q < 4; ++q) { const float rstd = 1.f / sqrtf(ss[q] * (1.f / D) + NORM_EPS);
        unsigned long long* o8 = (unsigned long long*)(o + (m0 + q * stride) * D) + lane; unsigned long long* x8 = (unsigned long long*)(xb + (m0 + q * stride) * D) + lane;
#pragma unroll
        for (int j = 0; j < 4; ++j) { const f32x4 gg = gr[64 * j];
            x8[64 * j] = (unsigned long long)pk2(v[q][j].x, v[q][j].y) | ((unsigned long long)pk2(v[q][j].z, v[q][j].w) << 32);
            o8[64 * j] = (unsigned long long)pk2(v[q][j].x * rstd * gg.x, v[q][j].y * rstd * gg.y) | ((unsigned long long)pk2(v[q][j].z * rstd * gg.z, v[q][j].w * rstd * gg.w) << 32); } }
}
DI void xb_init_rows4(const float* x, bf16* xb, float* ss, size_t m0, size_t stride, int lane) {
    f32x4 v[4][4]; float sq[4];
#pragma unroll
    for (int q = 0; q < 4; ++q) { const f32x4* xr = (const f32x4*)(x + (m0 + q * stride) * D) + lane;
#pragma unroll
        for (int j = 0; j < 4; ++j) v[q][j] = xr[64 * j]; }
#pragma unroll
    for (int q = 0; q < 4; ++q) { float a = 0.f;
#pragma unroll
        for (int j = 0; j < 4; ++j) a += (v[q][j].x * v[q][j].x + v[q][j].y * v[q][j].y) + (v[q][j].z * v[q][j].z + v[q][j].w * v[q][j].w);
        sq[q] = a; }
#pragma unroll
    for (int of = 1; of < 64; of <<= 1) {
#pragma unroll
        for (int q = 0; q < 4; ++q) sq[q] += __shfl_xor(sq[q], of); }
#pragma unroll
    for (int q = 0; q < 4; ++q) { unsigned long long* x8 = (unsigned long long*)(xb + (m0 + q * stride) * D) + lane;
#pragma unroll
        for (int j = 0; j < 4; ++j) x8[64 * j] = (unsigned long long)pk2(v[q][j].x, v[q][j].y) | ((unsigned long long)pk2(v[q][j].z, v[q][j].w) << 32);
        if (lane < 16) ss[(m0 + q * stride) * 16 + lane] = lane == 0 ? sq[q] : 0.f; }
}
template <int NR>
DI void rms_rows_b2b(const bf16* x, const float* g, bf16* o, size_t m0, size_t stride, int lane) {
    u32x4 v[NR][2]; float ss[NR];
#pragma unroll
    for (int q = 0; q < NR; ++q) { const u32x4* xr = (const u32x4*)(x + (m0 + q * stride) * D) + lane;
#pragma unroll
        for (int j = 0; j < 2; ++j) v[q][j] = xr[64 * j]; }
#pragma unroll
    for (int q = 0; q < NR; ++q) { float a = 0.f;
#pragma unroll
        for (int j = 0; j < 2; ++j) { const u32x4 t = v[q][j];
            a += (bflo(t.x) * bflo(t.x) + bfhi(t.x) * bfhi(t.x)) + (bflo(t.y) * bflo(t.y) + bfhi(t.y) * bfhi(t.y)) + (bflo(t.z) * bflo(t.z) + bfhi(t.z) * bfhi(t.z)) + (bflo(t.w) * bflo(t.w) + bfhi(t.w) * bfhi(t.w)); }
        ss[q] = a; }
#pragma unroll
    for (int of = 1; of < 64; of <<= 1) {
#pragma unroll
        for (int q = 0; q < NR; ++q) ss[q] += __shfl_xor(ss[q], of); }
#pragma unroll
    for (int q = 0; q < NR; ++q) { const float rstd = 1.f / sqrtf(ss[q] * (1.f / D) + NORM_EPS);
        u32x4* o16 = (u32x4*)(o + (m0 + q * stride) * D) + lane;
#pragma unroll
        for (int j = 0; j < 2; ++j) { const f32x4 g0 = ((const f32x4*)g)[2 * (lane + 64 * j)], g1 = ((const f32x4*)g)[2 * (lane + 64 * j) + 1]; const u32x4 t = v[q][j];
            u32x4 r; r.x = pk2(bflo(t.x) * rstd * g0.x, bfhi(t.x) * rstd * g0.y); r.y = pk2(bflo(t.y) * rstd * g0.z, bfhi(t.y) * rstd * g0.w);
            r.z = pk2(bflo(t.z) * rstd * g1.x, bfhi(t.z) * rstd * g1.y); r.w = pk2(bflo(t.w) * rstd * g1.z, bfhi(t.w) * rstd * g1.w);
            o16[64 * j] = r; } }
}
DI void rms_row_b2f(const bf16* xrow, const float* g, float* orow, int lane) {
    u32x4 v[2]; float s = 0.f;
#pragma unroll
    for (int j = 0; j < 2; ++j) { v[j] = ((const u32x4*)xrow)[lane + 64 * j]; const u32x4 t = v[j];
        s += (bflo(t.x) * bflo(t.x) + bfhi(t.x) * bfhi(t.x)) + (bflo(t.y) * bflo(t.y) + bfhi(t.y) * bfhi(t.y)) + (bflo(t.z) * bflo(t.z) + bfhi(t.z) * bfhi(t.z)) + (bflo(t.w) * bflo(t.w) + bfhi(t.w) * bfhi(t.w)); }
    const float rstd = 1.f / sqrtf(wave_sum(s) * (1.f / D) + NORM_EPS);
#pragma unroll
    for (int j = 0; j < 2; ++j) { const f32x4 g0 = ((const f32x4*)g)[2 * (lane + 64 * j)], g1 = ((const f32x4*)g)[2 * (lane + 64 * j) + 1]; const u32x4 t = v[j];
        f32x4 r0, r1; r0.x = bflo(t.x) * rstd * g0.x; r0.y = bfhi(t.x) * rstd * g0.y; r0.z = bflo(t.y) * rstd * g0.z; r0.w = bfhi(t.y) * rstd * g0.w;
        r1.x = bflo(t.z) * rstd * g1.x; r1.y = bfhi(t.z) * rstd * g1.y; r1.z = bflo(t.w) * rstd * g1.z; r1.w = bfhi(t.w) * rstd * g1.w;
        ((f32x4*)orow)[2 * (lane + 64 * j)] = r0; ((f32x4*)orow)[2 * (lane + 64 * j) + 1] = r1; }
}

struct Args { const float* in[22]; float* out; unsigned char* ws; int ph_lo, ph_hi; };
struct MapGen { int kind; const float* W0; const float* W1; const float* gk;
    DI const float* operator()(int n) const {
        if (kind == 0) return W0 + n;
        if (kind == 1) return ((n & 1) ? W1 : W0) + (n >> 1);
        if (kind == 2) { const int oc = zcol_to_orig(n); return oc < 0 ? nullptr : W0 + oc; }
        return W0 + (n >> 1) + 32 * (n & 1);
    } };
DI void convert_weights(const Args& A, int l, bf16* Wb, float* bias1p, LAS unsigned char* lds, int gw, int NGW, int wave, int lane, int tid) {
    LAS float* scr = (LAS float*)(lds + wave * 16384);
    constexpr int I_UP = 16 * 176, I_DN = 44 * 32, I_IN = 16 * 88, I_G = 16 * 96, I_A = 4 * 32, I_C = 8 * 32, I_O = 16 * 32, I_1 = 32 * 4, I_2 = 2 * 2;
    constexpr int NIT = 2 * I_UP + 2 * I_DN + I_IN + I_G + 2 * I_A + I_C + I_O + 2 * I_1 + 2 * I_2;
    for (int it = gw; it < NIT; it += NGW) {
        int r = it; MapGen mp; mp.kind = 0; mp.W0 = nullptr; mp.W1 = nullptr; mp.gk = nullptr; int ld, K, nblk; size_t dst;
        if (r < I_UP) { mp.kind = 1; mp.W0 = A.in[2] + (size_t)l * D * DFF; mp.W1 = A.in[3] + (size_t)l * D * DFF; mp.gk = A.in[1] + (size_t)l * D; ld = DFF; K = D; nblk = 176; dst = W_UP1; }
        else if ((r -= I_UP) < I_DN) { mp.W0 = A.in[4] + (size_t)l * DFF * D; ld = D; K = DFF; nblk = 32; dst = W_DN1; }
        else if ((r -= I_DN) < I_UP) { mp.kind = 1; mp.W0 = A.in[18] + (size_t)l * D * DFF; mp.W1 = A.in[19] + (size_t)l * D * DFF; mp.gk = A.in[17] + (size_t)l * D; ld = DFF; K = D; nblk = 176; dst = W_UP2; }
        else if ((r -= I_UP) < I_DN) { mp.W0 = A.in[20] + (size_t)l * DFF * D; ld = D; K = DFF; nblk = 32; dst = W_DN2; }
        else if ((r -= I_DN) < I_IN) { mp.kind = 2; mp.W0 = A.in[6] + (size_t)l * D * IN_COLS; mp.gk = A.in[5] + (size_t)l * D; ld = IN_COLS; K = D; nblk = 88; dst = W_IN; }
        else if ((r -= I_IN) < I_G) { mp.W0 = A.in[6] + (size_t)l * D * IN_COLS + Z_END; mp.gk = A.in[5] + (size_t)l * D; ld = IN_COLS; K = D; nblk = 96; dst = W_G; }
        else if ((r -= I_G) < I_A) { mp.W0 = A.in[13] + (size_t)l * 256 * D; ld = D; K = 256; nblk = 32; dst = W_A; }
        else if ((r -= I_A) < I_A) { mp.W0 = A.in[14] + (size_t)l * 256 * D; ld = D; K = 256; nblk = 32; dst = W_B; }
        else if ((r -= I_A) < I_C) { mp.W0 = A.in[15] + (size_t)l * 512 * D; ld = D; K = 512; nblk = 32; dst = W_C; }
        else if ((r -= I_C) < I_O) { mp.W0 = A.in[16] + (size_t)l * D * D; ld = D; K = D; nblk = 32; dst = W_O; }
        else if ((r -= I_O) < I_1) { mp.W0 = A.in[8] + (size_t)l * 2048 * 128; ld = 128; K = 2048; nblk = 4; dst = W_1K; }
        else if ((r -= I_1) < I_1) { mp.W0 = A.in[11] + (size_t)l * 2048 * 128; ld = 128; K = 2048; nblk = 4; dst = W_1V; }
        else if ((r -= I_1) < I_2) { mp.kind = 3; mp.W0 = A.in[9] + (size_t)l * 128 * 64; ld = 64; K = 128; nblk = 2; dst = W_2K; }
        else { r -= I_2; mp.W0 = A.in[12] + (size_t)l * 128 * 64; ld = 64; K = 128; nblk = 2; dst = W_2V; }
        tr_item(mp, ld, K, nblk, Wb + dst, scr, r, lane);
    }
    if (blockIdx.x < 16) {
        LDS_WAIT(); __syncthreads();
        const int kv = blockIdx.x >> 3, kc = blockIdx.x & 7, u = tid & 127, ks = tid >> 7;
        const float* pos = (kv ? A.in[10] : A.in[7]) + (size_t)l * 2048; const float* w1 = (kv ? A.in[11] : A.in[8]) + (size_t)l * 2048 * 128;
        float a = 0.f;
        for (int i = 0; i < 64; ++i) { const int k = kc * 256 + ks * 64 + i; a += pos[k] * w1[(size_t)k * 128 + u]; }
        LAS float* red = (LAS float*)lds;
        red[ks * 128 + u] = a;
        __syncthreads();
        if (tid < 128) bias1p[(kv * 8 + kc) * 128 + tid] = (red[tid] + red[128 + tid]) + (red[256 + tid] + red[384 + tid]);
        __syncthreads();
    }
}
DI void rope_table(float* cosT, float* sinT, int gtid, int gthreads) {
    for (int e = gtid; e < T * 32; e += gthreads) {
        const int pos = e >> 5, i = e & 31;
        double iv = 1.0;
        for (int k = 0; k < i; ++k) iv *= 0.74989420933245582;
        const float inv = (float)iv;
        const float ang = (float)pos * inv;
        const double x = (double)ang; const double n = rint(x * 0.15915494309189535);
        const float rr = (float)(x - n * 6.283185307179586);
        cosT[e] = __cosf(rr); sinT[e] = __sinf(rr);
    }
}

constexpr int VROWB = 192, VT_BYTES = 32 * VROWB;
DI void load_v_tile(const bf16* vbase, size_t vstride, LAS unsigned char* vt, int lane) {
#pragma unroll
    for (int it = 0; it < 4; ++it) { const int c = lane + 64 * it, key = c >> 3, ch = c & 7;
        const u32x4 v = *(const u32x4*)(vbase + (size_t)key * vstride + ch * 8);
        *(LAS u32x4*)(vt + key * VROWB + ch * 16) = v; }
}
DI f32x16 qk_tile(const bf16* kbase, size_t kstride, const bf16x8 (&qf)[4], int r, int h) {
    bf16x8 kf[4];
#pragma unroll
    for (int ks = 0; ks < 4; ++ks) kf[ks] = *(const bf16x8*)(kbase + (size_t)r * kstride + 16 * ks + 8 * h);
    f32x16 s;
#pragma unroll
    for (int i = 0; i < 16; ++i) s[i] = 0.f;
#pragma unroll
    for (int ks = 0; ks < 4; ++ks) s = MFMA32(kf[ks], qf[ks], s);
    return s;
}
DI s16x4 vtr(const LAS unsigned char* p) { return __builtin_bit_cast(s16x4, __builtin_amdgcn_ds_read_tr16_b64_v4i16((LAS s16x4*)p)); }
constexpr float SM_TAU = 8.f;
DI void softmax_pv(f32x16& s, float mx, float mref, f32x16& o0, f32x16& o1, float& m, float& l, const LAS unsigned char* vt, int lane) {
    mx = fmaxf(mx, __shfl_xor(mx, 32));
    const bool upd = (mx > SM_TAU) || (m < -1e29f && mx > -1e30f);
    if (__any(upd)) {
        const float d = upd ? mx : 0.f;
        const float alpha = (m < -1e29f) ? 1.f : ex2(-d);
        if (upd) m = mref + d;
        l *= alpha;
#pragma unroll
        for (int i = 0; i < 16; ++i) { o0[i] *= alpha; o1[i] *= alpha; s[i] -= d; }
    }
    float rs = 0.f;
#pragma unroll
    for (int i = 0; i < 16; ++i) { s[i] = ex2(s[i]); rs += s[i]; }
    l += rs;
    u32x4 pa, pb;
    pa.x = pk2(s[0], s[1]); pa.y = pk2(s[2], s[3]); pa.z = pk2(s[4], s[5]); pa.w = pk2(s[6], s[7]);
    pb.x = pk2(s[8], s[9]); pb.y = pk2(s[10], s[11]); pb.z = pk2(s[12], s[13]); pb.w = pk2(s[14], s[15]);
    const bf16x8 p0 = __builtin_bit_cast(bf16x8, pa), p1 = __builtin_bit_cast(bf16x8, pb);
    const int h = lane >> 5, blk = (lane >> 4) & 1, q = (lane & 15) >> 2, p = lane & 3;
    const LAS unsigned char* tb = vt + (4 * h + q) * VROWB + (16 * blk + 4 * p) * 2;
    s16x4 lo[2][2], hi[2][2];
#pragma unroll
    for (int dt = 0; dt < 2; ++dt)
#pragma unroll
        for (int ss = 0; ss < 2; ++ss) { lo[dt][ss] = vtr(tb + (16 * ss) * VROWB + 64 * dt); hi[dt][ss] = vtr(tb + (16 * ss + 8) * VROWB + 64 * dt); }
    asm volatile("" ::: "memory");
#pragma unroll
    for (int dt = 0; dt < 2; ++dt) {
#pragma unroll
        for (int ss = 0; ss < 2; ++ss) {
            const bf16x8 vf = __builtin_shufflevector(lo[dt][ss], hi[dt][ss], 0, 1, 2, 3, 4, 5, 6, 7);
            if (dt == 0) o0 = MFMA32(vf, ss ? p1 : p0, o0); else o1 = MFMA32(vf, ss ? p1 : p0, o1);
        }
    }
}
#define ZERO16(v) do { _Pragma("unroll") for (int _i = 0; _i < 16; ++_i) (v)[_i] = 0.f; } while (0)

struct KVPre { bf16x8 k[4]; u32x4 v[4]; };
DI void kv_issue(KVPre& p, const bf16* kb, size_t kstride, const bf16* vb, size_t vstride, int r, int h, int lane) {
#pragma unroll
    for (int ks = 0; ks < 4; ++ks) p.k[ks] = *(const bf16x8*)(kb + (size_t)r * kstride + 16 * ks + 8 * h);
#pragma unroll
    for (int it = 0; it < 4; ++it) { const int c = lane + 64 * it, key = c >> 3, ch = c & 7; p.v[it] = *(const u32x4*)(vb + (size_t)key * vstride + ch * 8); }
}
DI void k_issue(KVPre& p, const bf16* kb, size_t kstride, int r, int h) {
#pragma unroll
    for (int ks = 0; ks < 4; ++ks) p.k[ks] = *(const bf16x8*)(kb + (size_t)r * kstride + 16 * ks + 8 * h);
}
DI f32x16 qk_pre(const KVPre& p, const bf16x8 (&qf)[4]) {
    f32x16 s;
#pragma unroll
    for (int i = 0; i < 16; ++i) s[i] = 0.f;
#pragma unroll
    for (int ks = 0; ks < 4; ++ks) s = MFMA32(p.k[ks], qf[ks], s);
    return s;
}
DI void v_store(const KVPre& p, LAS unsigned char* vt, int lane) {
#pragma unroll
    for (int it = 0; it < 4; ++it) { const int c = lane + 64 * it, key = c >> 3, ch = c & 7; *(LAS u32x4*)(vt + key * VROWB + ch * 16) = p.v[it]; }
}
template <class It, class Mk>
DI void attn_loop(It& it, const Mk& mk, const bf16* kbase, size_t kstride, const bf16* vbase, size_t vstride, const bf16x8 (&qf)[4], float cs,
                  f32x16& o0, f32x16& o1, float& m, float& l, LAS unsigned char* vt0, LAS unsigned char* vt1, int lane) {
    const int r = lane & 31, h = lane >> 5;
    KVPre A, B;
    int kbA = -1, kbB = -1;
    bool hA = it.next(kbA), hB = false;
    if (!hA) return;
    kv_issue(A, kbase + (size_t)kbA * kstride, kstride, vbase + (size_t)kbA * vstride, vstride, r, h, lane);
    v_store(A, vt0, lane);
    for (;;) {
        kbB = kbA; hB = it.next(kbB);
        if (hB) { k_issue(B, kbase + (size_t)kbB * kstride, kstride, r, h);
            const bf16* vb = vbase + (size_t)kbB * vstride;
#pragma unroll
            for (int t4 = 0; t4 < 4; ++t4) { const int c = lane + 64 * t4, key = c >> 3, ch = c & 7; A.v[t4] = *(const u32x4*)(vb + (size_t)key * vstride + ch * 8); } }
        { f32x16 s = qk_pre(A, qf); const bool rw = mk.row(kbA); float mx; const float mref = (m < -1e29f) ? 0.f : m; const float biasm = (rw ? 0.f : NEG_INF) - mref;
          if (mk.full(kbA)) { const float bias = biasm;
#pragma unroll
            for (int i = 0; i < 16; ++i) s[i] = s[i] * cs + bias;
            mx = s[0];
#pragma unroll
            for (int i = 1; i < 16; ++i) mx = fmaxf(mx, s[i]);
          } else {
#pragma unroll
            for (int i = 0; i < 16; ++i) { const int key = kbA + crow(i, h); s[i] = mk.elem(key) ? s[i] * cs + biasm : NEG_INF; }
            mx = s[0];
#pragma unroll
            for (int i = 1; i < 16; ++i) mx = fmaxf(mx, s[i]); }
          softmax_pv(s, mx, mref, o0, o1, m, l, vt0, lane); }
        if (!hB) break;
        v_store(A, vt1, lane);
        kbA = kbB; hA = it.next(kbA);
        if (hA) { k_issue(A, kbase + (size_t)kbA * kstride, kstride, r, h);
            const bf16* vb = vbase + (size_t)kbA * vstride;
#pragma unroll
            for (int t4 = 0; t4 < 4; ++t4) { const int c = lane + 64 * t4, key = c >> 3, ch = c & 7; A.v[t4] = *(const u32x4*)(vb + (size_t)key * vstride + ch * 8); } }
        { f32x16 s = qk_pre(B, qf); const bool rw = mk.row(kbB); float mx; const float mref = (m < -1e29f) ? 0.f : m; const float biasm = (rw ? 0.f : NEG_INF) - mref;
          if (mk.full(kbB)) { const float bias = biasm;
#pragma unroll
            for (int i = 0; i < 16; ++i) s[i] = s[i] * cs + bias;
            mx = s[0];
#pragma unroll
            for (int i = 1; i < 16; ++i) mx = fmaxf(mx, s[i]);
          } else {
#pragma unroll
            for (int i = 0; i < 16; ++i) { const int key = kbB + crow(i, h); s[i] = mk.elem(key) ? s[i] * cs + biasm : NEG_INF; }
            mx = s[0];
#pragma unroll
            for (int i = 1; i < 16; ++i) mx = fmaxf(mx, s[i]); }
          softmax_pv(s, mx, mref, o0, o1, m, l, vt1, lane); }
        if (!hA) break;
        v_store(A, vt0, lane);
    }
}
struct ItRange { int kb0, kb_last; DI bool next(int& kb) const { const int nk = kb < 0 ? kb0 : kb + 32; if (nk > kb_last) return false; kb = nk; return true; } };
struct ItMoba { unsigned nm; int tmax; DI bool next(int& kb) const {
        if (kb >= 0) { const int nk = kb + 32; if ((nk & 255) && nk <= tmax) { kb = nk; return true; } }
        const int n = kb < 0 ? 0 : (kb >> 8) + 1; if (n > 31) return false; const unsigned mm = nm >> n; if (!mm) return false;
        kb = (n + __builtin_ctz(mm)) * 256; return true; } };
struct ItSlc { unsigned long long lo, hi; int tmax; DI bool next(int& kb) const {
        if (kb >= 0 && !(kb & 32) && kb + 32 <= tmax) { kb += 32; return true; }
        int j = kb < 0 ? 0 : (kb >> 6) + 1; if (j > 127) return false;
        if (j < 64) { const unsigned long long mm = lo >> j; if (mm) { kb = (j + __builtin_ctzll(mm)) * 64; return true; } j = 64; }
        const unsigned long long mh = hi >> (j - 64); if (!mh) return false; kb = (j + __builtin_ctzll(mh)) * 64; return true; } };

constexpr int KROWB = 144, KT2_BYTES = 64 * KROWB, VT2_BYTES = 64 * VROWB, BT_BYTES = KT2_BYTES + VT2_BYTES;
DI void softmax_pv2(f32x16& sa, f32x16& sb, float mx, float mref, f32x16& o0, f32x16& o1, float& m, float& l, const LAS unsigned char* vta, int lane) {
    mx = fmaxf(mx, __shfl_xor(mx, 32));
    const bool upd = (mx > SM_TAU) || (m < -1e29f && mx > -1e30f);
    if (__any(upd)) {
        const float d = upd ? mx : 0.f;
        const float alpha = (m < -1e29f) ? 1.f : ex2(-d);
        if (upd) m = mref + d;
        l *= alpha;
#pragma unroll
        for (int i = 0; i < 16; ++i) { o0[i] *= alpha; o1[i] *= alpha; sa[i] -= d; sb[i] -= d; }
    }
    float rs = 0.f;
#pragma unroll
    for (int i = 0; i < 16; i += 2) { sa[i] = ex2(sa[i]); sa[i + 1] = ex2(sa[i + 1]); sb[i] = ex2(sb[i]); sb[i + 1] = ex2(sb[i + 1]); rs += (sa[i] + sb[i]) + (sa[i + 1] + sb[i + 1]); }
    l += rs;
    u32x4 pa, pb, pc, pd;
    pa.x = pk2(sa[0], sa[1]); pa.y = pk2(sa[2], sa[3]); pa.z = pk2(sa[4], sa[5]); pa.w = pk2(sa[6], sa[7]);
    pb.x = pk2(sa[8], sa[9]); pb.y = pk2(sa[10], sa[11]); pb.z = pk2(sa[12], sa[13]); pb.w = pk2(sa[14], sa[15]);
    pc.x = pk2(sb[0], sb[1]); pc.y = pk2(sb[2], sb[3]); pc.z = pk2(sb[4], sb[5]); pc.w = pk2(sb[6], sb[7]);
    pd.x = pk2(sb[8], sb[9]); pd.y = pk2(sb[10], sb[11]); pd.z = pk2(sb[12], sb[13]); pd.w = pk2(sb[14], sb[15]);
    const bf16x8 p0 = __builtin_bit_cast(bf16x8, pa), p1 = __builtin_bit_cast(bf16x8, pb), p2 = __builtin_bit_cast(bf16x8, pc), p3 = __builtin_bit_cast(bf16x8, pd);
    const int h = lane >> 5, blk = (lane >> 4) & 1, q = (lane & 15) >> 2, p = lane & 3;
    const LAS unsigned char* tb = vta + (4 * h + q) * VROWB + (16 * blk + 4 * p) * 2;
#pragma unroll
    for (int dt = 0; dt < 2; ++dt) {
        s16x4 lo[4], hi[4];
#pragma unroll
        for (int ss = 0; ss < 4; ++ss) { lo[ss] = vtr(tb + (16 * ss) * VROWB + 64 * dt); hi[ss] = vtr(tb + (16 * ss + 8) * VROWB + 64 * dt); }
        asm volatile("" ::: "memory");
#pragma unroll
        for (int ss = 0; ss < 4; ++ss) {
            const bf16x8 vf = __builtin_shufflevector(lo[ss], hi[ss], 0, 1, 2, 3, 4, 5, 6, 7);
            const bf16x8 pp = ss == 0 ? p0 : ss == 1 ? p1 : ss == 2 ? p2 : p3;
            if (dt == 0) o0 = MFMA32(vf, pp, o0); else o1 = MFMA32(vf, pp, o1);
        }
    }
}
#define BLK_ISSUE(kbn) do { regk = *(const u32x4*)(kbase + (size_t)((kbn) + lk) * kstride + lc * 8); if (vbase) regv = *(const u32x4*)(vbase + (size_t)((kbn) + lk) * vstride + lc * 8); } while (0)
#define BLK_STORE(buf) do { *(LAS u32x4*)(tb + (buf) * BT_BYTES + lk * KROWB + lc * 16) = regk; if (vbase) *(LAS u32x4*)(tb + (buf) * BT_BYTES + KT2_BYTES + lk * VROWB + lc * 16) = regv; } while (0)
template <class It, class Mk>
DI void attn_loop_blk(It& it, const Mk& mk, const bf16* kbase, size_t kstride, const bf16* vbase, size_t vstride, const bf16x8 (&qf)[4], float cs,
                      f32x16& o0, f32x16& o1, float& m, float& l, LAS unsigned char* tb, int tid, int lane) {
    const int r = lane & 31, h = lane >> 5;
    const int lk = tid >> 3, lc = tid & 7;
    int kb = -1; bool has = it.next(kb);
    if (has) {
        u32x4 regk = {0u, 0u, 0u, 0u}, regv = {0u, 0u, 0u, 0u};
        BLK_ISSUE(kb); BLK_STORE(0);
        __syncthreads();
        int cur = 0;
        for (;;) {
            int kbn = kb; const bool hn = it.next(kbn);
            if (hn) BLK_ISSUE(kbn);
            if (mk.needs(kb)) {
                const LAS unsigned char* kt = tb + cur * BT_BYTES;
                f32x16 sa, sb;
#pragma unroll
                for (int i = 0; i < 16; ++i) { sa[i] = 0.f; sb[i] = 0.f; }
#pragma unroll
                for (int ks = 0; ks < 4; ++ks) { const bf16x8 ka = *(const LAS bf16x8*)(kt + r * KROWB + (16 * ks + 8 * h) * 2), kc = *(const LAS bf16x8*)(kt + (32 + r) * KROWB + (16 * ks + 8 * h) * 2);
                    sa = MFMA32(ka, qf[ks], sa); sb = MFMA32(kc, qf[ks], sb); }
                const bool rw = mk.row(kb); float mx; const float mref = (m < -1e29f) ? 0.f : m; const float biasm = (rw ? 0.f : NEG_INF) - mref;
                if (mk.full(kb)) { const float bias = biasm;
#pragma unroll
                    for (int i = 0; i < 16; ++i) { sa[i] = sa[i] * cs + bias; sb[i] = sb[i] * cs + bias; }
                    mx = fmaxf(sa[0], sb[0]);
#pragma unroll
                    for (int i = 1; i < 16; ++i) mx = fmaxf(mx, fmaxf(sa[i], sb[i]));
                } else {
#pragma unroll
                    for (int i = 0; i < 16; ++i) { const int key = kb + crow(i, h); sa[i] = mk.elem(key) ? sa[i] * cs + biasm : NEG_INF; sb[i] = mk.elem(key + 32) ? sb[i] * cs + biasm : NEG_INF; }
                    mx = fmaxf(sa[0], sb[0]);
#pragma unroll
                    for (int i = 1; i < 16; ++i) mx = fmaxf(mx, fmaxf(sa[i], sb[i])); }
                softmax_pv2(sa, sb, mx, mref, o0, o1, m, l, kt + KT2_BYTES, lane);
            }
            if (!hn) break;
            BLK_STORE(cur ^ 1);
            __syncthreads();
            cur ^= 1; kb = kbn;
        }
    }
    __syncthreads();
}
struct ItRange64 { int kb0, kb_last; DI bool next(int& kb) const { const int nk = kb < 0 ? kb0 : kb + 64; if (nk > kb_last) return false; kb = nk; return true; } };
struct ItSlc64 { unsigned long long lo, hi; DI bool next(int& kb) const {
        int j = kb < 0 ? 0 : (kb >> 6) + 1; if (j > 127) return false;
        if (j < 64) { const unsigned long long mm = lo >> j; if (mm) { kb = (j + __builtin_ctzll(mm)) * 64; return true; } j = 64; }
        const unsigned long long mh = hi >> (j - 64); if (!mh) return false; kb = (j + __builtin_ctzll(mh)) * 64; return true; } };

constexpr int NSA_WLDS = 2 * VT_BYTES;
constexpr int NSAB_IMP = 2 * BT_BYTES, NSAB_XCH = NSAB_IMP + 8 * 8192, NSAB_END = NSAB_XCH + 128;
DI void nsa_block_unit(int b, int g, int Q0, const bf16* z, const bf16* cqn, const bf16* kcmp, const bf16* vcmp, bf16* O, LAS unsigned char* lds, int tid) {
    const int lane = tid & 63, wave = __builtin_amdgcn_readfirstlane(tid >> 6), tq0 = Q0 + 8 * wave, tmaxb = Q0 + 63;
    LAS unsigned char* tb = lds;
    const int r = lane & 31, h = lane >> 5, qi = r >> 2, hh = r & 3, head = 4 * g + hh, t_row = tq0 + qi, tmax = tq0 + 7;
    const size_t row = (size_t)b * T + t_row;
    LAS float* impA = (LAS float*)(lds + NSAB_IMP + wave * 8192); LAS float* impB = impA + 1024;
    bf16x8 qn[4];
    { const bf16* qnp = cqn + row * 512 + head * 64 + 8 * h;
#pragma unroll
      for (int ks = 0; ks < 4; ++ks) qn[ks] = *(const bf16x8*)(qnp + 16 * ks); }
    const float cs = 0.125f * LOG2E;
    const bf16* gp = z + row * ZLD + Z_CG + head * 3;
    const float gate_c = bf2f(gp[0]), gate_s = bf2f(gp[1]), gate_w = bf2f(gp[2]);
    f32x16 tot0, tot1, o0, o1; ZERO16(tot0); ZERO16(tot1);
    float m, l;
    const bf16* zb = z + (size_t)b * T * ZLD;
    const int ncmp = (tmax >= 31) ? ((tmax - 31) >> 4) + 1 : 0, ntc = (ncmp + 31) >> 5;
    const bf16* kcb = kcmp + (size_t)((b * 2 + g) * 512) * 64; const bf16* vcb = vcmp + (size_t)((b * 2 + g) * 512) * 64;
    ZERO16(o0); ZERO16(o1); m = -1e30f; l = 0.f;
    const int ncmpb = (tmaxb >= 31) ? ((tmaxb - 31) >> 4) + 1 : 0, nscb = (ncmpb + 63) >> 6;
    { struct MkCmp { int t_row, tq0, ncmp; DI bool needs(int nb) const { return nb < ncmp; } DI bool row(int) const { return true; } DI bool elem(int n) const { return 16 * n + 31 <= t_row; } DI bool full(int nb) const { return 16 * (nb + 63) + 31 <= tq0; } } mk{t_row, tq0, ncmp};
      ItRange64 itc{0, 64 * (nscb - 1)};
      attn_loop_blk(itc, mk, kcb, 64, vcb, 64, qn, cs, o0, o1, m, l, tb, tid, lane); }
    float ltot = l + __shfl_xor(l, 32);
    const float inv_c = ltot > 0.f ? 1.f / ltot : 0.f;
    { const float f = gate_c * inv_c;
#pragma unroll
      for (int i = 0; i < 16; ++i) { tot0[i] = o0[i] * f; tot1[i] = o1[i] * f; } }
#pragma unroll
    for (int i = 0; i < 16; ++i) { impA[lane + 64 * i] = 0.f; impB[lane + 64 * i] = 0.f; }
    {
        const int lk = tid >> 3, lc = tid & 7;
        const bf16* kbase = kcb; const size_t kstride = 64; const bf16* vbase = nullptr; const size_t vstride = 0;
        if (nscb > 0) {
            u32x4 regk = {0u, 0u, 0u, 0u}, regv = {0u, 0u, 0u, 0u};
            BLK_ISSUE(0); BLK_STORE(0);
            __syncthreads();
            int cur = 0;
            for (int st = 0; st < nscb; ++st) {
                const int nb0 = 64 * st; const bool hn = st + 1 < nscb;
                if (hn) BLK_ISSUE(nb0 + 64);
                if (nb0 < ncmp) {
                    const LAS unsigned char* ktile = tb + cur * BT_BYTES;
#pragma unroll
                    for (int hf = 0; hf < 2; ++hf) {
                        const int nb = nb0 + 32 * hf, kt = 2 * st + hf;
                        f32x16 s; ZERO16(s);
#pragma unroll
                        for (int ks = 0; ks < 4; ++ks) { const bf16x8 kf = *(const LAS bf16x8*)(ktile + (32 * hf + r) * KROWB + (16 * ks + 8 * h) * 2); s = MFMA32(kf, qn[ks], s); }
#pragma unroll
                        for (int g4 = 0; g4 < 4; ++g4) {
                            float pp[4];
#pragma unroll
                            for (int i = 0; i < 4; ++i) { const int n = nb + 8 * g4 + 4 * h + i; pp[i] = (16 * n + 31 <= t_row) ? ex2(s[4 * g4 + i] * cs - m) * inv_c : 0.f; }
                            float s4 = (pp[0] + pp[1]) + (pp[2] + pp[3]), p3 = pp[3];
                            s4 += __shfl_xor(s4, 1); p3 += __shfl_xor(p3, 1);
                            s4 += __shfl_xor(s4, 2); p3 += __shfl_xor(p3, 2);
                            if (hh == 0) { const int j0 = 8 * kt + 2 * g4 + h; impA[qi * 128 + j0] = s4; impB[qi * 128 + j0] = p3; }
                        }
                    }
                }
                if (!hn) break;
                BLK_STORE(cur ^ 1);
                __syncthreads();
                cur ^= 1;
            }
        }
        __syncthreads();
    }
    const int jq = tmax >> 6;
    unsigned mk0 = 0, mk1 = 0, mk2 = 0, mk3 = 0;
    unsigned long long ulo = 0ull, uhi = 0ull;
    for (int q8 = 0; q8 < 8; ++q8) {
        const int j0 = lane, j1 = lane + 64;
        bool sel0, sel1;
        if (jq + 1 <= 16) { sel0 = j0 <= jq; sel1 = false; }
        else {
            const float i0 = impA[q8 * 128 + j0] + (j0 >= 1 ? impB[q8 * 128 + j0 - 1] : 0.f);
            const float i1 = impA[q8 * 128 + j1] + impB[q8 * 128 + j1 - 1];
            const bool fr0 = (j0 >= 1 && j0 <= jq - 2), fr1 = (j1 <= jq - 2);
            const bool fo0 = (j0 == 0 || j0 == jq || j0 == jq - 1), fo1 = (j1 == jq || j1 == jq - 1);
            const unsigned long long k0 = fr0 ? (((unsigned long long)__builtin_bit_cast(unsigned, i0) << 7) | (unsigned)(127 - j0)) : 0ull;
            const unsigned long long k1 = fr1 ? (((unsigned long long)__builtin_bit_cast(unsigned, i1) << 7) | (unsigned)(127 - j1)) : 0ull;
            unsigned long long Tk = 0ull;
            for (int bit = 38; bit >= 0; --bit) {
                const unsigned long long cand = Tk | (1ull << bit);
                const int cnt = __builtin_popcountll(__ballot(k0 >= cand)) + __builtin_popcountll(__ballot(k1 >= cand));
                if (cnt >= 13) Tk = cand;
            }
            sel0 = fo0 || (fr0 && k0 >= Tk); sel1 = fo1 || (fr1 && k1 >= Tk);
        }
        const unsigned long long mlo = __ballot(sel0), mhi = __ballot(sel1);
        ulo |= mlo; uhi |= mhi;
        if (qi == q8) { mk0 = (unsigned)mlo; mk1 = (unsigned)(mlo >> 32); mk2 = (unsigned)mhi; mk3 = (unsigned)(mhi >> 32); }
    }
#pragma unroll
    for (int i = 0; i < 16; ++i) { impA[i * 64 + lane] = tot0[i]; impA[(16 + i) * 64 + lane] = tot1[i]; }
    bf16x8 qr[4];
    { const bf16* qrp = z + row * ZLD + Z_CQ + head * 64 + 8 * h;
#pragma unroll
      for (int ks = 0; ks < 4; ++ks) qr[ks] = *(const bf16x8*)(qrp + 16 * ks); }
    ZERO16(o0); ZERO16(o1); m = -1e30f; l = 0.f;
    { struct MkSlc { unsigned m0, m1, m2, m3; int t_row; DI bool row(int kb) const { const int j = kb >> 6; const unsigned mw = (j < 32) ? m0 : (j < 64) ? m1 : (j < 96) ? m2 : m3; return (mw >> (j & 31)) & 1u; }
                      DI bool elem(int key) const { return key <= t_row; } DI bool full(int kb) const { return kb + 63 <= tq0; } int tq0; unsigned long long wlo, whi; DI bool needs(int kb) const { const int j = kb >> 6; return kb <= tq0 + 7 && ((j < 64) ? ((wlo >> j) & 1ull) : ((whi >> (j - 64)) & 1ull)); } } mk{mk0, mk1, mk2, mk3, t_row, tq0, ulo, uhi};
      LAS unsigned long long* xch = (LAS unsigned long long*)(lds + NSAB_XCH);
      if (lane == 0) { xch[2 * wave] = ulo; xch[2 * wave + 1] = uhi; }
      __syncthreads();
      unsigned long long blo = 0ull, bhi = 0ull;
#pragma unroll
      for (int ww = 0; ww < 8; ++ww) { blo |= xch[2 * ww]; bhi |= xch[2 * ww + 1]; }
      ItSlc64 its{blo, bhi};
      attn_loop_blk(its, mk, zb + Z_KS + g * 64, ZLD, zb + Z_VS + g * 64, ZLD, qr, cs, o0, o1, m, l, tb, tid, lane); }
    ltot = l + __shfl_xor(l, 32);
    { const float f = gate_s * (ltot > 0.f ? 1.f / ltot : 0.f);
#pragma unroll
      for (int i = 0; i < 16; ++i) { impA[i * 64 + lane] += o0[i] * f; impA[(16 + i) * 64 + lane] += o1[i] * f; } }
    ZERO16(o0); ZERO16(o1); m = -1e30f; l = 0.f;
    { const int klo = tq0 - 511 > 0 ? tq0 - 511 : 0;
      struct MkWin { int t_row, tq0, klo; DI bool needs(int kb) const { return kb <= tq0 + 7 && kb + 63 >= klo; } DI bool row(int) const { return true; } DI bool elem(int key) const { return key <= t_row && t_row - key < 512; } DI bool full(int kb) const { return kb + 63 <= tq0 && (tq0 + 7) - kb < 512; } } mk{t_row, tq0, klo};
      const int klob = Q0 - 511 > 0 ? Q0 - 511 : 0;
      ItRange64 itw{klob & ~63, tmaxb & ~63};
      attn_loop_blk(itw, mk, zb + Z_KW + g * 64, ZLD, zb + Z_VW + g * 64, ZLD, qr, cs, o0, o1, m, l, tb, tid, lane); }
    ltot = l + __shfl_xor(l, 32);
    { const float f = gate_w * (ltot > 0.f ? 1.f / ltot : 0.f);
#pragma unroll
      for (int i = 0; i < 16; ++i) { tot0[i] = impA[i * 64 + lane] + o0[i] * f; tot1[i] = impA[(16 + i) * 64 + lane] + o1[i] * f; } }
    bf16* op = O + row * 512 + head * 64 + 4 * h;
#pragma unroll
    for (int g4 = 0; g4 < 4; ++g4) {
        u32x2 a, c2; a.x = pk2(tot0[4 * g4], tot0[4 * g4 + 1]); a.y = pk2(tot0[4 * g4 + 2], tot0[4 * g4 + 3]);
        c2.x = pk2(tot1[4 * g4], tot1[4 * g4 + 1]); c2.y = pk2(tot1[4 * g4 + 2], tot1[4 * g4 + 3]);
        *(u32x2*)(op + 8 * g4) = a; *(u32x2*)(op + 32 + 8 * g4) = c2;
    }
}

constexpr int MB_SEL = 8 * 12288, MB_LIST = MB_SEL + 1024, MB_KM = MB_LIST + 8 * 512, MB_END = MB_KM + 8192;
constexpr int PART_F = 36;
DI void moba_write_partial(float* pp, bool active, int h, const f32x16& o0, const f32x16& o1, float m, float ltot) {
    if (active) {
#pragma unroll
        for (int g4 = 0; g4 < 4; ++g4) { u32x2 a, c; a.x = pk2(o0[4 * g4], o0[4 * g4 + 1]); a.y = pk2(o0[4 * g4 + 2], o0[4 * g4 + 3]); c.x = pk2(o1[4 * g4], o1[4 * g4 + 1]); c.y = pk2(o1[4 * g4 + 2], o1[4 * g4 + 3]);
            *(u32x2*)((bf16*)pp + 8 * g4 + 4 * h) = a; *(u32x2*)((bf16*)pp + 32 + 8 * g4 + 4 * h) = c; }
        if (h == 0) { pp[32] = m; pp[33] = ltot; }
    }
}
DI void moba_block_item(int b, int head, int own, int item, const bf16* z, const float* kmean, bf16* O, float* part, LAS unsigned char* lds, int tid) {
    const int lane = tid & 63, wave = __builtin_amdgcn_readfirstlane(tid >> 6), r = lane & 31, h = lane >> 5;
    const int Q0 = 256 * own, tq0 = Q0 + 32 * wave, t_row = tq0 + r, tmax = tq0 + 31;
    const size_t row = (size_t)b * T + t_row;
    LAS unsigned char* vt = lds + wave * NSA_WLDS;
    LAS unsigned* selb = (LAS unsigned*)(lds + MB_SEL);
    LAS unsigned short* rlist = (LAS unsigned short*)(lds + MB_LIST + wave * 512);
    const bf16* zb = z + (size_t)b * T * ZLD;
    float* pbase = part + (size_t)item * 256 * 4 * PART_F;
    const float cs = 0.125f * LOG2E;
    LAS float* kml = (LAS float*)(lds + MB_KM);
    __syncthreads();
    { const int e = tid * 4, n = e >> 6, d = e & 63; *(LAS f32x4*)(kml + e) = *(const f32x4*)(kmean + (size_t)((b * 32 + n) * 256 + head * 64 + d)); }
    __syncthreads();
    int i0 = -1, i1 = -1, i2 = -1;
    {
        u32x4 qrow[8];
        { const u32x4* qp = (const u32x4*)(z + row * ZLD + Z_BQ + head * 64);
#pragma unroll
          for (int c = 0; c < 8; ++c) qrow[c] = qp[c]; }
        float v0 = NEG_INF, v1 = NEG_INF, v2 = NEG_INF;
        for (int n = 0; n < own; ++n) {
            const LAS f32x4* km = (const LAS f32x4*)(kml + n * 64);
            float gsum = 0.f;
#pragma unroll
            for (int c = 0; c < 8; ++c) { const f32x4 ka = km[2 * c], kb2 = km[2 * c + 1]; const u32x4 qq = qrow[c];
                gsum += bflo(qq.x) * ka.x + bfhi(qq.x) * ka.y + bflo(qq.y) * ka.z + bfhi(qq.y) * ka.w + bflo(qq.z) * kb2.x + bfhi(qq.z) * kb2.y + bflo(qq.w) * kb2.z + bfhi(qq.w) * kb2.w; }
            if (gsum > v0) { v2 = v1; i2 = i1; v1 = v0; i1 = i0; v0 = gsum; i0 = n; }
            else if (gsum > v1) { v2 = v1; i2 = i1; v1 = gsum; i1 = n; }
            else if (gsum > v2) { v2 = gsum; i2 = n; }
        }
    }
    if (h == 0) selb[32 * wave + r] = (unsigned)(i0 & 0xff) | ((unsigned)(i1 & 0xff) << 8) | ((unsigned)(i2 & 0xff) << 16);
    {
        bf16x8 qf[4];
        { const bf16* qp = z + row * ZLD + Z_BQ + head * 64 + 8 * h;
#pragma unroll
          for (int ks = 0; ks < 4; ++ks) qf[ks] = *(const bf16x8*)(qp + 16 * ks); }
        f32x16 o0, o1; ZERO16(o0); ZERO16(o1); float m = -1e30f, l = 0.f;
        struct MkOwn { int t_row, tq0; DI bool row(int) const { return true; } DI bool elem(int key) const { return key <= t_row; } DI bool full(int kb) const { return kb + 31 <= tq0; } } mk{t_row, tq0};
        ItMoba itm{1u << own, tmax};
        attn_loop(itm, mk, zb + Z_BK + head * 64, ZLD, zb + Z_BV + head * 64, ZLD, qf, cs, o0, o1, m, l, vt, vt + VT_BYTES, lane);
        const float ltot = l + __shfl_xor(l, 32);
        moba_write_partial(pbase + ((size_t)(32 * wave + r) * 4 + 3) * PART_F, true, h, o0, o1, m, ltot);
    }
    __syncthreads();
#pragma unroll 1
    for (int n = 0; n < own; ++n) {
        int cnt = 0;
#pragma unroll
        for (int j = 0; j < 4; ++j) { const int q = lane + 64 * j; const unsigned sv = selb[q];
            const int slot = ((sv & 0xffu) == (unsigned)n) ? 0 : (((sv >> 8) & 0xffu) == (unsigned)n) ? 1 : (((sv >> 16) & 0xffu) == (unsigned)n) ? 2 : -1;
            const bool pr = slot >= 0; const unsigned long long mk_ = __ballot(pr);
            const int pos = cnt + (int)__builtin_amdgcn_mbcnt_hi((unsigned)(mk_ >> 32), __builtin_amdgcn_mbcnt_lo((unsigned)mk_, 0u));
            if (pr) rlist[pos] = (unsigned short)(q | (slot << 8));
            cnt += __builtin_popcountll(mk_); }
#pragma unroll 1
        for (int rt = (wave - n) & 7; rt * 32 < cnt; rt += 8) {
            const bool active = rt * 32 + r < cnt;
            const unsigned ent = rlist[active ? rt * 32 + r : 0];
            const int q = ent & 0xff, slot = (int)(ent >> 8);
            bf16x8 qf[4];
            { const bf16* qp = zb + (size_t)(Q0 + q) * ZLD + Z_BQ + head * 64 + 8 * h;
#pragma unroll
              for (int ks = 0; ks < 4; ++ks) qf[ks] = *(const bf16x8*)(qp + 16 * ks); }
            f32x16 o0, o1; ZERO16(o0); ZERO16(o1); float m = -1e30f, l = 0.f;
            struct MkAll { bool act; DI bool row(int) const { return act; } DI bool elem(int) const { return true; } DI bool full(int) const { return true; } } mk{active};
            ItMoba itm{1u << n, 0x7fffffff};
            attn_loop(itm, mk, zb + Z_BK + head * 64, ZLD, zb + Z_BV + head * 64, ZLD, qf, cs, o0, o1, m, l, vt, vt + VT_BYTES, lane);
            const float ltot = l + __shfl_xor(l, 32);
            moba_write_partial(pbase + ((size_t)q * 4 + slot) * PART_F, active, h, o0, o1, m, ltot);
        }
    }
    VM_WAIT();
    __syncthreads();
    {
        const float* pq = pbase + (size_t)(32 * wave + r) * 4 * PART_F;
        float mm[4], ll[4];
        { float mr[4], lr[4];
#pragma unroll
          for (int sl = 0; sl < 4; ++sl) { mr[sl] = pq[sl * PART_F + 32]; lr[sl] = pq[sl * PART_F + 33]; }
#pragma unroll
          for (int sl = 0; sl < 4; ++sl) { const bool valid = (sl == 3) || ((sl == 0 ? i0 : sl == 1 ? i1 : i2) >= 0);
              mm[sl] = valid ? mr[sl] : -1e30f; ll[sl] = valid ? lr[sl] : 0.f; } }
        const float M_ = fmaxf(fmaxf(mm[0], mm[1]), fmaxf(mm[2], mm[3]));
        float wgt[4], L = 0.f;
#pragma unroll
        for (int sl = 0; sl < 4; ++sl) { wgt[sl] = ex2(mm[sl] - M_); if (ll[sl] == 0.f) wgt[sl] = 0.f; L += ll[sl] * wgt[sl]; }
        const float inv = (L > 0.f ? 1.f / L : 0.f);
        bf16* op = O + row * 256 + head * 64 + 4 * h;
#pragma unroll
        for (int g4 = 0; g4 < 4; ++g4) {
            u32x2 pua[4], pub[4];
#pragma unroll
            for (int sl = 0; sl < 4; ++sl) { pua[sl] = *(const u32x2*)((const bf16*)(pq + sl * PART_F) + 8 * g4 + 4 * h); pub[sl] = *(const u32x2*)((const bf16*)(pq + sl * PART_F) + 32 + 8 * g4 + 4 * h); }
            f32x4 a = {0.f, 0.f, 0.f, 0.f}, c2 = {0.f, 0.f, 0.f, 0.f};
#pragma unroll
            for (int sl = 0; sl < 4; ++sl) { const bool use = wgt[sl] != 0.f;
                u32x2 ua_ = pua[sl], ub_ = pub[sl];
                ua_.x = use ? ua_.x : 0u; ua_.y = use ? ua_.y : 0u; ub_.x = use ? ub_.x : 0u; ub_.y = use ? ub_.y : 0u;
                const f32x4 pa = {bflo(ua_.x), bfhi(ua_.x), bflo(ua_.y), bfhi(ua_.y)}, pb = {bflo(ub_.x), bfhi(ub_.x), bflo(ub_.y), bfhi(ub_.y)};
                a = a + pa * wgt[sl]; c2 = c2 + pb * wgt[sl]; }
            u32x2 ua, uc; ua.x = pk2(a[0] * inv, a[1] * inv); ua.y = pk2(a[2] * inv, a[3] * inv); uc.x = pk2(c2[0] * inv, c2[1] * inv); uc.y = pk2(c2[2] * inv, c2[3] * inv);
            *(u32x2*)(op + 8 * g4) = ua; *(u32x2*)(op + 32 + 8 * g4) = uc;
        }
    }
}

DI void kmean_item(int it, const bf16* z, float* kmean, LAS unsigned char* lds, int tid) {
    const int b = it >> 5, n = it & 31, col = tid & 255, half = tid >> 8;
    const bf16* p = z + ((size_t)b * T + 256 * n + 128 * half) * ZLD + Z_BK + col;
    float a = 0.f;
#pragma unroll 8
    for (int k = 0; k < 128; ++k) a += bf2f(p[(size_t)k * ZLD]);
    LAS float* red = (LAS float*)lds;
    __syncthreads();
    if (half) red[col] = a;
    __syncthreads();
    if (!half) kmean[(size_t)(b * 32 + n) * 256 + col] = (a + red[col]) * (1.f / 256.f);
    __syncthreads();
}

DI float gelu_tanh(float x) { const float u = 0.7978845608028654f * (x + 0.044715f * x * x * x); const float e = ex2(2.f * LOG2E * u); const float th = 1.f - 2.f * __builtin_amdgcn_rcpf(e + 1.f); return 0.5f * x * (1.f + th); }
DI void compress_item(int it, const bf16* z, const bf16* Wb, const float* bias1p, bf16* kcmp, bf16* vcmp, LAS unsigned char* lds, int tid) {
    const int lane = tid & 63, wave = tid >> 6, r = lane & 31, h = lane >> 5;
    const int kv = it & 1, rtile = it >> 1, kh = wave >> 2, ut = wave & 3;
    const int R0 = 32 * rtile;
    const int bg = R0 >> 9, b = bg >> 1, g = bg & 1, n0 = R0 & 511;
    const bf16* w1t = Wb + (kv ? W_1V : W_1K); const bf16* w2t = Wb + (kv ? W_2V : W_2K);
    bf16* outp = kv ? vcmp : kcmp;
    int n = n0 + r; if (n > 510) n = 510;
    const bf16* ap = z + ((size_t)b * T + 16 * n) * ZLD + (kv ? Z_VC : Z_KC) + g * 64 + 8 * h;
    const bf16* bp = w1t + (size_t)(ut * 32 + r) * 2048 + 8 * h;
    f32x16 acc; ZERO16(acc);
#pragma unroll 8
    for (int kk = 0; kk < 64; ++kk) {
        const int ks = 64 * kh + kk, k0 = 16 * ks, ti = k0 >> 6, d = k0 & 63;
        const bf16x8 a = *(const bf16x8*)(ap + (size_t)ti * ZLD + d);
        const bf16x8 bb = *(const bf16x8*)(bp + k0);
        acc = MFMA32(a, bb, acc);
    }
    constexpr int HROW = 272, PSTR = 129, HID_OFF = 2 * 32 * PSTR * 4;
    LAS float* ps = (LAS float*)lds;
    __syncthreads();
#pragma unroll
    for (int i = 0; i < 16; ++i) ps[(kh * 32 + crow(i, h)) * PSTR + ut * 32 + r] = acc[i];
    __syncthreads();
    { const int u = tid & 127, rq = tid >> 7; float bias = 0.f;
#pragma unroll
      for (int c = 0; c < 8; ++c) bias += bias1p[(kv * 8 + c) * 128 + u];
#pragma unroll
      for (int i = 0; i < 8; ++i) { const int rowl = rq * 8 + i; const float v = ps[rowl * PSTR + u] + ps[(32 + rowl) * PSTR + u] + bias;
          *(LAS bf16*)(lds + HID_OFF + rowl * HROW + u * 2) = (bf16)f2bf(gelu_tanh(v)); } }
    __syncthreads();
    if (wave < 2) {
        const int ot = wave;
        f32x16 c2; ZERO16(c2);
#pragma unroll
        for (int ks = 0; ks < 8; ++ks) {
            const bf16x8 a = *(const LAS bf16x8*)(lds + HID_OFF + r * HROW + (16 * ks + 8 * h) * 2);
            const bf16x8 bb = *(const bf16x8*)(w2t + (size_t)(ot * 32 + r) * 128 + 16 * ks + 8 * h);
            c2 = MFMA32(a, bb, c2);
        }
#pragma unroll
        for (int i = 0; i < 16; ++i) { const int R = R0 + crow(i, h); const bool dead = (R & 511) == 511;
            outp[(size_t)R * 64 + ot * 32 + r] = dead ? (bf16)0 : (bf16)f2bf(c2[i]); }
    }
    __syncthreads();
}

constexpr int DS_S = 0, DS_SEL = 65536, DS_P = DS_SEL + 8 * 1024, DS_DMY = DS_P + 8 * 4096, DSA_LDS_END = DS_DMY + 8 * 256;
DI float relu_i(float x) { const int b = __builtin_bit_cast(int, x); return __builtin_bit_cast(float, b > 0 ? b : 0); }
DI unsigned orderkey(float s) { const unsigned u = __builtin_bit_cast(unsigned, s); return (u & 0x80000000u) ? ~u : (u | 0x80000000u); }
#define DPP_I(v, ctrl) __builtin_amdgcn_update_dpp(0, (v), (ctrl), 0xf, 0xf, false)
DI int row16_sum(int c) { c += DPP_I(c, 0x128); c += DPP_I(c, 0x124); c += DPP_I(c, 0x122); c += DPP_I(c, 0x121); return c; }
DI int wave_sum_i(int c) { c = row16_sum(c); return __builtin_amdgcn_readlane(c, 0) + __builtin_amdgcn_readlane(c, 16) + __builtin_amdgcn_readlane(c, 32) + __builtin_amdgcn_readlane(c, 48); }
#define DPP_F(v, ctrl) __builtin_bit_cast(float, DPP_I(__builtin_bit_cast(int, (v)), (ctrl)))
DI float row16_max(float v) { v = fmaxf(v, DPP_F(v, 0x128)); v = fmaxf(v, DPP_F(v, 0x124)); v = fmaxf(v, DPP_F(v, 0x122)); v = fmaxf(v, DPP_F(v, 0x121)); return v; }
DI float row16_sumf(float v) { v += DPP_F(v, 0x128); v += DPP_F(v, 0x124); v += DPP_F(v, 0x122); v += DPP_F(v, 0x121); return v; }
DI float oct_sumf(float v) {
    v += __builtin_bit_cast(float, DPP_I(__builtin_bit_cast(int, v), 0xB1));
    v += __builtin_bit_cast(float, DPP_I(__builtin_bit_cast(int, v), 0x4E));
    v += __builtin_bit_cast(float, DPP_I(__builtin_bit_cast(int, v), 0x141));
    return v; }
DI unsigned umin_(unsigned a, unsigned b) { return a < b ? a : b; }
DI unsigned umax_(unsigned a, unsigned b) { return a > b ? a : b; }
#define DPP_U(v, ctrl) ((unsigned)DPP_I((int)(v), (ctrl)))
DI unsigned wave_minu(unsigned v) { v = umin_(v, DPP_U(v, 0x128)); v = umin_(v, DPP_U(v, 0x124)); v = umin_(v, DPP_U(v, 0x122)); v = umin_(v, DPP_U(v, 0x121));
    return umin_(umin_((unsigned)__builtin_amdgcn_readlane((int)v, 0), (unsigned)__builtin_amdgcn_readlane((int)v, 16)), umin_((unsigned)__builtin_amdgcn_readlane((int)v, 32), (unsigned)__builtin_amdgcn_readlane((int)v, 48))); }
DI unsigned wave_maxu(unsigned v) { v = umax_(v, DPP_U(v, 0x128)); v = umax_(v, DPP_U(v, 0x124)); v = umax_(v, DPP_U(v, 0x122)); v = umax_(v, DPP_U(v, 0x121));
    return umax_(umax_((unsigned)__builtin_amdgcn_readlane((int)v, 0), (unsigned)__builtin_amdgcn_readlane((int)v, 16)), umax_((unsigned)__builtin_amdgcn_readlane((int)v, 32), (unsigned)__builtin_amdgcn_readlane((int)v, 48))); }
template <int NE>
DI void dsa_select(const unsigned (&ek)[NE], const int (&ei)[NE], unsigned& Tprev, LAS unsigned* selk, LAS int* selw, LAS unsigned* dmy, int& nsel, int lane, int nvalid) {
    unsigned L = Tprev, Kmax;
    { unsigned gm = 0u;
      if constexpr (NE == 36) {
          unsigned g4[4];
#pragma unroll
          for (int q = 0; q < 4; ++q) { unsigned g = ek[9 * q];
#pragma unroll
              for (int i = 1; i < 9; ++i) g = umax_(g, ek[9 * q + i]);
              g4[q] = g; }
          gm = umax_(umax_(g4[0], g4[1]), umax_(g4[2], g4[3]));
          const unsigned L2 = wave_minu(umin_(umin_(g4[0], g4[1]), umin_(g4[2], g4[3])));
          if (L2 > L) L = L2;
      } else {
#pragma unroll
          for (int i = 0; i < NE; ++i) gm = umax_(gm, ek[i]);
      }
      Kmax = wave_maxu(gm); }
    unsigned Tv = 0u; bool exact = false;
    int cHi = 0, cLo = nvalid, cBase = 0; bool compact = false; unsigned a0 = 0u, a1 = 0u, a2 = 0u, a3 = 0u;
    for (int bit = (nvalid > 256) ? 31 : -1; bit >= 0; --bit) {
        const unsigned cand = Tv | (1u << bit);
        if (cand <= L) { Tv = cand; continue; }
        if (cand > Kmax) continue;
        if constexpr (NE == 10) {
            if (bit >= 1) {
                const unsigned c1 = Tv | (1u << (bit - 1)), c3 = cand | (1u << (bit - 1));
                int l1 = 0, l2 = 0, l3 = 0, tmp; unsigned v1 = c1, v2 = cand, v3 = c3;
#define DSA_LT3(x) asm volatile("v_sub_co_u32_e32 %3, vcc, %4, %5\n\tv_addc_co_u32_e32 %0, vcc, 0, %0, vcc\n\tv_sub_co_u32_e32 %3, vcc, %4, %6\n\tv_addc_co_u32_e32 %1, vcc, 0, %1, vcc\n\t" \
                                "v_sub_co_u32_e32 %3, vcc, %4, %7\n\tv_addc_co_u32_e32 %2, vcc, 0, %2, vcc" : "+v"(l1), "+v"(l2), "+v"(l3), "=&v"(tmp) : "v"(x), "v"(v1), "v"(v2), "v"(v3) : "vcc");
#pragma unroll
                for (int i = 0; i < NE; ++i) { DSA_LT3(ek[i]) }
#undef DSA_LT3
                const int pk = wave_sum_i(l1 | (l2 << 10) | (l3 << 20));
                const int n1 = 64 * NE - (pk & 1023), n2 = 64 * NE - ((pk >> 10) & 1023), n3 = 64 * NE - (pk >> 20);
                int nsel_ = 0;
                if (n3 >= 256) { Tv = c3; nsel_ = n3; } else if (n2 >= 256) { Tv = cand; nsel_ = n2; } else if (n1 >= 256) { Tv = c1; nsel_ = n1; }
                --bit;
                if (nsel_ == 256) { exact = true; break; }
                continue;
            }
        }
        int tot;
        if (compact) {
            tot = cBase + __builtin_popcountll(__ballot(a0 >= cand)) + __builtin_popcountll(__ballot(a1 >= cand)) + __builtin_popcountll(__ballot(a2 >= cand)) + __builtin_popcountll(__ballot(a3 >= cand));
        } else {
            int lt0 = 0, lt1 = 0, tmp; unsigned cv = cand;
#define DSA_LT(acc, x) asm volatile("v_sub_co_u32_e32 %1, vcc, %2, %3\n\tv_addc_co_u32_e32 %0, vcc, 0, %0, vcc" : "+v"(acc), "=&v"(tmp) : "v"(x), "v"(cv) : "vcc");
#pragma unroll
            for (int i = 0; i < NE; i += 2) { DSA_LT(lt0, ek[i]) DSA_LT(lt1, ek[i + 1]) }
#undef DSA_LT
            tot = 64 * NE - wave_sum_i(lt0 + lt1);
        }
        if (tot >= 256) { Tv = cand; cLo = tot; if (tot == 256) { exact = true; break; } }
        else cHi = tot;
        if constexpr (NE == 36) {
            if (!compact && bit > 0 && cLo - cHi <= 256) {
                LAS unsigned* tk = selk + 256; const unsigned lo1 = Tv ? Tv : 1u, span = Tv + (1u << bit) - lo1; int ns = 0;
#pragma unroll
                for (int i = 0; i < NE; ++i) { const bool s_ = (ek[i] - lo1) < span; const unsigned long long mk_ = __ballot(s_);
                    const int pos_ = (int)__builtin_amdgcn_mbcnt_hi((unsigned)(mk_ >> 32), __builtin_amdgcn_mbcnt_lo((unsigned)mk_, (unsigned)ns));
                    *(s_ ? tk + pos_ : dmy) = ek[i]; ns += __builtin_popcountll(mk_); }
                { const unsigned r0 = tk[lane], r1 = tk[64 + lane], r2 = tk[128 + lane], r3 = tk[192 + lane];
                  a0 = (lane < ns) ? r0 : 0u; a1 = (64 + lane < ns) ? r1 : 0u; a2 = (128 + lane < ns) ? r2 : 0u; a3 = (192 + lane < ns) ? r3 : 0u; }
                compact = true; cBase = cHi;
            }
        }
    }
    int Xi = 0x7fffffff;
    if (!exact) {
        if (Tv == 0u) Tv = 1u;
        else {
            int cg = 0, ce = 0;
#pragma unroll
            for (int i = 0; i < NE; ++i) { cg += (ek[i] > Tv) ? 1 : 0; ce += (ek[i] == Tv) ? 1 : 0; }
            const int tg = wave_sum_i(cg), te = wave_sum_i(ce), need = 256 - tg;
            if (te != need) {
                int X = 0;
                for (int bit = 12; bit >= 0; --bit) {
                    const int cand = X | (1 << bit);
                    int cnt = 0;
#pragma unroll
                    for (int i = 0; i < NE; ++i) cnt += (ek[i] == Tv && ei[i] < cand) ? 1 : 0;
                    if (wave_sum_i(cnt) < need) X = cand;
                }
                Xi = X;
            }
        }
    }
    int run = 0;
#pragma unroll
    for (int i = 0; i < NE; ++i) { const bool s_ = (ek[i] > Tv) || (ek[i] == Tv && ei[i] <= Xi); const unsigned long long mk_ = __ballot(s_);
        const int pos_ = (int)__builtin_amdgcn_mbcnt_hi((unsigned)(mk_ >> 32), __builtin_amdgcn_mbcnt_lo((unsigned)mk_, (unsigned)run));
        const bool w_ = s_ && pos_ < 256;
        *(w_ ? selk + pos_ : dmy) = ek[i]; *(w_ ? selw + pos_ : (LAS int*)dmy) = ei[i]; run += __builtin_popcountll(mk_); }
    nsel = run > 256 ? 256 : run;
    Tprev = (run >= 256) ? Tv : 0u;
}
DI void dsa_item(int item, const bf16* z, bf16* O, LAS unsigned char* lds, int tid) {
    const int lane = tid & 63, w = __builtin_amdgcn_readfirstlane(tid >> 6);
    const int b = item & 1, tq0 = (item >> 1) * 8, tmax = tq0 + 7, tq = tq0 + w;
    const bf16* zb = z + (size_t)b * T * ZLD;
    const char* zbb = (const char*)zb;
    LAS unsigned* S = (LAS unsigned*)(lds + DS_S);
    LAS int* selw = (LAS int*)(lds + DS_SEL) + w * 256;
    LAS unsigned* selk = (LAS unsigned*)(lds + DS_P) + w * 1024;
    LAS float* pl = (LAS float*)(lds + DS_P) + w * 1024;
    LAS unsigned* dmy = (LAS unsigned*)(lds + DS_DMY) + w * 64 + lane;
    const int qq = lane >> 4, kq = lane >> 4, l15 = lane & 15;
    const int nchunk = (tmax >> 11) + 1;
    unsigned cs0 = 0u, cs1 = 0u, cs2 = 0u, cs3 = 0u; int ci0 = 0, ci1 = 0, ci2 = 0, ci3 = 0; int nsel = 0;
    unsigned Tprev = 0u;
    __syncthreads();
    bf16x8 af0, af1, ag0, ag1;
    { const int qa = l15 >> 2, ha = l15 & 3; const bf16* p = zb + (size_t)(tq0 + qa) * ZLD + Z_IQ + ha * 64 + 8 * kq;
      af0 = *(const bf16x8*)p; af1 = *(const bf16x8*)(p + 32); ag0 = *(const bf16x8*)(p + 4 * ZLD); ag1 = *(const bf16x8*)(p + 4 * ZLD + 32); }
#define DSA_KLOAD(b0, b1, c_, bt_) do { _Pragma("unroll") for (int i = 0; i < 8; ++i) { const int kl_ = (w + 8 * (8 * (bt_) + i)) * 16 + l15; \
        const unsigned ko_ = ((unsigned)((c_) * 2048 + kl_) * (unsigned)ZLD + (unsigned)(Z_IK + 8 * kq)) * 2u; b0[i] = *(const bf16x8*)(zbb + ko_); b1[i] = *(const bf16x8*)(zbb + ko_ + 64u); } } while (0)
#define DSA_KSCORE(b0, b1, c_, bt_) do { _Pragma("unroll") for (int i = 0; i < 8; ++i) { const int kl_ = (w + 8 * (8 * (bt_) + i)) * 16 + l15; \
        f32x4 cl = {0.f, 0.f, 0.f, 0.f}, ch = {0.f, 0.f, 0.f, 0.f}; \
        cl = MFMA16(af0, b0[i], cl); cl = MFMA16(af1, b1[i], cl); ch = MFMA16(ag0, b0[i], ch); ch = MFMA16(ag1, b1[i], ch); \
        const float sl = iwl0 * relu_i(cl[0]) + iwl1 * relu_i(cl[1]) + iwl2 * relu_i(cl[2]) + iwl3 * relu_i(cl[3]); \
        const float sh = iwh0 * relu_i(ch[0]) + iwh1 * relu_i(ch[1]) + iwh2 * relu_i(ch[2]) + iwh3 * relu_i(ch[3]); \
        S[qq * 2048 + kl_] = orderkey(sl); S[(4 + qq) * 2048 + kl_] = orderkey(sh); } } while (0)
    bf16x8 pb0[8], pb1[8];
    DSA_KLOAD(pb0, pb1, 0, 0);
#pragma unroll 1
    for (int c = 0; c < nchunk; ++c) {
        {
            float iwl0, iwl1, iwl2, iwl3, iwh0, iwh1, iwh2, iwh3;
            { const u32x2 a = *(const u32x2*)(zb + (size_t)(tq0 + qq) * ZLD + Z_IW), cc = *(const u32x2*)(zb + (size_t)(tq0 + 4 + qq) * ZLD + Z_IW);
              iwl0 = bflo(a.x); iwl1 = bfhi(a.x); iwl2 = bflo(a.y); iwl3 = bfhi(a.y); iwh0 = bflo(cc.x); iwh1 = bfhi(cc.x); iwh2 = bflo(cc.y); iwh3 = bfhi(cc.y); }
            bf16x8 qb0[8], qb1[8];
            const bool second = c * 2048 + 1024 <= tmax;
            if (second) { DSA_KLOAD(qb0, qb1, c, 1); DSA_KSCORE(pb0, pb1, c, 0); DSA_KSCORE(qb0, qb1, c, 1); }
            else DSA_KSCORE(pb0, pb1, c, 0);
        }
        if (c + 1 < nchunk) DSA_KLOAD(pb0, pb1, c + 1, 0);
        __syncthreads();
        unsigned sc[32];
        const int kbase = c * 2048 + lane * 4;
#pragma unroll
        for (int j = 0; j < 8; ++j) { const u32x4 v = *(const LAS u32x4*)(S + w * 2048 + j * 256 + lane * 4); const int key = kbase + j * 256;
            sc[j * 4 + 0] = (key + 0 <= tq) ? v.x : 0u; sc[j * 4 + 1] = (key + 1 <= tq) ? v.y : 0u;
            sc[j * 4 + 2] = (key + 2 <= tq) ? v.z : 0u; sc[j * 4 + 3] = (key + 3 <= tq) ? v.w : 0u; }
        __syncthreads();
        if (c * 2048 <= tq) {
            bool done = false;
            if (Tprev != 0u) {
                LAS unsigned* tk = selk + 256; LAS int* ti = (LAS int*)(selk + 640);
                int ns = 0;
#pragma unroll
                for (int i = 0; i < 32; ++i) { const bool s_ = sc[i] >= Tprev; const unsigned long long mk_ = __ballot(s_);
                    const int pos_ = (int)__builtin_amdgcn_mbcnt_hi((unsigned)(mk_ >> 32), __builtin_amdgcn_mbcnt_lo((unsigned)mk_, (unsigned)ns));
                    const bool w_ = s_ && pos_ < 384;
                    *(w_ ? tk + pos_ : dmy) = sc[i]; *(w_ ? ti + pos_ : (LAS int*)dmy) = kbase + (i >> 2) * 256 + (i & 3); ns += __builtin_popcountll(mk_); }
                if (ns <= 384) {
                    unsigned ek[10]; int ei[10];
                    ek[0] = cs0; ek[1] = cs1; ek[2] = cs2; ek[3] = cs3; ei[0] = ci0; ei[1] = ci1; ei[2] = ci2; ei[3] = ci3;
#pragma unroll
                    for (int j = 0; j < 6; ++j) { const int p_ = j * 64 + lane; const unsigned rk_ = tk[p_]; const int ri_ = ti[p_]; ek[4 + j] = (p_ < ns) ? rk_ : 0u; ei[4 + j] = (p_ < ns) ? ri_ : 0; }
                    dsa_select<10>(ek, ei, Tprev, selk, selw, dmy, nsel, lane, 640);
                    done = true;
                }
            }
            if (!done) {
                unsigned ek[36]; int ei[36];
                ek[0] = cs0; ek[1] = cs1; ek[2] = cs2; ek[3] = cs3; ei[0] = ci0; ei[1] = ci1; ei[2] = ci2; ei[3] = ci3;
#pragma unroll
                for (int i = 0; i < 32; ++i) { ek[4 + i] = sc[i]; ei[4 + i] = kbase + (i >> 2) * 256 + (i & 3); }
                dsa_select<36>(ek, ei, Tprev, selk, selw, dmy, nsel, lane, (c == 0) ? ((tq < 2047 ? tq : 2047) + 1) : 2304);
            }
            { const unsigned r0 = selk[lane], r1 = selk[64 + lane], r2 = selk[128 + lane], r3 = selk[192 + lane];
              cs0 = (lane < nsel) ? r0 : 0u; cs1 = (64 + lane < nsel) ? r1 : 0u; cs2 = (128 + lane < nsel) ? r2 : 0u; cs3 = (192 + lane < nsel) ? r3 : 0u; }
            ci0 = selw[lane]; ci1 = selw[64 + lane]; ci2 = selw[128 + lane]; ci3 = selw[192 + lane];
        }
    }
    {
        const float cs = 0.125f * LOG2E;
        bf16x8 qa0 = {0, 0, 0, 0, 0, 0, 0, 0}, qa1 = {0, 0, 0, 0, 0, 0, 0, 0};
        if (l15 < 4) { const bf16* p = zb + (size_t)tq * ZLD + Z_AQ + l15 * 64 + 8 * kq; qa0 = *(const bf16x8*)p; qa1 = *(const bf16x8*)(p + 32); }
        float mx0 = NEG_INF, mx1 = NEG_INF, mx2 = NEG_INF, mx3 = NEG_INF;
        const int kg = lane & 7, dc = lane >> 3;
#define DSA_AKLOAD(k0, k1, tg_) do { _Pragma("unroll") for (int t4 = 0; t4 < 4; ++t4) { const int jl_ = ((tg_) * 4 + t4) * 16 + l15; const int kraw_ = selw[jl_]; const int kidx_ = (jl_ < nsel) ? kraw_ : 0; \
        const unsigned ko_ = ((unsigned)kidx_ * (unsigned)ZLD + (unsigned)(Z_AK + 8 * kq)) * 2u; k0[t4] = *(const bf16x8*)(zbb + ko_); k1[t4] = *(const bf16x8*)(zbb + ko_ + 64u); } } while (0)
#define DSA_AKSCORE(k0, k1, tg_) do { _Pragma("unroll") for (int t4 = 0; t4 < 4; ++t4) { f32x4 c_ = {0.f, 0.f, 0.f, 0.f}; c_ = MFMA16(qa0, k0[t4], c_); c_ = MFMA16(qa1, k1[t4], c_); \
        const int jl_ = ((tg_) * 4 + t4) * 16 + l15; const bool valid_ = jl_ < nsel; \
        f32x4 sv_; sv_.x = valid_ ? c_[0] * cs : NEG_INF; sv_.y = valid_ ? c_[1] * cs : NEG_INF; sv_.z = valid_ ? c_[2] * cs : NEG_INF; sv_.w = valid_ ? c_[3] * cs : NEG_INF; \
        if (lane < 16) { *(LAS f32x4*)(pl + jl_ * 4) = sv_; mx0 = fmaxf(mx0, sv_.x); mx1 = fmaxf(mx1, sv_.y); mx2 = fmaxf(mx2, sv_.z); mx3 = fmaxf(mx3, sv_.w); } } } while (0)
#define DSA_VLOAD(vv, j0_) do { _Pragma("unroll") for (int i = 0; i < 8; ++i) { const int jl_ = (j0_) + 8 * i + kg; const int kraw_ = selw[jl_]; const int kidx_ = (jl_ < nsel) ? kraw_ : 0; \
        vv[i] = *(const u32x4*)(zbb + ((unsigned)kidx_ * (unsigned)ZLD + (unsigned)(Z_AV + 8 * dc)) * 2u); } } while (0)
        u32x4 va[8], vb[8];
        {
            bf16x8 ka0[4], ka1[4], kb0[4], kb1[4];
            DSA_AKLOAD(ka0, ka1, 0);
            if (64 < nsel) DSA_AKLOAD(kb0, kb1, 1);
            DSA_AKSCORE(ka0, ka1, 0);
            if (128 < nsel) DSA_AKLOAD(ka0, ka1, 2);
            if (64 < nsel) DSA_AKSCORE(kb0, kb1, 1);
            if (192 < nsel) DSA_AKLOAD(kb0, kb1, 3);
            DSA_VLOAD(va, 0);
            if (128 < nsel) DSA_AKSCORE(ka0, ka1, 2);
            if (64 < nsel) DSA_VLOAD(vb, 64);
            if (192 < nsel) DSA_AKSCORE(kb0, kb1, 3);
        }
        float mh[4], lh[4];
        mh[0] = fmaxf(__builtin_bit_cast(float, __builtin_amdgcn_readlane(__builtin_bit_cast(int, row16_max(mx0)), 0)), -1e30f);
        mh[1] = fmaxf(__builtin_bit_cast(float, __builtin_amdgcn_readlane(__builtin_bit_cast(int, row16_max(mx1)), 0)), -1e30f);
        mh[2] = fmaxf(__builtin_bit_cast(float, __builtin_amdgcn_readlane(__builtin_bit_cast(int, row16_max(mx2)), 0)), -1e30f);
        mh[3] = fmaxf(__builtin_bit_cast(float, __builtin_amdgcn_readlane(__builtin_bit_cast(int, row16_max(mx3)), 0)), -1e30f);
        LAS unsigned char* vtile = lds + DS_S + w * 8192;
        LAS unsigned short* pbl = (LAS unsigned short*)(vtile + 32 * VROWB);
        { float l0 = 0.f, l1 = 0.f, l2 = 0.f, l3 = 0.f;
#pragma unroll
          for (int rr = 0; rr < 4; ++rr) { const int jl = rr * 64 + lane; f32x4 sv = {0.f, 0.f, 0.f, 0.f};
              if (jl < nsel) { sv = *(const LAS f32x4*)(pl + jl * 4);
                  sv.x = ex2(sv.x - mh[0]); sv.y = ex2(sv.y - mh[1]); sv.z = ex2(sv.z - mh[2]); sv.w = ex2(sv.w - mh[3]);
                  l0 += sv.x; l1 += sv.y; l2 += sv.z; l3 += sv.w; }
              const unsigned p01 = pk2(sv.x, sv.y), p23 = pk2(sv.z, sv.w);
              pbl[jl] = (unsigned short)p01; pbl[256 + jl] = (unsigned short)(p01 >> 16); pbl[512 + jl] = (unsigned short)p23; pbl[768 + jl] = (unsigned short)(p23 >> 16); }
          l0 = row16_sumf(l0); l1 = row16_sumf(l1); l2 = row16_sumf(l2); l3 = row16_sumf(l3);
#define RL4(v) (__builtin_bit_cast(float, __builtin_amdgcn_readlane(__builtin_bit_cast(int, v), 0)) + __builtin_bit_cast(float, __builtin_amdgcn_readlane(__builtin_bit_cast(int, v), 16)) + \
                __builtin_bit_cast(float, __builtin_amdgcn_readlane(__builtin_bit_cast(int, v), 32)) + __builtin_bit_cast(float, __builtin_amdgcn_readlane(__builtin_bit_cast(int, v), 48)))
          lh[0] = RL4(l0); lh[1] = RL4(l1); lh[2] = RL4(l2); lh[3] = RL4(l3);
#undef RL4
        }
        f32x4 oacc[4];
#pragma unroll
        for (int dt = 0; dt < 4; ++dt) oacc[dt] = (f32x4){0.f, 0.f, 0.f, 0.f};
        const int pn = l15 < 4 ? l15 : 3, qd = l15 >> 2, pd = lane & 3;
#define DSA_PVHALF(vv, i0_, jb_) do { \
        _Pragma("unroll") for (int i = 0; i < 4; ++i) *(LAS u32x4*)(vtile + (8 * i + kg) * VROWB + dc * 16) = vv[(i0_) + i]; \
        u32x2 plo_ = *(const LAS u32x2*)(pbl + pn * 256 + (jb_) + 4 * kq), phi_ = *(const LAS u32x2*)(pbl + pn * 256 + (jb_) + 16 + 4 * kq); \
        u32x4 pw_; pw_.x = l15 < 4 ? plo_.x : 0u; pw_.y = l15 < 4 ? plo_.y : 0u; pw_.z = l15 < 4 ? phi_.x : 0u; pw_.w = l15 < 4 ? phi_.y : 0u; \
        const bf16x8 pf_ = __builtin_bit_cast(bf16x8, pw_); \
        _Pragma("unroll") for (int dt = 0; dt < 4; ++dt) { \
            const s16x4 lo_ = vtr(vtile + (4 * kq + qd) * VROWB + (16 * dt + 4 * pd) * 2), hi_ = vtr(vtile + (16 + 4 * kq + qd) * VROWB + (16 * dt + 4 * pd) * 2); \
            const bf16x8 vf_ = __builtin_shufflevector(lo_, hi_, 0, 1, 2, 3, 4, 5, 6, 7); \
            oacc[dt] = MFMA16(vf_, pf_, oacc[dt]); } } while (0)
#define DSA_VACC(vv, j0_) do { DSA_PVHALF(vv, 0, (j0_)); DSA_PVHALF(vv, 4, (j0_) + 32); } while (0)
        DSA_VACC(va, 0);
        if (128 < nsel) DSA_VLOAD(va, 128);
        if (64 < nsel) DSA_VACC(vb, 64);
        if (192 < nsel) DSA_VLOAD(vb, 192);
        if (128 < nsel) DSA_VACC(va, 128);
        if (192 < nsel) DSA_VACC(vb, 192);
        if (l15 < 4) {
            const float lsum = l15 == 0 ? lh[0] : l15 == 1 ? lh[1] : l15 == 2 ? lh[2] : lh[3];
            const float f = lsum > 0.f ? 1.f / lsum : 0.f;
            int l15o = l15; asm volatile("" : "+v"(l15o));
            bf16* op = O + ((size_t)b * T + tq) * 256 + l15o * 64 + 4 * kq;
#pragma unroll
            for (int dt = 0; dt < 4; ++dt) { u32x2 o; o.x = pk2(oacc[dt][0] * f, oacc[dt][1] * f); o.y = pk2(oacc[dt][2] * f, oacc[dt][3] * f); *(u32x2*)(op + 16 * dt) = o; }
        }
    }
    __syncthreads();
}


#ifndef N_LAUNCH_SPLIT
#define N_LAUNCH_SPLIT 0
#endif
constexpr int PH_PER_LAYER = 10, PH_TOTAL = DEPTH * PH_PER_LAYER + 1;

__global__ void __launch_bounds__(NWAVES * 64, 2) fwd_kernel(Args args) {
    extern __shared__ __attribute__((aligned(16))) unsigned char lds_raw[];
    LAS unsigned char* lds = (LAS unsigned char*)lds_raw;
    volatile LAS unsigned* MISC = (volatile LAS unsigned*)(lds + MISC_OFF);
#define G ((int)gridDim.x)
#define bx ((int)blockIdx.x)
#define gw ((int)blockIdx.x * NWAVES + wave)
#define NGW ((int)gridDim.x * NWAVES)
    for (int u = threadIdx.x; u < (LDS_BYTES - LDSCTL_OFF) / 4; u += NWAVES * 64) ((LAS unsigned*)(lds + LDSCTL_OFF))[u] = 0u;
    __syncthreads();
    XcdBarrier bar; bar.bar = (unsigned*)(args.ws + WS_CTL) + CW_BAR; bar.x = 0; bar.st = nullptr;
    if (!N_LAUNCH_SPLIT) bar = xcd_barrier_post((unsigned*)(args.ws + WS_CTL) + CW_BAR, MISC + 8);

#define x_in (args.in[0])
#define out (args.out)
#define cosT ((float*)(args.ws + WS_COS))
#define sinT ((float*)(args.ws + WS_SIN))
#define kmean ((float*)(args.ws + WS_KMEAN))
#define kcmp ((bf16*)(args.ws + WS_KCMP))
#define vcmp ((bf16*)(args.ws + WS_VCMP))
#define bias1p ((float*)(args.ws + WS_BIAS1))
#define Wb ((bf16*)(args.ws + WS_W))
#define H ((bf16*)(args.ws + WS_H))
#define Z ((bf16*)(args.ws + WS_Z))
#define HID ((bf16*)(args.ws + WS_HID))
#define GB ((bf16*)(args.ws + WS_GB))
#define MF ((float*)(args.ws + WS_MF))
#define XB ((bf16*)(args.ws + WS_XB))
#define SS ((float*)(args.ws + WS_SS))
#define RLP ((G == 256) ? (const LAS float*)(lds + LDSCTL_OFF + 2048) : (const LAS float*)nullptr)
#define RINV_FILL() do { if (G == 256) { LAS float* RL_ = (LAS float*)(lds + LDSCTL_OFF + 2048); const int rb_ = (bx & 7) * 2048; \
        for (int rr_ = tid; rr_ < 2048; rr_ += NWAVES * 64) { const f32x4* p_ = (const f32x4*)(SS + (size_t)(rb_ + rr_) * 16); const f32x4 s4_ = (p_[0] + p_[1]) + (p_[2] + p_[3]); \
            RL_[rr_] = __builtin_amdgcn_rsqf(((s4_[0] + s4_[1]) + (s4_[2] + s4_[3])) * (1.f / D) + NORM_EPS); } \
        __syncthreads(); } } while (0)
#define CQN ((bf16*)(args.ws + WS_CQN))
#define OA ((bf16*)(args.ws + WS_O))
#define OB ((bf16*)(args.ws + WS_O) + (size_t)M * 256)
#define OC ((bf16*)(args.ws + WS_O) + (size_t)M * 512)
    const int lo = args.ph_lo, hi = args.ph_hi;
    int seq = 0;
#define PH_ON (seq >= lo && seq < hi)
#define PH_END do { if (PH_ON && seq + 1 < hi) xcd_barrier(bar); ++seq; } while (0)

    if (lo == 0) rope_table(cosT, sinT, bx * (NWAVES * 64) + (int)threadIdx.x, G * NWAVES * 64);
#pragma unroll 1
    for (int l = 0; l < DEPTH; ++l) {
#pragma unroll 1
        for (int f = 0; f < 2; ++f) {
            if (f == 0) {
                if (PH_ON) { int tid = threadIdx.x; asm volatile("" : "+v"(tid)); const int lane = tid & 63, wave = __builtin_amdgcn_readfirstlane(tid >> 6); (void)lane; (void)wave;
                    convert_weights(args, l, Wb, bias1p, lds, gw, NGW, wave, lane, tid);
                    if (l == 0) { int m = gw; for (; m + 3 * NGW < M; m += 4 * NGW) xb_init_rows4(x_in, XB, SS, (size_t)m, (size_t)NGW, lane); for (; m < M; m += NGW) xb_init_rows4(x_in, XB, SS, (size_t)m, 0, lane); }
                }
                PH_END;
            }
            if (PH_ON) { int tid = threadIdx.x; asm volatile("" : "+v"(tid)); const int lane = tid & 63, wave = __builtin_amdgcn_readfirstlane(tid >> 6); (void)lane; (void)wave;
                pg8::Gemm g{XB, Wb + (f ? W_UP2 : W_UP1), M, 2 * DFF, D}; pg8::StaticOrder S; S.init(M, 2 * DFF, G, bx);
                RINV_FILL();
                pg8::EpiSwiGLU E{HID, DFF, SS, RLP};
                pg8::gemm_phase<pg8::EpiSwiGLU, pg8::StaticOrder, true, true>(lds, g, S, E);
            }
            PH_END;
            if (PH_ON) { int tid = threadIdx.x; asm volatile("" : "+v"(tid)); const int lane = tid & 63, wave = __builtin_amdgcn_readfirstlane(tid >> 6); (void)lane; (void)wave;
                pg8::Gemm g{HID, Wb + (f ? W_DN2 : W_DN1), M, D, DFF}; pg8::StaticOrder S; S.init(M, D, G, bx);
                pg8::EpiResid E{XB, XB, 0.5f, SS};
                pg8::gemm_phase<pg8::EpiResid, pg8::StaticOrder, true, true>(lds, g, S, E);
            }
            PH_END;
            if (f == 0) {
                if (PH_ON) { int tid = threadIdx.x; asm volatile("" : "+v"(tid)); const int lane = tid & 63, wave = __builtin_amdgcn_readfirstlane(tid >> 6); (void)lane; (void)wave;
                    pg8::Gemm g{XB, Wb + W_IN, M, ZLD, D}; pg8::StaticOrder S; S.init(M, ZLD, G, bx);
                    RINV_FILL();
                    pg8::EpiZin E{Z, CQN, cosT, sinT, SS, RLP};
                    pg8::gemm_phase<pg8::EpiZin, pg8::StaticOrder, true, true>(lds, g, S, E);
                }
                PH_END;
                if (PH_ON) { int tid = threadIdx.x; asm volatile("" : "+v"(tid)); const int lane = tid & 63, wave = __builtin_amdgcn_readfirstlane(tid >> 6); (void)lane; (void)wave;
                    constexpr int N_CMP = 128, N_KM = 64, N_DSA = M / 8, N_IT = N_CMP + N_KM + N_DSA;
                    {
                        const bool perx = (G == 256);
                        unsigned* qctr = (unsigned*)(args.ws + WS_CTL) + 8192 + (l * 8 + (perx ? (bx & 7) : 0)) * 16;
                        const int qlim = perx ? N_IT / 8 : N_IT;
                        for (;;) {
                            __syncthreads();
                            if (tid == 0) MISC[16] = atomicAdd(qctr, 1u);
                            __syncthreads();
                            const int U = (int)MISC[16];
                            if (U >= qlim) break;
                            const int x = perx ? (bx & 7) : U / (N_IT / 8), uu = perx ? U : U % (N_IT / 8);
                            const int it = (uu < (N_CMP + N_KM) / 8) ? x + 8 * uu : N_CMP + N_KM + x + 8 * (N_DSA / 8 - 1 - (uu - (N_CMP + N_KM) / 8));
                            if (it < N_CMP) compress_item(it, Z, Wb, bias1p, kcmp, vcmp, lds, tid);
                            else if (it < N_CMP + N_KM) kmean_item(it - N_CMP, Z, kmean, lds, tid);
                            else dsa_item(it - N_CMP - N_KM, Z, OA, lds, tid);
                        }
                    }
                }
                PH_END;
                if (PH_ON) { int tid = threadIdx.x; asm volatile("" : "+v"(tid)); const int lane = tid & 63, wave = __builtin_amdgcn_readfirstlane(tid >> 6); (void)lane; (void)wave;
                    LAS unsigned char* wl = lds + wave * NSA_WLDS;
                    {
                        const bool perx = (G == 256);
                        unsigned* qctr = (unsigned*)(args.ws + WS_CTL) + 9216 + (l * 8 + (perx ? (bx & 7) : 0)) * 16;
                        const int qlim = perx ? 96 : 768;
                        for (;;) {
                            __syncthreads();
                            if (tid == 0) MISC[16] = atomicAdd(qctr, 1u);
                            __syncthreads();
                            const int U = (int)MISC[16];
                            if (U >= qlim) break;
                            const int x = perx ? (bx & 7) : U / 96, uu = perx ? U : U % 96;
                            if (uu < 64) { const int par = x >> 2, bg = x & 3;
                                const int tile = (uu < 32) ? 127 - par - 2 * uu : 62 + par - 2 * (uu - 32);
                                nsa_block_unit(bg >> 1, bg & 1, 64 * tile, Z, CQN, kcmp, vcmp, OC, lds, tid); }
                            else { const int own = 31 - (uu - 64);
                                moba_block_item(x >> 2, x & 3, own, own * 8 + x, Z, kmean, OB, (float*)(args.ws + WS_PART), lds, tid); }
                        }
                    }
                }
                PH_END;
                for (int c = 0; c < 6; ++c) {
                    if (PH_ON) { int tid = threadIdx.x; asm volatile("" : "+v"(tid)); (void)tid;
                        if (c == 0) RINV_FILL();
                        const int i = c >> 1;
                        pg8::Gemm g; g.M = M; g.N = D;
                        if ((c & 1) == 0) { g.A = XB; g.Bt = Wb + W_G + (size_t)i * D * D; g.K = D; }
                        else if (i == 0) { g.A = OA; g.Bt = Wb + W_A; g.K = 256; }
                        else if (i == 1) { g.A = OB; g.Bt = Wb + W_B; g.K = 256; }
                        else { g.A = OC; g.Bt = Wb + W_C; g.K = 512; }
                        pg8::StaticOrder S; S.init(M, D, G, bx);
                        if ((c & 1) == 0) { pg8::EpiMerge<0> E{GB, MF, SS, RLP}; pg8::gemm_phase<pg8::EpiMerge<0>, pg8::StaticOrder, true, true>(lds, g, S, E); }
                        else if (i == 0) { pg8::EpiMerge<1> E{GB, MF, SS, RLP}; pg8::gemm_phase<pg8::EpiMerge<1>, pg8::StaticOrder, true, true>(lds, g, S, E); }
                        else if (i == 1) { pg8::EpiMerge<2> E{GB, MF, SS, RLP}; pg8::gemm_phase<pg8::EpiMerge<2>, pg8::StaticOrder, true, true>(lds, g, S, E); }
                        else { pg8::EpiMerge<3> E{GB, MF, SS, RLP}; pg8::gemm_phase<pg8::EpiMerge<3>, pg8::StaticOrder, true, true>(lds, g, S, E); }
                        VM_WAIT(); __syncthreads();
                    }
                }
                PH_END;
                if (PH_ON) { int tid = threadIdx.x; asm volatile("" : "+v"(tid)); const int lane = tid & 63, wave = __builtin_amdgcn_readfirstlane(tid >> 6); (void)lane; (void)wave;
                    pg8::Gemm g{GB, Wb + W_O, M, D, D}; pg8::StaticOrder S; S.init(M, D, G, bx);
                    pg8::EpiResid E{XB, XB, 1.0f, SS};
                    pg8::gemm_phase<pg8::EpiResid, pg8::StaticOrder, true, true>(lds, g, S, E);
                }
                PH_END;
            }
        }
    }
    if (PH_ON) { int tid = threadIdx.x; asm volatile("" : "+v"(tid)); const int lane = tid & 63, wave = __builtin_amdgcn_readfirstlane(tid >> 6); (void)lane; (void)wave; for (int m = gw; m < M; m += NGW) rms_row_b2f(XB + (size_t)m * D, args.in[21], out + (size_t)m * D, lane); }
#undef PH_ON
#undef PH_END
#undef x_in
#undef out
#undef cosT
#undef sinT
#undef kmean
#undef kcmp
#undef vcmp
#undef bias1p
#undef Wb
#undef H
#undef Z
#undef HID
#undef GB
#undef MF
#undef CQN
#undef OA
#undef OB
#undef OC
#undef gw
#undef NGW
#undef G
#undef bx
}

extern "C" void kernel_launch(void* const* d_in, const int* in_sizes, int n_in, void* d_out, int out_size, void* d_ws, size_t ws_size, hipStream_t stream) {
    static int grid = 0;
    if (grid == 0) {
        if (n_in != 22 || out_size != M * D || ws_size < WS_END) { fprintf(stderr, "kernel_launch: unexpected shapes (n_in %d, out %d, ws %zu, need %zu)\n", n_in, out_size, ws_size, (size_t)WS_END); grid = -1; return; }
        int dev = 0, cus = 0, per_cu = 0;
        if (hipGetDevice(&dev) != hipSuccess || hipDeviceGetAttribute(&cus, hipDeviceAttributeMultiprocessorCount, dev) != hipSuccess) { grid = -1; return; }
        if (hipFuncSetAttribute((const void*)fwd_kernel, hipFuncAttributeMaxDynamicSharedMemorySize, LDS_BYTES) != hipSuccess) { fprintf(stderr, "kernel_launch: hipFuncSetAttribute failed\n"); grid = -1; return; }
        if (hipOccupancyMaxActiveBlocksPerMultiprocessor(&per_cu, (const void*)fwd_kernel, NWAVES * 64, LDS_BYTES) != hipSuccess || per_cu < 1)
            fprintf(stderr, "kernel_launch: occupancy query reports %d workgroups per CU\n", per_cu);
        (void)hipGetLastError();
        grid = cus;
    }
    if (grid < 0) return;
    if (hipMemsetAsync((char*)d_ws + WS_CTL, 0, CTL_ZERO_BYTES, stream) != hipSuccess) return;
    Args a{};
    for (int i = 0; i < 22; ++i) a.in[i] = (const float*)d_in[i];
    a.out = (float*)d_out; a.ws = (unsigned char*)d_ws;
#if N_LAUNCH_SPLIT
    for (int p = 0; p < PH_TOTAL; ++p) { a.ph_lo = p; a.ph_hi = p + 1; hipLaunchKernelGGL(fwd_kernel, dim3(grid), dim3(NWAVES * 64), LDS_BYTES, stream, a); }
#else
    a.ph_lo = 0; a.ph_hi = PH_TOTAL;
    hipLaunchKernelGGL(fwd_kernel, dim3(grid), dim3(NWAVES * 64), LDS_BYTES, stream, a);
#endif
}
```

```cpp
#include <hip/hip_runtime.h>
#include <cstdio>
#include <cstdint>

constexpr int BATCH = 2, T = 8192, D = 1024, DEPTH = 4, DFF = 2816, M = BATCH * T;
constexpr int IN_COLS = 5852;
constexpr float NORM_EPS = 1e-6f;
constexpr int ZLD = 2816;
constexpr int Z_AQ = 0, Z_AK = 256, Z_IQ = 320, Z_IK = 576, Z_BQ = 640, Z_BK = 896, Z_CQ = 1152, Z_KS = 1664, Z_KW = 1792, Z_ROPE_END = 1920;
constexpr int Z_AV = 1920, Z_BV = 1984, Z_KC = 2240, Z_VC = 2368, Z_VS = 2496, Z_VW = 2624, Z_IW = 2752, Z_CG = 2756, Z_END = 2780;
constexpr int O_A = 0, O_B = 256, O_C = 512;

namespace pg8 {
#define PG8_LAS __attribute__((address_space(3)))
typedef unsigned short bf16_t;
typedef short bf16x8 __attribute__((ext_vector_type(8)));
typedef float f32x4 __attribute__((ext_vector_type(4)));
typedef unsigned u32x4 __attribute__((ext_vector_type(4)));
constexpr int BM = 256, BK = 64, HALF = 128, HTB = HALF * BK * 2  , STAGE_BYTES = 8 * HTB, NXCD = 8, WGM = 8;

__host__ __device__ __forceinline__ int lds_byte(int r, int c) { const int st = (r >> 4) * 2 + (c >> 5), rr = r & 15, cc = c & 31, ob = rr * 64 + cc * 2; return st * 1024 + (ob ^ (((ob >> 9) & 1) << 5)); }
__host__ __device__ __forceinline__ void stage_rc(int b, int& R, int& C) { const int st = b / 1024, sb = b % 1024, swz = sb ^ (((sb >> 9) & 1) << 5); R = (st >> 1) * 16 + swz / 64; C = (st & 1) * 32 + (swz % 64) / 2; }
__host__ __device__ __forceinline__ int perm32(int rho) { const int n = rho >> 4, i = rho & 15; return 8 * (i >> 2) + 4 * n + (i & 3); }

struct Unit { int pm, pn; };
struct Gemm { const bf16_t* A; const bf16_t* Bt; int M, N, K; };

struct StaticOrder {
    int nM, nN, nwg, G, c;
    __host__ __device__ void init(int M, int N, int G_, int c_) { nM = M / BM; nN = N / BM; nwg = nM * nN; G = G_; c = c_; }
    __host__ __device__ bool next(int i, Unit& u) const {
        const long L = (long)i * G + c; if (L >= nwg) return false;
        int wgid = (int)L; { const int q = nwg / NXCD, r = nwg % NXCD, xcd = wgid % NXCD, off = wgid / NXCD; wgid = (xcd < r ? xcd * (q + 1) : r * (q + 1) + (xcd - r) * q) + off; }
        const int nig = WGM * nN, gid = wgid / nig, fm = gid * WGM, gsz = (nM - fm) < WGM ? (nM - fm) : WGM;
        u.pm = fm + ((wgid % nig) % gsz); u.pn = (wgid % nig) / gsz; return true;
    }
    __device__ __forceinline__ void a_ready(const Unit&) const {}
    __device__ __forceinline__ void done(const Unit&) const {}
};

typedef float f32x2_ __attribute__((ext_vector_type(2)));
typedef __bf16 bf16x2_ __attribute__((ext_vector_type(2)));
__device__ __forceinline__ unsigned cvt_pk_bf16(float lo, float hi) { f32x2_ v = {lo, hi}; bf16x2_ b = __builtin_convertvector(v, bf16x2_); return __builtin_bit_cast(unsigned, b); }
__device__ __forceinline__ float bf_lo(unsigned u) { return __builtin_bit_cast(float, u << 16); }
__device__ __forceinline__ float bf_hi(unsigned u) { return __builtin_bit_cast(float, u & 0xffff0000u); }
__device__ __forceinline__ float fast_sigmoid(float v) { return __builtin_amdgcn_rcpf(1.f + __builtin_amdgcn_exp2f(-1.4426950408889634f * v)); }
typedef unsigned u32x2 __attribute__((ext_vector_type(2)));

__device__ __forceinline__ void row_rinv8(const float* ss, const PG8_LAS float* rl, int row0, int fq, int lane, float (&rinv)[8]) {
    if (rl) {
#pragma unroll
        for (int ri = 0; ri < 8; ++ri) rinv[ri] = rl[(row0 + (ri >> 2) * HALF + (ri & 3) * 16) & 2047];
        return; }
    float mine[2];
#pragma unroll
    for (int t = 0; t < 2; ++t) { const int row = row0 + (fq >> 1) * HALF + (2 * (fq & 1) + t) * 16; const f32x4* p = (const f32x4*)(ss + (size_t)row * 16);
        const f32x4 s4 = (p[0] + p[1]) + (p[2] + p[3]); mine[t] = __builtin_amdgcn_rsqf(((s4[0] + s4[1]) + (s4[2] + s4[3])) * (1.f / D) + NORM_EPS); }
#pragma unroll
    for (int ri = 0; ri < 8; ++ri) rinv[ri] = __shfl(mine[ri & 1], (lane & 15) + 16 * (ri >> 1));
}
struct EpiSwiGLU {
    static constexpr bool PERM = true, AFTER_DRAIN = false;
    bf16_t* H; int ldh; const float* ss; const PG8_LAS float* rl;
    __device__ __forceinline__ void operator()(const f32x4 (&acc)[2][2][4][2], const Unit& u, int wr, int wc, int fr, int fq) const {
        const int row0 = u.pm * BM + wr * 64 + fr, col0 = u.pn * BM + wc * 32 + 8 * fq;
        float rinv[8]; row_rinv8(ss, rl, row0, fq, fq * 16 + fr, rinv);
#pragma unroll
        for (int ai = 0; ai < 2; ++ai)
#pragma unroll
            for (int m = 0; m < 4; ++m) { const unsigned rowb = (unsigned)(row0 + ai * HALF + m * 16) * (unsigned)ldh * 2u; const float ri = rinv[ai * 4 + m];
                u32x2 ob[2];
#pragma unroll
                for (int bj = 0; bj < 2; ++bj) { const f32x4 v0 = acc[ai][bj][m][0] * ri, v1 = acc[ai][bj][m][1] * ri;
                    const float h0 = v0[0] * fast_sigmoid(v0[0]) * v0[1], h1 = v0[2] * fast_sigmoid(v0[2]) * v0[3];
                    const float h2 = v1[0] * fast_sigmoid(v1[0]) * v1[1], h3 = v1[2] * fast_sigmoid(v1[2]) * v1[3];
                    ob[bj].x = cvt_pk_bf16(h0, h1); ob[bj].y = cvt_pk_bf16(h2, h3); }
                const bool odd = fq & 1;
                const u32x2 snd = odd ? ob[0] : ob[1];
                u32x2 rcv; rcv.x = (unsigned)__shfl_xor((int)snd.x, 16); rcv.y = (unsigned)__shfl_xor((int)snd.y, 16);
                u32x4 o4; o4.x = odd ? rcv.x : ob[0].x; o4.y = odd ? rcv.y : ob[0].y; o4.z = odd ? ob[1].x : rcv.x; o4.w = odd ? ob[1].y : rcv.y;
                const unsigned colo = (unsigned)(((col0 - (odd ? 8 : 0)) + (odd ? HALF : 0)) >> 1) * 2u;
                *(u32x4*)((char*)H + rowb + colo) = o4; }
    }
};
struct EpiResid {
    static constexpr bool PERM = true, AFTER_DRAIN = false;
    const bf16_t* src; bf16_t* dst; float scale; float* ss;
    __device__ __forceinline__ void operator()(const f32x4 (&acc)[2][2][4][2], const Unit& u, int wr, int wc, int fr, int fq) const {
        const int row0 = u.pm * BM + wr * 64 + fr, col0 = u.pn * BM + wc * 32 + 8 * fq;
#pragma unroll
        for (int ai = 0; ai < 2; ++ai)
#pragma unroll
            for (int m = 0; m < 4; ++m) { const int row = row0 + ai * HALF + m * 16; const unsigned ro = ((unsigned)row * (unsigned)D + (unsigned)col0) * 2u; float sq = 0.f;
#pragma unroll
                for (int bj = 0; bj < 2; ++bj) { const unsigned o = ro + (unsigned)(bj * HALF) * 2u; f32x4 v0 = acc[ai][bj][m][0] * scale, v1 = acc[ai][bj][m][1] * scale;
                    const u32x4 so = *(const u32x4*)((const char*)src + o);
                    v0[0] += bf_lo(so.x); v0[1] += bf_hi(so.x); v0[2] += bf_lo(so.y); v0[3] += bf_hi(so.y); v1[0] += bf_lo(so.z); v1[1] += bf_hi(so.z); v1[2] += bf_lo(so.w); v1[3] += bf_hi(so.w);
                    sq += ((v0[0] * v0[0] + v0[1] * v0[1]) + (v0[2] * v0[2] + v0[3] * v0[3])) + ((v1[0] * v1[0] + v1[1] * v1[1]) + (v1[2] * v1[2] + v1[3] * v1[3]));
                    u32x4 r; r.x = cvt_pk_bf16(v0[0], v0[1]); r.y = cvt_pk_bf16(v0[2], v0[3]); r.z = cvt_pk_bf16(v1[0], v1[1]); r.w = cvt_pk_bf16(v1[2], v1[3]);
                    *(u32x4*)((char*)dst + o) = r; }
                sq += __shfl_xor(sq, 16); sq += __shfl_xor(sq, 32);
                if (fq == 0) ss[(size_t)row * 16 + u.pn * 4 + wc] = sq; }
    }
};
struct EpiZin {
    static constexpr bool PERM = true, AFTER_DRAIN = false;
    bf16_t* Z; bf16_t* CQN; const float* cosT; const float* sinT; const float* ss; const PG8_LAS float* rl;
    __device__ __forceinline__ void operator()(const f32x4 (&acc)[2][2][4][2], const Unit& u, int wr, int wc, int fr, int fq) const {
        const int row0 = u.pm * BM + wr * 64 + fr, col0 = u.pn * BM + wc * 32 + 8 * fq;
        float rinv[8]; row_rinv8(ss, rl, row0, fq, fq * 16 + fr, rinv);
#pragma unroll
        for (int ai = 0; ai < 2; ++ai)
#pragma unroll
            for (int m = 0; m < 4; ++m) { const int row = row0 + ai * HALF + m * 16; const int pos = row & (T - 1); const float ri = rinv[ai * 4 + m];
#pragma unroll
                for (int bj = 0; bj < 2; ++bj) { const int col = col0 + bj * HALF; f32x4 v0 = acc[ai][bj][m][0] * ri, v1 = acc[ai][bj][m][1] * ri;
                    if (col < Z_ROPE_END) {
                        if (col >= Z_CQ && col < Z_KS) { u32x4 r; r.x = cvt_pk_bf16(v0[0], v0[1]); r.y = cvt_pk_bf16(v0[2], v0[3]); r.z = cvt_pk_bf16(v1[0], v1[1]); r.w = cvt_pk_bf16(v1[2], v1[3]);
                            *(u32x4*)((char*)CQN + ((unsigned)row * 512u + (unsigned)(col - Z_CQ)) * 2u) = r; }
                        const int i0 = (col & 63) >> 1;
                        const f32x4 c = *(const f32x4*)(cosT + pos * 32 + i0), s = *(const f32x4*)(sinT + pos * 32 + i0);
                        f32x4 w0, w1;
                        w0[0] = v0[0] * c[0] - v0[1] * s[0]; w0[1] = v0[0] * s[0] + v0[1] * c[0];
                        w0[2] = v0[2] * c[1] - v0[3] * s[1]; w0[3] = v0[2] * s[1] + v0[3] * c[1];
                        w1[0] = v1[0] * c[2] - v1[1] * s[2]; w1[1] = v1[0] * s[2] + v1[1] * c[2];
                        w1[2] = v1[2] * c[3] - v1[3] * s[3]; w1[3] = v1[2] * s[3] + v1[3] * c[3];
                        v0 = w0; v1 = w1;
                    } else if (col >= Z_IW) {
#pragma unroll
                        for (int e = 0; e < 4; ++e) { if (col + e >= Z_CG) v0[e] = fast_sigmoid(v0[e]); if (col + 4 + e >= Z_CG) v1[e] = fast_sigmoid(v1[e]); }
                    }
                    u32x4 r; r.x = cvt_pk_bf16(v0[0], v0[1]); r.y = cvt_pk_bf16(v0[2], v0[3]); r.z = cvt_pk_bf16(v1[0], v1[1]); r.w = cvt_pk_bf16(v1[2], v1[3]);
                    *(u32x4*)((char*)Z + ((unsigned)row * (unsigned)ZLD + (unsigned)col) * 2u) = r; } asm volatile("" ::: "memory"); }
    }
};
template <int MODE> struct EpiMerge {
    static constexpr bool PERM = true, AFTER_DRAIN = false;
    bf16_t* Gb; float* Mf; const float* ss; const PG8_LAS float* rl;
    __device__ __forceinline__ void operator()(const f32x4 (&acc)[2][2][4][2], const Unit& u, int wr, int wc, int fr, int fq) const {
        const int row0 = u.pm * BM + wr * 64 + fr, col0 = u.pn * BM + wc * 32 + 8 * fq;
        float rinv[8];
        if constexpr (MODE == 0) row_rinv8(ss, rl, row0, fq, fq * 16 + fr, rinv);
#pragma unroll
        for (int ai = 0; ai < 2; ++ai)
#pragma unroll
            for (int m = 0; m < 4; ++m) { const unsigned ro = ((unsigned)(row0 + ai * HALF + m * 16) * (unsigned)D + (unsigned)col0) * 2u;
#pragma unroll
                for (int bj = 0; bj < 2; ++bj) { const unsigned o = ro + (unsigned)(bj * HALF) * 2u; f32x4 v0 = acc[ai][bj][m][0], v1 = acc[ai][bj][m][1];
                    if constexpr (MODE == 0) {
#pragma unroll
                        for (int e = 0; e < 4; ++e) { v0[e] = fast_sigmoid(v0[e] * rinv[ai * 4 + m]); v1[e] = fast_sigmoid(v1[e] * rinv[ai * 4 + m]); }
                        u32x4 r; r.x = cvt_pk_bf16(v0[0], v0[1]); r.y = cvt_pk_bf16(v0[2], v0[3]); r.z = cvt_pk_bf16(v1[0], v1[1]); r.w = cvt_pk_bf16(v1[2], v1[3]);
                        *(u32x4*)((char*)Gb + o) = r;
                    } else {
                        const u32x4 g = *(const u32x4*)((const char*)Gb + o);
                        v0[0] *= bf_lo(g.x); v0[1] *= bf_hi(g.x); v0[2] *= bf_lo(g.y); v0[3] *= bf_hi(g.y);
                        v1[0] *= bf_lo(g.z); v1[1] *= bf_hi(g.z); v1[2] *= bf_lo(g.w); v1[3] *= bf_hi(g.w);
                        bf16_t* Mb = (bf16_t*)Mf;
                        if constexpr (MODE >= 2) { const u32x4 mo = *(const u32x4*)((const char*)Mb + o);
                            v0[0] += bf_lo(mo.x); v0[1] += bf_hi(mo.x); v0[2] += bf_lo(mo.y); v0[3] += bf_hi(mo.y); v1[0] += bf_lo(mo.z); v1[1] += bf_hi(mo.z); v1[2] += bf_lo(mo.w); v1[3] += bf_hi(mo.w); }
                        u32x4 r; r.x = cvt_pk_bf16(v0[0], v0[1]); r.y = cvt_pk_bf16(v0[2], v0[3]); r.z = cvt_pk_bf16(v1[0], v1[1]); r.w = cvt_pk_bf16(v1[2], v1[3]);
                        if constexpr (MODE == 3) *(u32x4*)((char*)Gb + o) = r; else *(u32x4*)((char*)Mb + o) = r;
                    } } }
    }
};

template <class Epi, class Sched, bool ALIGN_EPI = false, bool SP2 = false>
__device__ __forceinline__ void gemm_phase(PG8_LAS unsigned char* lds, const Gemm g, const Sched& S, const Epi& E) {
    int tid_o = threadIdx.x; asm volatile("" : "+v"(tid_o)); const int tid = tid_o, wid = __builtin_amdgcn_readfirstlane(tid >> 6), lane = tid & 63, wr = wid >> 2, wc = wid & 3, fr = lane & 15, fq = lane >> 4;
    const int K = g.K, nt = K / BK;
    unsigned voffA[2], voffB[2];
#pragma unroll
    for (int i = 0; i < 2; ++i) { int R, C; stage_rc(tid * 16 + i * 8192, R, C); const int Rb = Epi::PERM ? ((R & ~31) + perm32(R & 31)) : R;
        voffA[i] = (unsigned)(R * K + C) * 2u; voffB[i] = (unsigned)(Rb * K + C) * 2u; }
    const size_t kstep = (size_t)(BK * 2);
    const size_t hstep = (size_t)HALF * K * 2;
    const size_t tstep = 2 * hstep;
    const unsigned ldsw = (unsigned)wid * 1024u;
    const int aoff = lds_byte(wr * 64 + fr, fq * 8), boff = lds_byte(wc * 32 + fr, fq * 8);
#define PG8_SA(b, h) (((b) * 2 + (h)) * HTB)
#define PG8_SB(b, h) ((4 + (b) * 2 + (h)) * HTB)
#define PG8_STAGE(bufoff, gbase, voff) do { _Pragma("unroll") for (int _i = 0; _i < 2; ++_i) \
        __builtin_amdgcn_global_load_lds((const unsigned*)((const char*)(gbase) + (voff)[_i]), (PG8_LAS unsigned*)(lds + (bufoff) + ldsw + _i * 8192), 16, 0, 0); } while (0)
#define PG8_LDA(dst, b, h) do { _Pragma("unroll") for (int m = 0; m < 4; ++m) _Pragma("unroll") for (int k = 0; k < 2; ++k) dst[m][k] = *(const PG8_LAS bf16x8*)(lds + PG8_SA(b, h) + aoff + m * 2048 + k * 1024); } while (0)
#define PG8_LDB(dst, b, h) do { _Pragma("unroll") for (int n = 0; n < 2; ++n) _Pragma("unroll") for (int k = 0; k < 2; ++k) dst[n][k] = *(const PG8_LAS bf16x8*)(lds + PG8_SB(b, h) + boff + n * 2048 + k * 1024); } while (0)
#define PG8_MMA(ai, bj, At, Bt) do { __builtin_amdgcn_s_setprio(1); _Pragma("unroll") for (int m = 0; m < 4; ++m) _Pragma("unroll") for (int n = 0; n < 2; ++n) _Pragma("unroll") for (int k = 0; k < 2; ++k) \
        acc[ai][bj][m][n] = __builtin_amdgcn_mfma_f32_16x16x32_bf16(Bt[n][k], At[m][k], acc[ai][bj][m][n], 0, 0, 0); __builtin_amdgcn_s_setprio(0); } while (0)
#define PG8_WAIT_V(n) asm volatile("s_waitcnt vmcnt(" #n ")" ::: "memory")
#define PG8_WAIT_L(n) asm volatile("s_waitcnt lgkmcnt(" #n ")" ::: "memory")
#define PG8_BAR __builtin_amdgcn_s_barrier()
#define PG8_SCHED __builtin_amdgcn_sched_barrier(0)
    Unit cur, nxt; int ui = 0;
    if (!S.next(0, cur)) return;
    f32x4 acc[2][2][4][2];
#pragma unroll
    for (int a = 0; a < 2; ++a)
#pragma unroll
        for (int b = 0; b < 2; ++b)
#pragma unroll
            for (int m = 0; m < 4; ++m)
#pragma unroll
                for (int n = 0; n < 2; ++n) acc[a][b][m][n] = (f32x4){0.f, 0.f, 0.f, 0.f};
    bf16x8 At[4][2], B0[2][2], B1[2][2];
    const char* cA = (const char*)g.A + (size_t)cur.pm * tstep; const char* cB = (const char*)g.Bt + (size_t)cur.pn * tstep;
    S.a_ready(cur);
    if constexpr (SP2) {
        PG8_STAGE(PG8_SB(0, 0), cB, voffB); PG8_STAGE(PG8_SB(0, 1), cB + hstep, voffB); PG8_STAGE(PG8_SA(0, 0), cA, voffA); PG8_STAGE(PG8_SA(0, 1), cA + hstep, voffA);
        if (wr == 1) PG8_BAR;
        PG8_WAIT_V(2); PG8_BAR;
        PG8_STAGE(PG8_SB(1, 0), cB + kstep, voffB); PG8_STAGE(PG8_SA(1, 0), cA + kstep, voffA); PG8_STAGE(PG8_SB(1, 1), cB + hstep + kstep, voffB);
        PG8_WAIT_V(6); PG8_BAR;
    } else {
        PG8_STAGE(PG8_SB(0, 0), cB, voffB); PG8_STAGE(PG8_SA(0, 0), cA, voffA); PG8_STAGE(PG8_SB(0, 1), cB + hstep, voffB); PG8_STAGE(PG8_SA(0, 1), cA + hstep, voffA);
        if (wr == 1) PG8_BAR;
        PG8_WAIT_V(4); PG8_BAR;
        PG8_STAGE(PG8_SB(1, 0), cB + kstep, voffB); PG8_STAGE(PG8_SA(1, 0), cA + kstep, voffA); PG8_STAGE(PG8_SB(1, 1), cB + hstep + kstep, voffB);
        PG8_WAIT_V(6); PG8_BAR;
    }
    for (;;) {
        const bool has_next = S.next(ui + 1, nxt);
        const char* nA = has_next ? (const char*)g.A + (size_t)nxt.pm * tstep : cA; const char* nB = has_next ? (const char*)g.Bt + (size_t)nxt.pn * tstep : cB;
        for (int t = 0; t < nt; t += 2) {
            const bool last = (t == nt - 2);
            const char* a1 = cA + (size_t)(t + 1) * kstep;
            const char* a2 = last ? nA : cA + (size_t)(t + 2) * kstep; const char* b2 = last ? nB : cB + (size_t)(t + 2) * kstep;
            const char* a3 = a2 + kstep; const char* b3 = b2 + kstep;
            if (last && has_next) S.a_ready(nxt);
            if constexpr (SP2) {
            PG8_LDB(B0, 0, 0); PG8_LDB(B1, 0, 1); PG8_SCHED; PG8_LDA(At, 0, 0); PG8_STAGE(PG8_SA(1, 1), a1 + hstep, voffA);
            PG8_WAIT_V(8); PG8_WAIT_L(0); PG8_BAR; PG8_MMA(0, 0, At, B0); PG8_MMA(0, 1, At, B1); PG8_BAR; PG8_SCHED;
            PG8_LDA(At, 0, 1); PG8_STAGE(PG8_SB(0, 0), b2, voffB); PG8_STAGE(PG8_SB(0, 1), b2 + hstep, voffB); PG8_STAGE(PG8_SA(0, 0), a2, voffA);
            PG8_WAIT_V(8); PG8_WAIT_L(0); PG8_BAR; PG8_MMA(1, 0, At, B0); PG8_MMA(1, 1, At, B1); PG8_BAR; PG8_SCHED;
            PG8_LDB(B0, 1, 0); PG8_LDB(B1, 1, 1); PG8_SCHED; PG8_LDA(At, 1, 0); PG8_STAGE(PG8_SA(0, 1), a2 + hstep, voffA);
            PG8_WAIT_V(8); PG8_WAIT_L(0); PG8_BAR; PG8_MMA(0, 0, At, B0); PG8_MMA(0, 1, At, B1); PG8_BAR; PG8_SCHED;
            PG8_LDA(At, 1, 1); PG8_STAGE(PG8_SB(1, 0), b3, voffB); PG8_STAGE(PG8_SB(1, 1), b3 + hstep, voffB); PG8_STAGE(PG8_SA(1, 0), a3, voffA);
            PG8_WAIT_V(8); PG8_WAIT_L(0); PG8_BAR; PG8_MMA(1, 0, At, B0); PG8_MMA(1, 1, At, B1); PG8_BAR; PG8_SCHED;
            } else {
            PG8_LDB(B0, 0, 0); PG8_SCHED; PG8_LDA(At, 0, 0); PG8_STAGE(PG8_SA(1, 1), a1 + hstep, voffA);
            PG8_WAIT_L(8); PG8_BAR; PG8_WAIT_L(0); PG8_MMA(0, 0, At, B0); PG8_BAR; PG8_SCHED;
            PG8_LDB(B1, 0, 1); PG8_STAGE(PG8_SB(0, 0), b2, voffB);
            PG8_BAR; PG8_WAIT_L(0); PG8_MMA(0, 1, At, B1); PG8_BAR;
            PG8_LDA(At, 0, 1); PG8_STAGE(PG8_SA(0, 0), a2, voffA);
            PG8_BAR; PG8_WAIT_L(0); PG8_MMA(1, 0, At, B0); PG8_BAR; PG8_SCHED;
            PG8_STAGE(PG8_SB(0, 1), b2 + hstep, voffB);
            PG8_WAIT_V(6); PG8_BAR; PG8_MMA(1, 1, At, B1); PG8_BAR;
            PG8_LDB(B0, 1, 0); PG8_SCHED; PG8_LDA(At, 1, 0); PG8_STAGE(PG8_SA(0, 1), a2 + hstep, voffA);
            PG8_WAIT_L(8); PG8_BAR; PG8_WAIT_L(0); PG8_MMA(0, 0, At, B0); PG8_BAR; PG8_SCHED;
            PG8_LDB(B1, 1, 1); PG8_STAGE(PG8_SB(1, 0), b3, voffB);
            PG8_BAR; PG8_WAIT_L(0); PG8_MMA(0, 1, At, B1); PG8_BAR;
            PG8_LDA(At, 1, 1); PG8_STAGE(PG8_SA(1, 0), a3, voffA);
            PG8_BAR; PG8_WAIT_L(0); PG8_MMA(1, 0, At, B0); PG8_BAR; PG8_SCHED;
            PG8_STAGE(PG8_SB(1, 1), b3 + hstep, voffB);
            PG8_WAIT_V(6); PG8_BAR; PG8_MMA(1, 1, At, B1); PG8_BAR;
            }
        }
        if constexpr (ALIGN_EPI) { if (wr == 0) PG8_BAR; }
        if constexpr (!Epi::AFTER_DRAIN) { E(acc, cur, wr, wc, fr, fq); S.done(cur); }
        if (!has_next) break;
#pragma unroll
        for (int a = 0; a < 2; ++a)
#pragma unroll
            for (int b = 0; b < 2; ++b)
#pragma unroll
                for (int m = 0; m < 4; ++m)
#pragma unroll
                    for (int n = 0; n < 2; ++n) acc[a][b][m][n] = (f32x4){0.f, 0.f, 0.f, 0.f};
        cur = nxt; cA = nA; cB = nB; ++ui;
        if constexpr (ALIGN_EPI) { if (wr == 1) PG8_BAR; }
    }
    PG8_WAIT_V(0);
    if constexpr (!ALIGN_EPI) { if (wr == 0) PG8_BAR; }
    PG8_BAR;
    if constexpr (Epi::AFTER_DRAIN) { E.fused(acc, cur, wr, wc, fr, fq, lds, wid, lane); S.done(cur); }
#undef PG8_SA
#undef PG8_SB
#undef PG8_STAGE
#undef PG8_LDA
#undef PG8_LDB
#undef PG8_MMA
#undef PG8_WAIT_V
#undef PG8_WAIT_L
#undef PG8_BAR
#undef PG8_SCHED
}
}

#define LAS __attribute__((address_space(3)))
#define DI __device__ __forceinline__
typedef unsigned short bf16;
typedef short bf16x8 __attribute__((ext_vector_type(8)));
typedef short s16x4 __attribute__((ext_vector_type(4)));
typedef float f32x2 __attribute__((ext_vector_type(2)));
typedef float f32x4 __attribute__((ext_vector_type(4)));
typedef float f32x16 __attribute__((ext_vector_type(16)));
typedef unsigned u32x2 __attribute__((ext_vector_type(2)));
typedef unsigned u32x4 __attribute__((ext_vector_type(4)));
typedef __bf16 bf16x2_t __attribute__((ext_vector_type(2)));
typedef __attribute__((address_space(1))) unsigned gu32;
#define RLX_AGENT __ATOMIC_RELAXED, __HIP_MEMORY_SCOPE_AGENT
#define LDS_WAIT() asm volatile("s_waitcnt lgkmcnt(0)" ::: "memory")
#define VM_WAIT() asm volatile("s_waitcnt vmcnt(0)" ::: "memory")
#define MFMA32(a, b, c) __builtin_amdgcn_mfma_f32_32x32x16_bf16((a), (b), (c), 0, 0, 0)
#define MFMA16(a, b, c) __builtin_amdgcn_mfma_f32_16x16x32_bf16((a), (b), (c), 0, 0, 0)
constexpr float LOG2E = 1.4426950408889634f;
constexpr float NEG_INF = -__builtin_inff();
DI unsigned f2bf(float f) { unsigned u = __builtin_bit_cast(unsigned, f); return (u + 0x7fffu + ((u >> 16) & 1u)) >> 16; }
DI unsigned pk2(float lo, float hi) { f32x2 v = {lo, hi}; bf16x2_t b = __builtin_convertvector(v, bf16x2_t); return __builtin_bit_cast(unsigned, b); }
DI float bflo(unsigned u) { return __builtin_bit_cast(float, u << 16); }
DI float bfhi(unsigned u) { return __builtin_bit_cast(float, u & 0xffff0000u); }
DI float bf2f(bf16 v) { return __builtin_bit_cast(float, (unsigned)v << 16); }
DI float ex2(float x) { return __builtin_amdgcn_exp2f(x); }
DI int crow(int reg, int h) { return (reg & 3) + 8 * (reg >> 2) + 4 * h; }
DI float wave_sum(float v) {
#pragma unroll
    for (int o = 1; o < 64; o <<= 1) v += __shfl_xor(v, o);
    return v;
}
DI float wave_max(float v) {
#pragma unroll
    for (int o = 1; o < 64; o <<= 1) v = fmaxf(v, __shfl_xor(v, o));
    return v;
}

constexpr size_t MiB = 1u << 20;
constexpr size_t WS_CTL = 0, CTL_ZERO_BYTES = 64 * 1024;
constexpr size_t WS_COS = 1 * MiB, WS_SIN = 2 * MiB;
constexpr size_t WS_KMEAN = 3 * MiB, WS_KCMP = 3 * MiB + 128 * 1024, WS_VCMP = 3 * MiB + 384 * 1024, WS_BIAS1 = 3 * MiB + 640 * 1024;
constexpr size_t WS_W = 4 * MiB, WS_H = 60 * MiB, WS_O = 92 * MiB, WS_Z = 124 * MiB, WS_HID = WS_Z, WS_GB = WS_Z, WS_MF = 156 * MiB, WS_CQN = 220 * MiB, WS_PART = 240 * MiB, WS_XB = 320 * MiB, WS_SS = 352 * MiB, WS_END = 353 * MiB;
constexpr size_t W_UP1 = 0, W_DN1 = W_UP1 + (size_t)2 * DFF * D, W_UP2 = W_DN1 + (size_t)D * DFF, W_DN2 = W_UP2 + (size_t)2 * DFF * D, W_IN = W_DN2 + (size_t)D * DFF,
                 W_G = W_IN + (size_t)ZLD * D, W_A = W_G + (size_t)3 * D * D, W_B = W_A + (size_t)D * 256, W_C = W_B + (size_t)D * 256, W_O = W_C + (size_t)D * 512,
                 W_1K = W_O + (size_t)D * D, W_1V = W_1K + (size_t)128 * 2048, W_2K = W_1V + (size_t)128 * 2048, W_2V = W_2K + (size_t)64 * 128, W_END = W_2V + (size_t)64 * 128;
static_assert(W_END * 2 <= 56 * MiB, "weights region");
constexpr int CW_BAR = 1024;

constexpr int RING_BYTES = 131072;
constexpr int LDSCTL_OFF = RING_BYTES, MISC_OFF = LDSCTL_OFF + 320;
constexpr int LDS_BYTES = 147456;
constexpr int NWAVES = 8;

#define XB_TMO      128
#define XB_XCNT(j)  (256  + 64 * (j))
#define XB_XSUB(j)  (1280 + 64 * (j))
#define XB_XGEN(j)  (2304 + 64 * (j))
#define XB_TOP      3328
#define XB_TOPGEN   3392
#define XCD_BAR_WORDS 3456
#define XB_SPIN_CAP (1u << 18)

__device__ __forceinline__ unsigned xb_ld(unsigned* p)              { return __hip_atomic_load(p, __ATOMIC_RELAXED, __HIP_MEMORY_SCOPE_AGENT); }
__device__ __forceinline__ unsigned xb_add(unsigned* p, unsigned v) { return __hip_atomic_fetch_add(p, v, __ATOMIC_RELAXED, __HIP_MEMORY_SCOPE_AGENT); }
__device__ __forceinline__ unsigned xb_xcc_id() { return (unsigned)__builtin_amdgcn_s_getreg((3 << 11) | 20) & 0xFu; }
#define XB_SPIN(cond, bar) do { unsigned _sp = 0; while (cond) { __builtin_amdgcn_s_sleep(1); \
    if ((++_sp & 255u) == 0u) { if (xb_ld(&(bar)[XB_TMO])) break; if (_sp > XB_SPIN_CAP) { atomicAdd(&(bar)[XB_TMO], 1u); break; } } } } while (0)

struct XcdBarrier {
    unsigned* bar; unsigned x;
    volatile LAS unsigned* st;
};

__device__ __forceinline__ XcdBarrier xcd_barrier_post(unsigned* bar, volatile LAS unsigned* st) {
    XcdBarrier b; b.bar = bar; b.x = xb_xcc_id(); b.st = st;
    if (threadIdx.x == 0) (void)xb_add(&bar[XB_XCNT(b.x)], 1u);
    return b;
}
__device__ __forceinline__ void xcd_barrier_complete(unsigned* bar, unsigned x, unsigned& nloc, unsigned& nx) {
    const unsigned G = gridDim.x * gridDim.y * gridDim.z;
    unsigned sum, cnt, mine, sp = 0u;
    for (;;) {
        sum = 0u; cnt = 0u; mine = 0u;
#pragma unroll
        for (unsigned j = 0; j < 16; ++j) { const unsigned c = xb_ld(&bar[XB_XCNT(j)]); sum += c; cnt += (c > 0u) ? 1u : 0u; mine = (j == x) ? c : mine; }
        if (sum == G) break;
        __builtin_amdgcn_s_sleep(1);
        if ((++sp & 255u) == 0u) { if (xb_ld(&bar[XB_TMO])) break; if (sp > XB_SPIN_CAP) { atomicAdd(&bar[XB_TMO], 1u); break; } }
    }
    nloc = mine > 0u ? mine : 1u; nx = cnt > 0u ? cnt : 1u;
}

__device__ __forceinline__ void xcd_barrier(const XcdBarrier& b) {
    asm volatile("s_waitcnt vmcnt(0)" ::: "memory");
    __syncthreads();
    if (threadIdx.x == 0) {
        unsigned* bar = b.bar;
        __builtin_amdgcn_s_waitcnt(0);
        unsigned nloc = b.st[0], nx = b.st[1];
        if (nloc == 0u) { xcd_barrier_complete(bar, b.x, nloc, nx); b.st[0] = nloc; b.st[1] = nx; }
        const unsigned old = xb_add(&bar[XB_XSUB(b.x)], 1u);
        const unsigned gen = old / nloc;
        if (old + 1u == (gen + 1u) * nloc) {
            __builtin_amdgcn_fence(__ATOMIC_RELEASE, "agent");
            asm volatile("s_waitcnt vmcnt(0)" ::: "memory");
            const unsigned og = xb_add(&bar[XB_TOP], 1u);
            const unsigned tg = og / nx;
            if (og + 1u == (tg + 1u) * nx) xb_add(&bar[XB_TOPGEN], 1u);
            else XB_SPIN(xb_ld(&bar[XB_TOPGEN]) == tg, bar);
            __builtin_amdgcn_fence(__ATOMIC_ACQUIRE, "agent");
            xb_add(&bar[XB_XGEN(b.x)], 1u);
            asm volatile("s_waitcnt vmcnt(0)" ::: "memory");
        } else {
            XB_SPIN(xb_ld(&bar[XB_XGEN(b.x)]) == gen, bar);
            __builtin_amdgcn_fence(__ATOMIC_ACQUIRE, "agent");
            asm volatile("s_waitcnt vmcnt(0)" ::: "memory");
        }
    }
    __syncthreads();
}


DI int zcol_to_orig(int n) {
    if (n < Z_ROPE_END) { const int hh = n >> 6, w = n & 63, e = (w >> 1) + 32 * (w & 1); int base;
        if (hh < 4) base = hh * 64; else if (hh == 4) base = 256; else if (hh < 9) base = 384 + (hh - 5) * 64; else if (hh == 9) base = 640;
        else if (hh < 14) base = 708 + (hh - 10) * 64; else if (hh < 18) base = 964 + (hh - 14) * 64; else if (hh < 26) base = 1476 + (hh - 18) * 64;
        else if (hh < 28) base = 2244 + (hh - 26) * 64; else base = 2500 + (hh - 28) * 64;
        return base + e; }
    if (n < Z_BV) return 320 + (n - Z_AV);
    if (n < Z_KC) return 1220 + (n - Z_BV);
    if (n < Z_VC) return 1988 + (n - Z_KC);
    if (n < Z_VS) return 2116 + (n - Z_VC);
    if (n < Z_VW) return 2372 + (n - Z_VS);
    if (n < Z_IW) return 2628 + (n - Z_VW);
    if (n < Z_CG) return 704 + (n - Z_IW);
    if (n < Z_END) return 2756 + (n - Z_CG);
    return -1;
}
struct MapPlain { const float* W; DI const float* operator()(int n) const { return W + n; } };
struct MapGateUp { const float* Wg; const float* Wu; DI const float* operator()(int n) const { return ((n & 1) ? Wu : Wg) + (n >> 1); } };
struct MapZin { const float* W; DI const float* operator()(int n) const { const int oc = zcol_to_orig(n); return oc < 0 ? nullptr : W + oc; } };
struct MapW2K { const float* W; DI const float* operator()(int n) const { return W + (n >> 1) + 32 * (n & 1); } };
template <class Map>
DI void tr_item(const Map& mp, int ld, int K, int nblk, bf16* WT, LAS float* scr, int item, int lane) {
    const int kb = item / nblk, nb = item % nblk, k0 = 64 * kb, n0 = 32 * nb;
    if (mp.kind <= 1) {
        const int rr = lane >> 3, c4 = lane & 7;
        const float* src = (mp.kind == 0) ? mp.W0 + n0 + 4 * c4 : ((c4 < 4) ? mp.W0 : mp.W1) + (n0 >> 1) + 4 * (c4 & 3);
        f32x4 v[8];
#pragma unroll
        for (int i = 0; i < 8; ++i) v[i] = *(const f32x4*)(src + (size_t)(k0 + 8 * i + rr) * ld);
#pragma unroll
        for (int i = 0; i < 8; ++i) { LAS float* d = scr + (8 * i + rr) * 33;
            if (mp.kind == 0) { d[4 * c4] = v[i].x; d[4 * c4 + 1] = v[i].y; d[4 * c4 + 2] = v[i].z; d[4 * c4 + 3] = v[i].w; }
            else { const int nl = 8 * (c4 & 3) + (c4 >> 2); d[nl] = v[i].x; d[nl + 2] = v[i].y; d[nl + 4] = v[i].z; d[nl + 6] = v[i].w; } }
    } else {
        const float* colp = mp(n0 + (lane & 31));
#pragma unroll 8
        for (int i = 0; i < 32; ++i) { const int kk = 2 * i + (lane >> 5); scr[kk * 33 + (lane & 31)] = colp ? colp[(size_t)(k0 + kk) * ld] : 0.f; }
    }
    LDS_WAIT(); asm volatile("" ::: "memory");
    const int c = lane & 7;
    f32x4 ga = {1.f, 1.f, 1.f, 1.f}, gb = {1.f, 1.f, 1.f, 1.f};
    if (mp.gk) { ga = *(const f32x4*)(mp.gk + k0 + 8 * c); gb = *(const f32x4*)(mp.gk + k0 + 8 * c + 4); }
#pragma unroll
    for (int j = 0; j < 4; ++j) { const int n = (lane >> 3) + 8 * j; const LAS float* s = scr + (8 * c) * 33 + n;
        u32x4 o; o.x = pk2(s[0 * 33] * ga.x, s[1 * 33] * ga.y); o.y = pk2(s[2 * 33] * ga.z, s[3 * 33] * ga.w); o.z = pk2(s[4 * 33] * gb.x, s[5 * 33] * gb.y); o.w = pk2(s[6 * 33] * gb.z, s[7 * 33] * gb.w);
        *(u32x4*)(WT + (size_t)(n0 + n) * K + k0 + 8 * c) = o; }
    LDS_WAIT(); asm volatile("" ::: "memory");
}
DI void rms_row_bf16(const float* xrow, const float* g, bf16* orow, bf16* xbrow, int lane) {
    const f32x4* xr = (const f32x4*)xrow + lane; const f32x4* gr = (const f32x4*)g + lane;
    f32x4 v[4]; float s = 0.f;
#pragma unroll
    for (int j = 0; j < 4; ++j) { v[j] = xr[64 * j]; s += (v[j].x * v[j].x + v[j].y * v[j].y) + (v[j].z * v[j].z + v[j].w * v[j].w); }
    const float rstd = 1.f / sqrtf(wave_sum(s) * (1.f / D) + NORM_EPS);
    unsigned long long* o8 = (unsigned long long*)orow + lane; unsigned long long* x8 = (unsigned long long*)xbrow + lane;
#pragma unroll
    for (int j = 0; j < 4; ++j) { const f32x4 gg = gr[64 * j];
        x8[64 * j] = (unsigned long long)pk2(v[j].x, v[j].y) | ((unsigned long long)pk2(v[j].z, v[j].w) << 32);
        o8[64 * j] = (unsigned long long)pk2(v[j].x * rstd * gg.x, v[j].y * rstd * gg.y) | ((unsigned long long)pk2(v[j].z * rstd * gg.z, v[j].w * rstd * gg.w) << 32); }
}
DI void rms_rows4_bf16(const float* x, const float* g, bf16* o, bf16* xb, size_t m0, size_t stride, int lane) {
    f32x4 v[4][4]; float ss[4];
#pragma unroll
    for (int q = 0; q < 4; ++q) { const f32x4* xr = (const f32x4*)(x + (m0 + q * stride) * D) + lane;
#pragma unroll
        for (int j = 0; j < 4; ++j) v[q][j] = xr[64 * j]; }
#pragma unroll
    for (int q = 0; q < 4; ++q) { float a = 0.f;
#pragma unroll
        for (int j = 0; j < 4; ++j) a += (v[q][j].x * v[q][j].x + v[q][j].y * v[q][j].y) + (v[q][j].z * v[q][j].z + v[q][j].w * v[q][j].w);
        ss[q] = a; }
#pragma unroll
    for (int of = 1; of < 64; of <<= 1) {
#pragma unroll
        for (int q = 0; q < 4; ++q) ss[q] += __shfl_xor(ss[q], of); }
    const f32x4* gr = (const f32x4*)g + lane;
#pragma unroll
    for (int q = 0; q < 4; ++q) { const float rstd = 1.f / sqrtf(ss[q] * (1.f / D) + NORM_EPS);
        unsigned long long* o8 = (unsigned long long*)(o + (m0 + q * stride) * D) + lane; unsigned long long* x8 = (unsigned long long*)(xb + (m0 + q * stride) * D) + lane;
#pragma unroll
        for (int j = 0; j < 4; ++j) { const f32x4 gg = gr[64 * j];
            x8[64 * j] = (unsigned long long)pk2(v[q][j].x, v[q][j].y) | ((unsigned long long)pk2(v[q][j].z, v[q][j].w) << 32);
            o8[64 * j] = (unsigned long long)pk2(v[q][j].x * rstd * gg.x, v[q][j].y * rstd * gg.y) | ((unsigned long long)pk2(v[q][j].z * rstd * gg.z, v[q][j].w * rstd * gg.w) << 32); } }
}
DI void xb_init_rows4(const float* x, bf16* xb, float* ss, size_t m0, size_t stride, int lane) {
    f32x4 v[4][4]; float sq[4];
#pragma unroll
    for (int q = 0; q < 4; ++q) { const f32x4* xr = (const f32x4*)(x + (m0 + q * stride) * D) + lane;
#pragma unroll
        for (int j = 0; j < 4; ++j) v[q][j] = xr[64 * j]; }
#pragma unroll
    for (int q = 0; q < 4; ++q) { float a = 0.f;
#pragma unroll
        for (int j = 0; j < 4; ++j) a += (v[q][j].x * v[q][j].x + v[q][j].y * v[q][j].y) + (v[q][j].z * v[q][j].z + v[q][j].w * v[q][j].w);
        sq[q] = a; }
#pragma unroll
    for (int of = 1; of < 64; of <<= 1) {
#pragma unroll
        for (int q = 0; q < 4; ++q) sq[q] += __shfl_xor(sq[q], of); }
#pragma unroll
    for (int q = 0; q < 4; ++q) { unsigned long long* x8 = (unsigned long long*)(xb + (m0 + q * stride) * D) + lane;
#pragma unroll
        for (int j = 0; j < 4; ++j) x8[64 * j] = (unsigned long long)pk2(v[q][j].x, v[q][j].y) | ((unsigned long long)pk2(v[q][j].z, v[q][j].w) << 32);
        if (lane < 16) ss[(m0 + q * stride) * 16 + lane] = lane == 0 ? sq[q] : 0.f; }
}
template <int NR>
DI void rms_rows_b2b(const bf16* x, const float* g, bf16* o, size_t m0, size_t stride, int lane) {
    u32x4 v[NR][2]; float ss[NR];
#pragma unroll
    for (int q = 0; q < NR; ++q) { const u32x4* xr = (const u32x4*)(x + (m0 + q * stride) * D) + lane;
#pragma unroll
        for (int j = 0; j < 2; ++j) v[q][j] = xr[64 * j]; }
#pragma unroll
    for (int q = 0; q < NR; ++q) { float a = 0.f;
#pragma unroll
        for (int j = 0; j < 2; ++j) { const u32x4 t = v[q][j];
            a += (bflo(t.x) * bflo(t.x) + bfhi(t.x) * bfhi(t.x)) + (bflo(t.y) * bflo(t.y) + bfhi(t.y) * bfhi(t.y)) + (bflo(t.z) * bflo(t.z) + bfhi(t.z) * bfhi(t.z)) + (bflo(t.w) * bflo(t.w) + bfhi(t.w) * bfhi(t.w)); }
        ss[q] = a; }
#pragma unroll
    for (int of = 1; of < 64; of <<= 1) {
#pragma unroll
        for (int q = 0; q < NR; ++q) ss[q] += __shfl_xor(ss[q], of); }
#pragma unroll
    for (int q = 0; q < NR; ++q) { const float rstd = 1.f / sqrtf(ss[q] * (1.f / D) + NORM_EPS);
        u32x4* o16 = (u32x4*)(o + (m0 + q * stride) * D) + lane;
#pragma unroll
        for (int j = 0; j < 2; ++j) { const f32x4 g0 = ((const f32x4*)g)[2 * (lane + 64 * j)], g1 = ((const f32x4*)g)[2 * (lane + 64 * j) + 1]; const u32x4 t = v[q][j];
            u32x4 r; r.x = pk2(bflo(t.x) * rstd * g0.x, bfhi(t.x) * rstd * g0.y); r.y = pk2(bflo(t.y) * rstd * g0.z, bfhi(t.y) * rstd * g0.w);
            r.z = pk2(bflo(t.z) * rstd * g1.x, bfhi(t.z) * rstd * g1.y); r.w = pk2(bflo(t.w) * rstd * g1.z, bfhi(t.w) * rstd * g1.w);
            o16[64 * j] = r; } }
}
DI void rms_row_b2f(const bf16* xrow, const float* g, float* orow, int lane) {
    u32x4 v[2]; float s = 0.f;
#pragma unroll
    for (int j = 0; j < 2; ++j) { v[j] = ((const u32x4*)xrow)[lane + 64 * j]; const u32x4 t = v[j];
        s += (bflo(t.x) * bflo(t.x) + bfhi(t.x) * bfhi(t.x)) + (bflo(t.y) * bflo(t.y) + bfhi(t.y) * bfhi(t.y)) + (bflo(t.z) * bflo(t.z) + bfhi(t.z) * bfhi(t.z)) + (bflo(t.w) * bflo(t.w) + bfhi(t.w) * bfhi(t.w)); }
    const float rstd = 1.f / sqrtf(wave_sum(s) * (1.f / D) + NORM_EPS);
#pragma unroll
    for (int j = 0; j < 2; ++j) { const f32x4 g0 = ((const f32x4*)g)[2 * (lane + 64 * j)], g1 = ((const f32x4*)g)[2 * (lane + 64 * j) + 1]; const u32x4 t = v[j];
        f32x4 r0, r1; r0.x = bflo(t.x) * rstd * g0.x; r0.y = bfhi(t.x) * rstd * g0.y; r0.z = bflo(t.y) * rstd * g0.z; r0.w = bfhi(t.y) * rstd * g0.w;
        r1.x = bflo(t.z) * rstd * g1.x; r1.y = bfhi(t.z) * rstd * g1.y; r1.z = bflo(t.w) * rstd * g1.z; r1.w = bfhi(t.w) * rstd * g1.w;
        ((f32x4*)orow)[2 * (lane + 64 * j)] = r0; ((f32x4*)orow)[2 * (lane + 64 * j) + 1] = r1; }
}

struct Args { const float* in[22]; float* out; unsigned char* ws; int ph_lo, ph_hi; };
struct MapGen { int kind; const float* W0; const float* W1; const float* gk;
    DI const float* operator()(int n) const {
        if (kind == 0) return W0 + n;
        if (kind == 1) return ((n & 1) ? W1 : W0) + (n >> 1);
        if (kind == 2) { const int oc = zcol_to_orig(n); return oc < 0 ? nullptr : W0 + oc; }
        return W0 + (n >> 1) + 32 * (n & 1);
    } };
DI void convert_weights(const Args& A, int l, bf16* Wb, float* bias1p, LAS unsigned char* lds, int gw, int NGW, int wave, int lane, int tid) {
    LAS float* scr = (LAS float*)(lds + wave * 16384);
    constexpr int I_UP = 16 * 176, I_DN = 44 * 32, I_IN = 16 * 88, I_G = 16 * 96, I_A = 4 * 32, I_C = 8 * 32, I_O = 16 * 32, I_1 = 32 * 4, I_2 = 2 * 2;
    constexpr int NIT = 2 * I_UP + 2 * I_DN + I_IN + I_G + 2 * I_A + I_C + I_O + 2 * I_1 + 2 * I_2;
    for (int it = gw; it < NIT; it += NGW) {
        int r = it; MapGen mp; mp.kind = 0; mp.W0 = nullptr; mp.W1 = nullptr; mp.gk = nullptr; int ld, K, nblk; size_t dst;
        if (r < I_UP) { mp.kind = 1; mp.W0 = A.in[2] + (size_t)l * D * DFF; mp.W1 = A.in[3] + (size_t)l * D * DFF; mp.gk = A.in[1] + (size_t)l * D; ld = DFF; K = D; nblk = 176; dst = W_UP1; }
        else if ((r -= I_UP) < I_DN) { mp.W0 = A.in[4] + (size_t)l * DFF * D; ld = D; K = DFF; nblk = 32; dst = W_DN1; }
        else if ((r -= I_DN) < I_UP) { mp.kind = 1; mp.W0 = A.in[18] + (size_t)l * D * DFF; mp.W1 = A.in[19] + (size_t)l * D * DFF; mp.gk = A.in[17] + (size_t)l * D; ld = DFF; K = D; nblk = 176; dst = W_UP2; }
        else if ((r -= I_UP) < I_DN) { mp.W0 = A.in[20] + (size_t)l * DFF * D; ld = D; K = DFF; nblk = 32; dst = W_DN2; }
        else if ((r -= I_DN) < I_IN) { mp.kind = 2; mp.W0 = A.in[6] + (size_t)l * D * IN_COLS; mp.gk = A.in[5] + (size_t)l * D; ld = IN_COLS; K = D; nblk = 88; dst = W_IN; }
        else if ((r -= I_IN) < I_G) { mp.W0 = A.in[6] + (size_t)l * D * IN_COLS + Z_END; mp.gk = A.in[5] + (size_t)l * D; ld = IN_COLS; K = D; nblk = 96; dst = W_G; }
        else if ((r -= I_G) < I_A) { mp.W0 = A.in[13] + (size_t)l * 256 * D; ld = D; K = 256; nblk = 32; dst = W_A; }
        else if ((r -= I_A) < I_A) { mp.W0 = A.in[14] + (size_t)l * 256 * D; ld = D; K = 256; nblk = 32; dst = W_B; }
        else if ((r -= I_A) < I_C) { mp.W0 = A.in[15] + (size_t)l * 512 * D; ld = D; K = 512; nblk = 32; dst = W_C; }
        else if ((r -= I_C) < I_O) { mp.W0 = A.in[16] + (size_t)l * D * D; ld = D; K = D; nblk = 32; dst = W_O; }
        else if ((r -= I_O) < I_1) { mp.W0 = A.in[8] + (size_t)l * 2048 * 128; ld = 128; K = 2048; nblk = 4; dst = W_1K; }
        else if ((r -= I_1) < I_1) { mp.W0 = A.in[11] + (size_t)l * 2048 * 128; ld = 128; K = 2048; nblk = 4; dst = W_1V; }
        else if ((r -= I_1) < I_2) { mp.kind = 3; mp.W0 = A.in[9] + (size_t)l * 128 * 64; ld = 64; K = 128; nblk = 2; dst = W_2K; }
        else { r -= I_2; mp.W0 = A.in[12] + (size_t)l * 128 * 64; ld = 64; K = 128; nblk = 2; dst = W_2V; }
        tr_item(mp, ld, K, nblk, Wb + dst, scr, r, lane);
    }
    if (blockIdx.x < 16) {
        LDS_WAIT(); __syncthreads();
        const int kv = blockIdx.x >> 3, kc = blockIdx.x & 7, u = tid & 127, ks = tid >> 7;
        const float* pos = (kv ? A.in[10] : A.in[7]) + (size_t)l * 2048; const float* w1 = (kv ? A.in[11] : A.in[8]) + (size_t)l * 2048 * 128;
        float a = 0.f;
        for (int i = 0; i < 64; ++i) { const int k = kc * 256 + ks * 64 + i; a += pos[k] * w1[(size_t)k * 128 + u]; }
        LAS float* red = (LAS float*)lds;
        red[ks * 128 + u] = a;
        __syncthreads();
        if (tid < 128) bias1p[(kv * 8 + kc) * 128 + tid] = (red[tid] + red[128 + tid]) + (red[256 + tid] + red[384 + tid]);
        __syncthreads();
    }
}
DI void rope_table(float* cosT, float* sinT, int gtid, int gthreads) {
    for (int e = gtid; e < T * 32; e += gthreads) {
        const int pos = e >> 5, i = e & 31;
        double iv = 1.0;
        for (int k = 0; k < i; ++k) iv *= 0.74989420933245582;
        const float inv = (float)iv;
        const float ang = (float)pos * inv;
        const double x = (double)ang; const double n = rint(x * 0.15915494309189535);
        const float rr = (float)(x - n * 6.283185307179586);
        cosT[e] = __cosf(rr); sinT[e] = __sinf(rr);
    }
}

constexpr int VROWB = 192, VT_BYTES = 32 * VROWB;
DI void load_v_tile(const bf16* vbase, size_t vstride, LAS unsigned char* vt, int lane) {
#pragma unroll
    for (int it = 0; it < 4; ++it) { const int c = lane + 64 * it, key = c >> 3, ch = c & 7;
        const u32x4 v = *(const u32x4*)(vbase + (size_t)key * vstride + ch * 8);
        *(LAS u32x4*)(vt + key * VROWB + ch * 16) = v; }
}
DI f32x16 qk_tile(const bf16* kbase, size_t kstride, const bf16x8 (&qf)[4], int r, int h) {
    bf16x8 kf[4];
#pragma unroll
    for (int ks = 0; ks < 4; ++ks) kf[ks] = *(const bf16x8*)(kbase + (size_t)r * kstride + 16 * ks + 8 * h);
    f32x16 s;
#pragma unroll
    for (int i = 0; i < 16; ++i) s[i] = 0.f;
#pragma unroll
    for (int ks = 0; ks < 4; ++ks) s = MFMA32(kf[ks], qf[ks], s);
    return s;
}
DI s16x4 vtr(const LAS unsigned char* p) { return __builtin_bit_cast(s16x4, __builtin_amdgcn_ds_read_tr16_b64_v4i16((LAS s16x4*)p)); }
constexpr float SM_TAU = 8.f;
DI void softmax_pv(f32x16& s, float mx, float mref, f32x16& o0, f32x16& o1, float& m, float& l, const LAS unsigned char* vt, int lane) {
    mx = fmaxf(mx, __shfl_xor(mx, 32));
    const bool upd = (mx > SM_TAU) || (m < -1e29f && mx > -1e30f);
    if (__any(upd)) {
        const float d = upd ? mx : 0.f;
        const float alpha = (m < -1e29f) ? 1.f : ex2(-d);
        if (upd) m = mref + d;
        l *= alpha;
#pragma unroll
        for (int i = 0; i < 16; ++i) { o0[i] *= alpha; o1[i] *= alpha; s[i] -= d; }
    }
    float rs = 0.f;
#pragma unroll
    for (int i = 0; i < 16; ++i) { s[i] = ex2(s[i]); rs += s[i]; }
    l += rs;
    u32x4 pa, pb;
    pa.x = pk2(s[0], s[1]); pa.y = pk2(s[2], s[3]); pa.z = pk2(s[4], s[5]); pa.w = pk2(s[6], s[7]);
    pb.x = pk2(s[8], s[9]); pb.y = pk2(s[10], s[11]); pb.z = pk2(s[12], s[13]); pb.w = pk2(s[14], s[15]);
    const bf16x8 p0 = __builtin_bit_cast(bf16x8, pa), p1 = __builtin_bit_cast(bf16x8, pb);
    const int h = lane >> 5, blk = (lane >> 4) & 1, q = (lane & 15) >> 2, p = lane & 3;
    const LAS unsigned char* tb = vt + (4 * h + q) * VROWB + (16 * blk + 4 * p) * 2;
    s16x4 lo[2][2], hi[2][2];
#pragma unroll
    for (int dt = 0; dt < 2; ++dt)
#pragma unroll
        for (int ss = 0; ss < 2; ++ss) { lo[dt][ss] = vtr(tb + (16 * ss) * VROWB + 64 * dt); hi[dt][ss] = vtr(tb + (16 * ss + 8) * VROWB + 64 * dt); }
    asm volatile("" ::: "memory");
#pragma unroll
    for (int dt = 0; dt < 2; ++dt) {
#pragma unroll
        for (int ss = 0; ss < 2; ++ss) {
            const bf16x8 vf = __builtin_shufflevector(lo[dt][ss], hi[dt][ss], 0, 1, 2, 3, 4, 5, 6, 7);
            if (dt == 0) o0 = MFMA32(vf, ss ? p1 : p0, o0); else o1 = MFMA32(vf, ss ? p1 : p0, o1);
        }
    }
}
#define ZERO16(v) do { _Pragma("unroll") for (int _i = 0; _i < 16; ++_i) (v)[_i] = 0.f; } while (0)

struct KVPre { bf16x8 k[4]; u32x4 v[4]; };
DI void kv_issue(KVPre& p, const bf16* kb, size_t kstride, const bf16* vb, size_t vstride, int r, int h, int lane) {
#pragma unroll
    for (int ks = 0; ks < 4; ++ks) p.k[ks] = *(const bf16x8*)(kb + (size_t)r * kstride + 16 * ks + 8 * h);
#pragma unroll
    for (int it = 0; it < 4; ++it) { const int c = lane + 64 * it, key = c >> 3, ch = c & 7; p.v[it] = *(const u32x4*)(vb + (size_t)key * vstride + ch * 8); }
}
DI void k_issue(KVPre& p, const bf16* kb, size_t kstride, int r, int h) {
#pragma unroll
    for (int ks = 0; ks < 4; ++ks) p.k[ks] = *(const bf16x8*)(kb + (size_t)r * kstride + 16 * ks + 8 * h);
}
DI f32x16 qk_pre(const KVPre& p, const bf16x8 (&qf)[4]) {
    f32x16 s;
#pragma unroll
    for (int i = 0; i < 16; ++i) s[i] = 0.f;
#pragma unroll
    for (int ks = 0; ks < 4; ++ks) s = MFMA32(p.k[ks], qf[ks], s);
    return s;
}
DI void v_store(const KVPre& p, LAS unsigned char* vt, int lane) {
#pragma unroll
    for (int it = 0; it < 4; ++it) { const int c = lane + 64 * it, key = c >> 3, ch = c & 7; *(LAS u32x4*)(vt + key * VROWB + ch * 16) = p.v[it]; }
}
template <class It, class Mk>
DI void attn_loop(It& it, const Mk& mk, const bf16* kbase, size_t kstride, const bf16* vbase, size_t vstride, const bf16x8 (&qf)[4], float cs,
                  f32x16& o0, f32x16& o1, float& m, float& l, LAS unsigned char* vt0, LAS unsigned char* vt1, int lane) {
    const int r = lane & 31, h = lane >> 5;
    KVPre A, B;
    int kbA = -1, kbB = -1;
    bool hA = it.next(kbA), hB = false;
    if (!hA) return;
    kv_issue(A, kbase + (size_t)kbA * kstride, kstride, vbase + (size_t)kbA * vstride, vstride, r, h, lane);
    v_store(A, vt0, lane);
    for (;;) {
        kbB = kbA; hB = it.next(kbB);
        if (hB) { k_issue(B, kbase + (size_t)kbB * kstride, kstride, r, h);
            const bf16* vb = vbase + (size_t)kbB * vstride;
#pragma unroll
            for (int t4 = 0; t4 < 4; ++t4) { const int c = lane + 64 * t4, key = c >> 3, ch = c & 7; A.v[t4] = *(const u32x4*)(vb + (size_t)key * vstride + ch * 8); } }
        { f32x16 s = qk_pre(A, qf); const bool rw = mk.row(kbA); float mx; const float mref = (m < -1e29f) ? 0.f : m; const float biasm = (rw ? 0.f : NEG_INF) - mref;
          if (mk.full(kbA)) { const float bias = biasm;
#pragma unroll
            for (int i = 0; i < 16; ++i) s[i] = s[i] * cs + bias;
            mx = s[0];
#pragma unroll
            for (int i = 1; i < 16; ++i) mx = fmaxf(mx, s[i]);
          } else {
#pragma unroll
            for (int i = 0; i < 16; ++i) { const int key = kbA + crow(i, h); s[i] = mk.elem(key) ? s[i] * cs + biasm : NEG_INF; }
            mx = s[0];
#pragma unroll
            for (int i = 1; i < 16; ++i) mx = fmaxf(mx, s[i]); }
          softmax_pv(s, mx, mref, o0, o1, m, l, vt0, lane); }
        if (!hB) break;
        v_store(A, vt1, lane);
        kbA = kbB; hA = it.next(kbA);
        if (hA) { k_issue(A, kbase + (size_t)kbA * kstride, kstride, r, h);
            const bf16* vb = vbase + (size_t)kbA * vstride;
#pragma unroll
            for (int t4 = 0; t4 < 4; ++t4) { const int c = lane + 64 * t4, key = c >> 3, ch = c & 7; A.v[t4] = *(const u32x4*)(vb + (size_t)key * vstride + ch * 8); } }
        { f32x16 s = qk_pre(B, qf); const bool rw = mk.row(kbB); float mx; const float mref = (m < -1e29f) ? 0.f : m; const float biasm = (rw ? 0.f : NEG_INF) - mref;
          if (mk.full(kbB)) { const float bias = biasm;
#pragma unroll
            for (int i = 0; i < 16; ++i) s[i] = s[i] * cs + bias;
            mx = s[0];
#pragma unroll
            for (int i = 1; i < 16; ++i) mx = fmaxf(mx, s[i]);
          } else {
#pragma unroll
            for (int i = 0; i < 16; ++i) { const int key = kbB + crow(i, h); s[i] = mk.elem(key) ? s[i] * cs + biasm : NEG_INF; }
            mx = s[0];
#pragma unroll
            for (int i = 1; i < 16; ++i) mx = fmaxf(mx, s[i]); }
          softmax_pv(s, mx, mref, o0, o1, m, l, vt1, lane); }
        if (!hA) break;
        v_store(A, vt0, lane);
    }
}
struct ItRange { int kb0, kb_last; DI bool next(int& kb) const { const int nk = kb < 0 ? kb0 : kb + 32; if (nk > kb_last) return false; kb = nk; return true; } };
struct ItMoba { unsigned nm; int tmax; DI bool next(int& kb) const {
        if (kb >= 0) { const int nk = kb + 32; if ((nk & 255) && nk <= tmax) { kb = nk; return true; } }
        const int n = kb < 0 ? 0 : (kb >> 8) + 1; if (n > 31) return false; const unsigned mm = nm >> n; if (!mm) return false;
        kb = (n + __builtin_ctz(mm)) * 256; return true; } };
struct ItSlc { unsigned long long lo, hi; int tmax; DI bool next(int& kb) const {
        if (kb >= 0 && !(kb & 32) && kb + 32 <= tmax) { kb += 32; return true; }
        int j = kb < 0 ? 0 : (kb >> 6) + 1; if (j > 127) return false;
        if (j < 64) { const unsigned long long mm = lo >> j; if (mm) { kb = (j + __builtin_ctzll(mm)) * 64; return true; } j = 64; }
        const unsigned long long mh = hi >> (j - 64); if (!mh) return false; kb = (j + __builtin_ctzll(mh)) * 64; return true; } };

constexpr int KROWB = 144, KT2_BYTES = 64 * KROWB, VT2_BYTES = 64 * VROWB, BT_BYTES = KT2_BYTES + VT2_BYTES;
DI void softmax_pv2(f32x16& sa, f32x16& sb, float mx, float mref, f32x16& o0, f32x16& o1, float& m, float& l, const LAS unsigned char* vta, int lane) {
    mx = fmaxf(mx, __shfl_xor(mx, 32));
    const bool upd = (mx > SM_TAU) || (m < -1e29f && mx > -1e30f);
    if (__any(upd)) {
        const float d = upd ? mx : 0.f;
        const float alpha = (m < -1e29f) ? 1.f : ex2(-d);
        if (upd) m = mref + d;
        l *= alpha;
#pragma unroll
        for (int i = 0; i < 16; ++i) { o0[i] *= alpha; o1[i] *= alpha; sa[i] -= d; sb[i] -= d; }
    }
    float rs = 0.f;
#pragma unroll
    for (int i = 0; i < 16; i += 2) { sa[i] = ex2(sa[i]); sa[i + 1] = ex2(sa[i + 1]); sb[i] = ex2(sb[i]); sb[i + 1] = ex2(sb[i + 1]); rs += (sa[i] + sb[i]) + (sa[i + 1] + sb[i + 1]); }
    l += rs;
    u32x4 pa, pb, pc, pd;
    pa.x = pk2(sa[0], sa[1]); pa.y = pk2(sa[2], sa[3]); pa.z = pk2(sa[4], sa[5]); pa.w = pk2(sa[6], sa[7]);
    pb.x = pk2(sa[8], sa[9]); pb.y = pk2(sa[10], sa[11]); pb.z = pk2(sa[12], sa[13]); pb.w = pk2(sa[14], sa[15]);
    pc.x = pk2(sb[0], sb[1]); pc.y = pk2(sb[2], sb[3]); pc.z = pk2(sb[4], sb[5]); pc.w = pk2(sb[6], sb[7]);
    pd.x = pk2(sb[8], sb[9]); pd.y = pk2(sb[10], sb[11]); pd.z = pk2(sb[12], sb[13]); pd.w = pk2(sb[14], sb[15]);
    const bf16x8 p0 = __builtin_bit_cast(bf16x8, pa), p1 = __builtin_bit_cast(bf16x8, pb), p2 = __builtin_bit_cast(bf16x8, pc), p3 = __builtin_bit_cast(bf16x8, pd);
    const int h = lane >> 5, blk = (lane >> 4) & 1, q = (lane & 15) >> 2, p = lane & 3;
    const LAS unsigned char* tb = vta + (4 * h + q) * VROWB + (16 * blk + 4 * p) * 2;
#pragma unroll
    for (int dt = 0; dt < 2; ++dt) {
        s16x4 lo[4], hi[4];
#pragma unroll
        for (int ss = 0; ss < 4; ++ss) { lo[ss] = vtr(tb + (16 * ss) * VROWB + 64 * dt); hi[ss] = vtr(tb + (16 * ss + 8) * VROWB + 64 * dt); }
        asm volatile("" ::: "memory");
#pragma unroll
        for (int ss = 0; ss < 4; ++ss) {
            const bf16x8 vf = __builtin_shufflevector(lo[ss], hi[ss], 0, 1, 2, 3, 4, 5, 6, 7);
            const bf16x8 pp = ss == 0 ? p0 : ss == 1 ? p1 : ss == 2 ? p2 : p3;
            if (dt == 0) o0 = MFMA32(vf, pp, o0); else o1 = MFMA32(vf, pp, o1);
        }
    }
}
#define BLK_ISSUE(kbn) do { regk = *(const u32x4*)(kbase + (size_t)((kbn) + lk) * kstride + lc * 8); if (vbase) regv = *(const u32x4*)(vbase + (size_t)((kbn) + lk) * vstride + lc * 8); } while (0)
#define BLK_STORE(buf) do { *(LAS u32x4*)(tb + (buf) * BT_BYTES + lk * KROWB + lc * 16) = regk; if (vbase) *(LAS u32x4*)(tb + (buf) * BT_BYTES + KT2_BYTES + lk * VROWB + lc * 16) = regv; } while (0)
template <class It, class Mk>
DI void attn_loop_blk(It& it, const Mk& mk, const bf16* kbase, size_t kstride, const bf16* vbase, size_t vstride, const bf16x8 (&qf)[4], float cs,
                      f32x16& o0, f32x16& o1, float& m, float& l, LAS unsigned char* tb, int tid, int lane) {
    const int r = lane & 31, h = lane >> 5;
    const int lk = tid >> 3, lc = tid & 7;
    int kb = -1; bool has = it.next(kb);
    if (has) {
        u32x4 regk = {0u, 0u, 0u, 0u}, regv = {0u, 0u, 0u, 0u};
        BLK_ISSUE(kb); BLK_STORE(0);
        __syncthreads();
        int cur = 0;
        for (;;) {
            int kbn = kb; const bool hn = it.next(kbn);
            if (hn) BLK_ISSUE(kbn);
            if (mk.needs(kb)) {
                const LAS unsigned char* kt = tb + cur * BT_BYTES;
                f32x16 sa, sb;
#pragma unroll
                for (int i = 0; i < 16; ++i) { sa[i] = 0.f; sb[i] = 0.f; }
#pragma unroll
                for (int ks = 0; ks < 4; ++ks) { const bf16x8 ka = *(const LAS bf16x8*)(kt + r * KROWB + (16 * ks + 8 * h) * 2), kc = *(const LAS bf16x8*)(kt + (32 + r) * KROWB + (16 * ks + 8 * h) * 2);
                    sa = MFMA32(ka, qf[ks], sa); sb = MFMA32(kc, qf[ks], sb); }
                const bool rw = mk.row(kb); float mx; const float mref = (m < -1e29f) ? 0.f : m; const float biasm = (rw ? 0.f : NEG_INF) - mref;
                if (mk.full(kb)) { const float bias = biasm;
#pragma unroll
                    for (int i = 0; i < 16; ++i) { sa[i] = sa[i] * cs + bias; sb[i] = sb[i] * cs + bias; }
                    mx = fmaxf(sa[0], sb[0]);
#pragma unroll
                    for (int i = 1; i < 16; ++i) mx = fmaxf(mx, fmaxf(sa[i], sb[i]));
                } else {
#pragma unroll
                    for (int i = 0; i < 16; ++i) { const int key = kb + crow(i, h); sa[i] = mk.elem(key) ? sa[i] * cs + biasm : NEG_INF; sb[i] = mk.elem(key + 32) ? sb[i] * cs + biasm : NEG_INF; }
                    mx = fmaxf(sa[0], sb[0]);
#pragma unroll
                    for (int i = 1; i < 16; ++i) mx = fmaxf(mx, fmaxf(sa[i], sb[i])); }
                softmax_pv2(sa, sb, mx, mref, o0, o1, m, l, kt + KT2_BYTES, lane);
            }
            if (!hn) break;
            BLK_STORE(cur ^ 1);
            __syncthreads();
            cur ^= 1; kb = kbn;
        }
    }
    __syncthreads();
}
struct ItRange64 { int kb0, kb_last; DI bool next(int& kb) const { const int nk = kb < 0 ? kb0 : kb + 64; if (nk > kb_last) return false; kb = nk; return true; } };
struct ItSlc64 { unsigned long long lo, hi; DI bool next(int& kb) const {
        int j = kb < 0 ? 0 : (kb >> 6) + 1; if (j > 127) return false;
        if (j < 64) { const unsigned long long mm = lo >> j; if (mm) { kb = (j + __builtin_ctzll(mm)) * 64; return true; } j = 64; }
        const unsigned long long mh = hi >> (j - 64); if (!mh) return false; kb = (j + __builtin_ctzll(mh)) * 64; return true; } };

constexpr int NSA_WLDS = 2 * VT_BYTES;
constexpr int NSAB_IMP = 2 * BT_BYTES, NSAB_XCH = NSAB_IMP + 8 * 8192, NSAB_END = NSAB_XCH + 128;
DI void nsa_block_unit(int b, int g, int Q0, const bf16* z, const bf16* cqn, const bf16* kcmp, const bf16* vcmp, bf16* O, LAS unsigned char* lds, int tid) {
    const int lane = tid & 63, wave = __builtin_amdgcn_readfirstlane(tid >> 6), tq0 = Q0 + 8 * wave, tmaxb = Q0 + 63;
    LAS unsigned char* tb = lds;
    const int r = lane & 31, h = lane >> 5, qi = r >> 2, hh = r & 3, head = 4 * g + hh, t_row = tq0 + qi, tmax = tq0 + 7;
    const size_t row = (size_t)b * T + t_row;
    LAS float* impA = (LAS float*)(lds + NSAB_IMP + wave * 8192); LAS float* impB = impA + 1024;
    bf16x8 qn[4];
    { const bf16* qnp = cqn + row * 512 + head * 64 + 8 * h;
#pragma unroll
      for (int ks = 0; ks < 4; ++ks) qn[ks] = *(const bf16x8*)(qnp + 16 * ks); }
    const float cs = 0.125f * LOG2E;
    const bf16* gp = z + row * ZLD + Z_CG + head * 3;
    const float gate_c = bf2f(gp[0]), gate_s = bf2f(gp[1]), gate_w = bf2f(gp[2]);
    f32x16 tot0, tot1, o0, o1; ZERO16(tot0); ZERO16(tot1);
    float m, l;
    const bf16* zb = z + (size_t)b * T * ZLD;
    const int ncmp = (tmax >= 31) ? ((tmax - 31) >> 4) + 1 : 0, ntc = (ncmp + 31) >> 5;
    const bf16* kcb = kcmp + (size_t)((b * 2 + g) * 512) * 64; const bf16* vcb = vcmp + (size_t)((b * 2 + g) * 512) * 64;
    ZERO16(o0); ZERO16(o1); m = -1e30f; l = 0.f;
    const int ncmpb = (tmaxb >= 31) ? ((tmaxb - 31) >> 4) + 1 : 0, nscb = (ncmpb + 63) >> 6;
    { struct MkCmp { int t_row, tq0, ncmp; DI bool needs(int nb) const { return nb < ncmp; } DI bool row(int) const { return true; } DI bool elem(int n) const { return 16 * n + 31 <= t_row; } DI bool full(int nb) const { return 16 * (nb + 63) + 31 <= tq0; } } mk{t_row, tq0, ncmp};
      ItRange64 itc{0, 64 * (nscb - 1)};
      attn_loop_blk(itc, mk, kcb, 64, vcb, 64, qn, cs, o0, o1, m, l, tb, tid, lane); }
    float ltot = l + __shfl_xor(l, 32);
    const float inv_c = ltot > 0.f ? 1.f / ltot : 0.f;
    { const float f = gate_c * inv_c;
#pragma unroll
      for (int i = 0; i < 16; ++i) { tot0[i] = o0[i] * f; tot1[i] = o1[i] * f; } }
#pragma unroll
    for (int i = 0; i < 16; ++i) { impA[lane + 64 * i] = 0.f; impB[lane + 64 * i] = 0.f; }
    {
        const int lk = tid >> 3, lc = tid & 7;
        const bf16* kbase = kcb; const size_t kstride = 64; const bf16* vbase = nullptr; const size_t vstride = 0;
        if (nscb > 0) {
            u32x4 regk = {0u, 0u, 0u, 0u}, regv = {0u, 0u, 0u, 0u};
            BLK_ISSUE(0); BLK_STORE(0);
            __syncthreads();
            int cur = 0;
            for (int st = 0; st < nscb; ++st) {
                const int nb0 = 64 * st; const bool hn = st + 1 < nscb;
                if (hn) BLK_ISSUE(nb0 + 64);
                if (nb0 < ncmp) {
                    const LAS unsigned char* ktile = tb + cur * BT_BYTES;
#pragma unroll
                    for (int hf = 0; hf < 2; ++hf) {
                        const int nb = nb0 + 32 * hf, kt = 2 * st + hf;
                        f32x16 s; ZERO16(s);
#pragma unroll
                        for (int ks = 0; ks < 4; ++ks) { const bf16x8 kf = *(const LAS bf16x8*)(ktile + (32 * hf + r) * KROWB + (16 * ks + 8 * h) * 2); s = MFMA32(kf, qn[ks], s); }
#pragma unroll
                        for (int g4 = 0; g4 < 4; ++g4) {
                            float pp[4];
#pragma unroll
                            for (int i = 0; i < 4; ++i) { const int n = nb + 8 * g4 + 4 * h + i; pp[i] = (16 * n + 31 <= t_row) ? ex2(s[4 * g4 + i] * cs - m) * inv_c : 0.f; }
                            float s4 = (pp[0] + pp[1]) + (pp[2] + pp[3]), p3 = pp[3];
                            s4 += __shfl_xor(s4, 1); p3 += __shfl_xor(p3, 1);
                            s4 += __shfl_xor(s4, 2); p3 += __shfl_xor(p3, 2);
                            if (hh == 0) { const int j0 = 8 * kt + 2 * g4 + h; impA[qi * 128 + j0] = s4; impB[qi * 128 + j0] = p3; }
                        }
                    }
                }
                if (!hn) break;
                BLK_STORE(cur ^ 1);
                __syncthreads();
                cur ^= 1;
            }
        }
        __syncthreads();
    }
    const int jq = tmax >> 6;
    unsigned mk0 = 0, mk1 = 0, mk2 = 0, mk3 = 0;
    unsigned long long ulo = 0ull, uhi = 0ull;
    for (int q8 = 0; q8 < 8; ++q8) {
        const int j0 = lane, j1 = lane + 64;
        bool sel0, sel1;
        if (jq + 1 <= 16) { sel0 = j0 <= jq; sel1 = false; }
        else {
            const float i0 = impA[q8 * 128 + j0] + (j0 >= 1 ? impB[q8 * 128 + j0 - 1] : 0.f);
            const float i1 = impA[q8 * 128 + j1] + impB[q8 * 128 + j1 - 1];
            const bool fr0 = (j0 >= 1 && j0 <= jq - 2), fr1 = (j1 <= jq - 2);
            const bool fo0 = (j0 == 0 || j0 == jq || j0 == jq - 1), fo1 = (j1 == jq || j1 == jq - 1);
            const unsigned long long k0 = fr0 ? (((unsigned long long)__builtin_bit_cast(unsigned, i0) << 7) | (unsigned)(127 - j0)) : 0ull;
            const unsigned long long k1 = fr1 ? (((unsigned long long)__builtin_bit_cast(unsigned, i1) << 7) | (unsigned)(127 - j1)) : 0ull;
            unsigned long long Tk = 0ull;
            for (int bit = 38; bit >= 0; --bit) {
                const unsigned long long cand = Tk | (1ull << bit);
                const int cnt = __builtin_popcountll(__ballot(k0 >= cand)) + __builtin_popcountll(__ballot(k1 >= cand));
                if (cnt >= 13) Tk = cand;
            }
            sel0 = fo0 || (fr0 && k0 >= Tk); sel1 = fo1 || (fr1 && k1 >= Tk);
        }
        const unsigned long long mlo = __ballot(sel0), mhi = __ballot(sel1);
        ulo |= mlo; uhi |= mhi;
        if (qi == q8) { mk0 = (unsigned)mlo; mk1 = (unsigned)(mlo >> 32); mk2 = (unsigned)mhi; mk3 = (unsigned)(mhi >> 32); }
    }
#pragma unroll
    for (int i = 0; i < 16; ++i) { impA[i * 64 + lane] = tot0[i]; impA[(16 + i) * 64 + lane] = tot1[i]; }
    bf16x8 qr[4];
    { const bf16* qrp = z + row * ZLD + Z_CQ + head * 64 + 8 * h;
#pragma unroll
      for (int ks = 0; ks < 4; ++ks) qr[ks] = *(const bf16x8*)(qrp + 16 * ks); }
    ZERO16(o0); ZERO16(o1); m = -1e30f; l = 0.f;
    { struct MkSlc { unsigned m0, m1, m2, m3; int t_row; DI bool row(int kb) const { const int j = kb >> 6; const unsigned mw = (j < 32) ? m0 : (j < 64) ? m1 : (j < 96) ? m2 : m3; return (mw >> (j & 31)) & 1u; }
                      DI bool elem(int key) const { return key <= t_row; } DI bool full(int kb) const { return kb + 63 <= tq0; } int tq0; unsigned long long wlo, whi; DI bool needs(int kb) const { const int j = kb >> 6; return kb <= tq0 + 7 && ((j < 64) ? ((wlo >> j) & 1ull) : ((whi >> (j - 64)) & 1ull)); } } mk{mk0, mk1, mk2, mk3, t_row, tq0, ulo, uhi};
      LAS unsigned long long* xch = (LAS unsigned long long*)(lds + NSAB_XCH);
      if (lane == 0) { xch[2 * wave] = ulo; xch[2 * wave + 1] = uhi; }
      __syncthreads();
      unsigned long long blo = 0ull, bhi = 0ull;
#pragma unroll
      for (int ww = 0; ww < 8; ++ww) { blo |= xch[2 * ww]; bhi |= xch[2 * ww + 1]; }
      ItSlc64 its{blo, bhi};
      attn_loop_blk(its, mk, zb + Z_KS + g * 64, ZLD, zb + Z_VS + g * 64, ZLD, qr, cs, o0, o1, m, l, tb, tid, lane); }
    ltot = l + __shfl_xor(l, 32);
    { const float f = gate_s * (ltot > 0.f ? 1.f / ltot : 0.f);
#pragma unroll
      for (int i = 0; i < 16; ++i) { impA[i * 64 + lane] += o0[i] * f; impA[(16 + i) * 64 + lane] += o1[i] * f; } }
    ZERO16(o0); ZERO16(o1); m = -1e30f; l = 0.f;
    { const int klo = tq0 - 511 > 0 ? tq0 - 511 : 0;
      struct MkWin { int t_row, tq0, klo; DI bool needs(int kb) const { return kb <= tq0 + 7 && kb + 63 >= klo; } DI bool row(int) const { return true; } DI bool elem(int key) const { return key <= t_row && t_row - key < 512; } DI bool full(int kb) const { return kb + 63 <= tq0 && (tq0 + 7) - kb < 512; } } mk{t_row, tq0, klo};
      const int klob = Q0 - 511 > 0 ? Q0 - 511 : 0;
      ItRange64 itw{klob & ~63, tmaxb & ~63};
      attn_loop_blk(itw, mk, zb + Z_KW + g * 64, ZLD, zb + Z_VW + g * 64, ZLD, qr, cs, o0, o1, m, l, tb, tid, lane); }
    ltot = l + __shfl_xor(l, 32);
    { const float f = gate_w * (ltot > 0.f ? 1.f / ltot : 0.f);
#pragma unroll
      for (int i = 0; i < 16; ++i) { tot0[i] = impA[i * 64 + lane] + o0[i] * f; tot1[i] = impA[(16 + i) * 64 + lane] + o1[i] * f; } }
    bf16* op = O + row * 512 + head * 64 + 4 * h;
#pragma unroll
    for (int g4 = 0; g4 < 4; ++g4) {
        u32x2 a, c2; a.x = pk2(tot0[4 * g4], tot0[4 * g4 + 1]); a.y = pk2(tot0[4 * g4 + 2], tot0[4 * g4 + 3]);
        c2.x = pk2(tot1[4 * g4], tot1[4 * g4 + 1]); c2.y = pk2(tot1[4 * g4 + 2], tot1[4 * g4 + 3]);
        *(u32x2*)(op + 8 * g4) = a; *(u32x2*)(op + 32 + 8 * g4) = c2;
    }
}

constexpr int MB_SEL = 8 * 12288, MB_LIST = MB_SEL + 1024, MB_KM = MB_LIST + 8 * 512, MB_END = MB_KM + 8192;
constexpr int PART_F = 36;
DI void moba_write_partial(float* pp, bool active, int h, const f32x16& o0, const f32x16& o1, float m, float ltot) {
#pragma unroll
    for (int g4 = 0; g4 < 4; ++g4) { u32x2 a, c; a.x = pk2(o0[4 * g4], o0[4 * g4 + 1]); a.y = pk2(o0[4 * g4 + 2], o0[4 * g4 + 3]); c.x = pk2(o1[4 * g4], o1[4 * g4 + 1]); c.y = pk2(o1[4 * g4 + 2], o1[4 * g4 + 3]);
        const u32x2 snd = h ? a : c; u32x2 rcv; rcv.x = (unsigned)__shfl_xor((int)snd.x, 32); rcv.y = (unsigned)__shfl_xor((int)snd.y, 32);
        u32x4 o4; o4.x = h ? rcv.x : a.x; o4.y = h ? rcv.y : a.y; o4.z = h ? c.x : rcv.x; o4.w = h ? c.y : rcv.y;
        if (active) *(u32x4*)((bf16*)pp + 32 * h + 8 * g4) = o4; }
    if (active && h == 0) { pp[32] = m; pp[33] = ltot; }
}
DI void moba_block_item(int b, int head, int own, int item, const bf16* z, const float* kmean, bf16* O, float* part, LAS unsigned char* lds, int tid) {
    const int lane = tid & 63, wave = __builtin_amdgcn_readfirstlane(tid >> 6), r = lane & 31, h = lane >> 5;
    const int Q0 = 256 * own, tq0 = Q0 + 32 * wave, t_row = tq0 + r, tmax = tq0 + 31;
    const size_t row = (size_t)b * T + t_row;
    LAS unsigned char* vt = lds + wave * NSA_WLDS;
    LAS unsigned* selb = (LAS unsigned*)(lds + MB_SEL);
    LAS unsigned short* rlist = (LAS unsigned short*)(lds + MB_LIST + wave * 512);
    const bf16* zb = z + (size_t)b * T * ZLD;
    float* pbase = part + (size_t)item * 256 * 4 * PART_F;
    const float cs = 0.125f * LOG2E;
    LAS float* kml = (LAS float*)(lds + MB_KM);
    __syncthreads();
    { const int e = tid * 4, n = e >> 6, d = e & 63; *(LAS f32x4*)(kml + e) = *(const f32x4*)(kmean + (size_t)((b * 32 + n) * 256 + head * 64 + d)); }
    __syncthreads();
    int i0 = -1, i1 = -1, i2 = -1;
    {
        u32x4 qrow[8];
        { const u32x4* qp = (const u32x4*)(z + row * ZLD + Z_BQ + head * 64);
#pragma unroll
          for (int c = 0; c < 8; ++c) qrow[c] = qp[c]; }
        float v0 = NEG_INF, v1 = NEG_INF, v2 = NEG_INF;
        for (int n = 0; n < own; ++n) {
            const LAS f32x4* km = (const LAS f32x4*)(kml + n * 64);
            float gsum = 0.f;
#pragma unroll
            for (int c = 0; c < 8; ++c) { const f32x4 ka = km[2 * c], kb2 = km[2 * c + 1]; const u32x4 qq = qrow[c];
                gsum += bflo(qq.x) * ka.x + bfhi(qq.x) * ka.y + bflo(qq.y) * ka.z + bfhi(qq.y) * ka.w + bflo(qq.z) * kb2.x + bfhi(qq.z) * kb2.y + bflo(qq.w) * kb2.z + bfhi(qq.w) * kb2.w; }
            if (gsum > v0) { v2 = v1; i2 = i1; v1 = v0; i1 = i0; v0 = gsum; i0 = n; }
            else if (gsum > v1) { v2 = v1; i2 = i1; v1 = gsum; i1 = n; }
            else if (gsum > v2) { v2 = gsum; i2 = n; }
        }
    }
    if (h == 0) selb[32 * wave + r] = (unsigned)(i0 & 0xff) | ((unsigned)(i1 & 0xff) << 8) | ((unsigned)(i2 & 0xff) << 16);
    {
        bf16x8 qf[4];
        { const bf16* qp = z + row * ZLD + Z_BQ + head * 64 + 8 * h;
#pragma unroll
          for (int ks = 0; ks < 4; ++ks) qf[ks] = *(const bf16x8*)(qp + 16 * ks); }
        f32x16 o0, o1; ZERO16(o0); ZERO16(o1); float m = -1e30f, l = 0.f;
        struct MkOwn { int t_row, tq0; DI bool row(int) const { return true; } DI bool elem(int key) const { return key <= t_row; } DI bool full(int kb) const { return kb + 31 <= tq0; } } mk{t_row, tq0};
        ItMoba itm{1u << own, tmax};
        attn_loop(itm, mk, zb + Z_BK + head * 64, ZLD, zb + Z_BV + head * 64, ZLD, qf, cs, o0, o1, m, l, vt, vt + VT_BYTES, lane);
        const float ltot = l + __shfl_xor(l, 32);
        moba_write_partial(pbase + ((size_t)(32 * wave + r) * 4 + 3) * PART_F, true, h, o0, o1, m, ltot);
    }
    __syncthreads();
#pragma unroll 1
    for (int n = 0; n < own; ++n) {
        int cnt = 0;
#pragma unroll
        for (int j = 0; j < 4; ++j) { const int q = lane + 64 * j; const unsigned sv = selb[q];
            const int slot = ((sv & 0xffu) == (unsigned)n) ? 0 : (((sv >> 8) & 0xffu) == (unsigned)n) ? 1 : (((sv >> 16) & 0xffu) == (unsigned)n) ? 2 : -1;
            const bool pr = slot >= 0; const unsigned long long mk_ = __ballot(pr);
            const int pos = cnt + (int)__builtin_amdgcn_mbcnt_hi((unsigned)(mk_ >> 32), __builtin_amdgcn_mbcnt_lo((unsigned)mk_, 0u));
            if (pr) rlist[pos] = (unsigned short)(q | (slot << 8));
            cnt += __builtin_popcountll(mk_); }
#pragma unroll 1
        for (int rt = (wave - n) & 7; rt * 32 < cnt; rt += 8) {
            const bool active = rt * 32 + r < cnt;
            const unsigned ent = rlist[active ? rt * 32 + r : 0];
            const int q = ent & 0xff, slot = (int)(ent >> 8);
            bf16x8 qf[4];
            { const bf16* qp = zb + (size_t)(Q0 + q) * ZLD + Z_BQ + head * 64 + 8 * h;
#pragma unroll
              for (int ks = 0; ks < 4; ++ks) qf[ks] = *(const bf16x8*)(qp + 16 * ks); }
            f32x16 o0, o1; ZERO16(o0); ZERO16(o1); float m = -1e30f, l = 0.f;
            struct MkAll { bool act; DI bool row(int) const { return act; } DI bool elem(int) const { return true; } DI bool full(int) const { return true; } } mk{active};
            ItMoba itm{1u << n, 0x7fffffff};
            attn_loop(itm, mk, zb + Z_BK + head * 64, ZLD, zb + Z_BV + head * 64, ZLD, qf, cs, o0, o1, m, l, vt, vt + VT_BYTES, lane);
            const float ltot = l + __shfl_xor(l, 32);
            moba_write_partial(pbase + ((size_t)q * 4 + slot) * PART_F, active, h, o0, o1, m, ltot);
        }
    }
    VM_WAIT();
    __syncthreads();
    {
        const float* pq = pbase + (size_t)(32 * wave + r) * 4 * PART_F;
        float mm[4], ll[4];
        { float mr[4], lr[4];
#pragma unroll
          for (int sl = 0; sl < 4; ++sl) { mr[sl] = pq[sl * PART_F + 32]; lr[sl] = pq[sl * PART_F + 33]; }
#pragma unroll
          for (int sl = 0; sl < 4; ++sl) { const bool valid = (sl == 3) || ((sl == 0 ? i0 : sl == 1 ? i1 : i2) >= 0);
              mm[sl] = valid ? mr[sl] : -1e30f; ll[sl] = valid ? lr[sl] : 0.f; } }
        const float M_ = fmaxf(fmaxf(mm[0], mm[1]), fmaxf(mm[2], mm[3]));
        float wgt[4], L = 0.f;
#pragma unroll
        for (int sl = 0; sl < 4; ++sl) { wgt[sl] = ex2(mm[sl] - M_); if (ll[sl] == 0.f) wgt[sl] = 0.f; L += ll[sl] * wgt[sl]; }
        const float inv = (L > 0.f ? 1.f / L : 0.f);
        bf16* op = O + row * 256 + head * 64 + 4 * h;
#pragma unroll
        for (int g4 = 0; g4 < 4; ++g4) {
            u32x2 pua[4], pub[4];
#pragma unroll
            for (int sl = 0; sl < 4; ++sl) {
                const u32x4 w4 = *(const u32x4*)((const bf16*)(pq + sl * PART_F) + 32 * h + 8 * g4);
                u32x2 snd, rcv; snd.x = h ? w4.x : w4.z; snd.y = h ? w4.y : w4.w; rcv.x = (unsigned)__shfl_xor((int)snd.x, 32); rcv.y = (unsigned)__shfl_xor((int)snd.y, 32);
                pua[sl].x = h ? rcv.x : w4.x; pua[sl].y = h ? rcv.y : w4.y; pub[sl].x = h ? w4.z : rcv.x; pub[sl].y = h ? w4.w : rcv.y; }
            f32x4 a = {0.f, 0.f, 0.f, 0.f}, c2 = {0.f, 0.f, 0.f, 0.f};
#pragma unroll
            for (int sl = 0; sl < 4; ++sl) { const bool use = wgt[sl] != 0.f;
                u32x2 ua_ = pua[sl], ub_ = pub[sl];
                ua_.x = use ? ua_.x : 0u; ua_.y = use ? ua_.y : 0u; ub_.x = use ? ub_.x : 0u; ub_.y = use ? ub_.y : 0u;
                const f32x4 pa = {bflo(ua_.x), bfhi(ua_.x), bflo(ua_.y), bfhi(ua_.y)}, pb = {bflo(ub_.x), bfhi(ub_.x), bflo(ub_.y), bfhi(ub_.y)};
                a = a + pa * wgt[sl]; c2 = c2 + pb * wgt[sl]; }
            u32x2 ua, uc; ua.x = pk2(a[0] * inv, a[1] * inv); ua.y = pk2(a[2] * inv, a[3] * inv); uc.x = pk2(c2[0] * inv, c2[1] * inv); uc.y = pk2(c2[2] * inv, c2[3] * inv);
            *(u32x2*)(op + 8 * g4) = ua; *(u32x2*)(op + 32 + 8 * g4) = uc;
        }
    }
}

DI void kmean_item(int it, const bf16* z, float* kmean, LAS unsigned char* lds, int tid) {
    const int b = it >> 5, n = it & 31, col = tid & 255, half = tid >> 8;
    const bf16* p = z + ((size_t)b * T + 256 * n + 128 * half) * ZLD + Z_BK + col;
    float a = 0.f;
#pragma unroll 8
    for (int k = 0; k < 128; ++k) a += bf2f(p[(size_t)k * ZLD]);
    LAS float* red = (LAS float*)lds;
    __syncthreads();
    if (half) red[col] = a;
    __syncthreads();
    if (!half) kmean[(size_t)(b * 32 + n) * 256 + col] = (a + red[col]) * (1.f / 256.f);
    __syncthreads();
}

DI float gelu_tanh(float x) { const float u = 0.7978845608028654f * (x + 0.044715f * x * x * x); const float e = ex2(2.f * LOG2E * u); const float th = 1.f - 2.f * __builtin_amdgcn_rcpf(e + 1.f); return 0.5f * x * (1.f + th); }
DI void compress_item(int it, const bf16* z, const bf16* Wb, const float* bias1p, bf16* kcmp, bf16* vcmp, LAS unsigned char* lds, int tid) {
    const int lane = tid & 63, wave = tid >> 6, r = lane & 31, h = lane >> 5;
    const int kv = it & 1, rtile = it >> 1, kh = wave >> 2, ut = wave & 3;
    const int R0 = 32 * rtile;
    const int bg = R0 >> 9, b = bg >> 1, g = bg & 1, n0 = R0 & 511;
    const bf16* w1t = Wb + (kv ? W_1V : W_1K); const bf16* w2t = Wb + (kv ? W_2V : W_2K);
    bf16* outp = kv ? vcmp : kcmp;
    int n = n0 + r; if (n > 510) n = 510;
    const bf16* ap = z + ((size_t)b * T + 16 * n) * ZLD + (kv ? Z_VC : Z_KC) + g * 64 + 8 * h;
    const bf16* bp = w1t + (size_t)(ut * 32 + r) * 2048 + 8 * h;
    f32x16 acc; ZERO16(acc);
#pragma unroll 8
    for (int kk = 0; kk < 64; ++kk) {
        const int ks = 64 * kh + kk, k0 = 16 * ks, ti = k0 >> 6, d = k0 & 63;
        const bf16x8 a = *(const bf16x8*)(ap + (size_t)ti * ZLD + d);
        const bf16x8 bb = *(const bf16x8*)(bp + k0);
        acc = MFMA32(a, bb, acc);
    }
    constexpr int HROW = 272, PSTR = 129, HID_OFF = 2 * 32 * PSTR * 4;
    LAS float* ps = (LAS float*)lds;
    __syncthreads();
#pragma unroll
    for (int i = 0; i < 16; ++i) ps[(kh * 32 + crow(i, h)) * PSTR + ut * 32 + r] = acc[i];
    __syncthreads();
    { const int u = tid & 127, rq = tid >> 7; float bias = 0.f;
#pragma unroll
      for (int c = 0; c < 8; ++c) bias += bias1p[(kv * 8 + c) * 128 + u];
#pragma unroll
      for (int i = 0; i < 8; ++i) { const int rowl = rq * 8 + i; const float v = ps[rowl * PSTR + u] + ps[(32 + rowl) * PSTR + u] + bias;
          *(LAS bf16*)(lds + HID_OFF + rowl * HROW + u * 2) = (bf16)f2bf(gelu_tanh(v)); } }
    __syncthreads();
    if (wave < 2) {
        const int ot = wave;
        f32x16 c2; ZERO16(c2);
#pragma unroll
        for (int ks = 0; ks < 8; ++ks) {
            const bf16x8 a = *(const LAS bf16x8*)(lds + HID_OFF + r * HROW + (16 * ks + 8 * h) * 2);
            const bf16x8 bb = *(const bf16x8*)(w2t + (size_t)(ot * 32 + r) * 128 + 16 * ks + 8 * h);
            c2 = MFMA32(a, bb, c2);
        }
#pragma unroll
        for (int i = 0; i < 16; ++i) { const int R = R0 + crow(i, h); const bool dead = (R & 511) == 511;
            outp[(size_t)R * 64 + ot * 32 + r] = dead ? (bf16)0 : (bf16)f2bf(c2[i]); }
    }
    __syncthreads();
}

constexpr int DS_S = 0, DS_SEL = 65536, DS_P = DS_SEL + 8 * 1024, DS_DMY = DS_P + 8 * 4096, DSA_LDS_END = DS_DMY + 8 * 256;
DI float relu_i(float x) { const int b = __builtin_bit_cast(int, x); return __builtin_bit_cast(float, b > 0 ? b : 0); }
DI unsigned orderkey(float s) { const unsigned u = __builtin_bit_cast(unsigned, s); return (u & 0x80000000u) ? ~u : (u | 0x80000000u); }
#define DPP_I(v, ctrl) __builtin_amdgcn_update_dpp(0, (v), (ctrl), 0xf, 0xf, false)
DI int row16_sum(int c) { c += DPP_I(c, 0x128); c += DPP_I(c, 0x124); c += DPP_I(c, 0x122); c += DPP_I(c, 0x121); return c; }
DI int wave_sum_i(int c) { c = row16_sum(c); return __builtin_amdgcn_readlane(c, 0) + __builtin_amdgcn_readlane(c, 16) + __builtin_amdgcn_readlane(c, 32) + __builtin_amdgcn_readlane(c, 48); }
#define DPP_F(v, ctrl) __builtin_bit_cast(float, DPP_I(__builtin_bit_cast(int, (v)), (ctrl)))
DI float row16_max(float v) { v = fmaxf(v, DPP_F(v, 0x128)); v = fmaxf(v, DPP_F(v, 0x124)); v = fmaxf(v, DPP_F(v, 0x122)); v = fmaxf(v, DPP_F(v, 0x121)); return v; }
DI float row16_sumf(float v) { v += DPP_F(v, 0x128); v += DPP_F(v, 0x124); v += DPP_F(v, 0x122); v += DPP_F(v, 0x121); return v; }
DI float oct_sumf(float v) {
    v += __builtin_bit_cast(float, DPP_I(__builtin_bit_cast(int, v), 0xB1));
    v += __builtin_bit_cast(float, DPP_I(__builtin_bit_cast(int, v), 0x4E));
    v += __builtin_bit_cast(float, DPP_I(__builtin_bit_cast(int, v), 0x141));
    return v; }
DI unsigned umin_(unsigned a, unsigned b) { return a < b ? a : b; }
DI unsigned umax_(unsigned a, unsigned b) { return a > b ? a : b; }
#define DPP_U(v, ctrl) ((unsigned)DPP_I((int)(v), (ctrl)))
DI unsigned wave_minu(unsigned v) { v = umin_(v, DPP_U(v, 0x128)); v = umin_(v, DPP_U(v, 0x124)); v = umin_(v, DPP_U(v, 0x122)); v = umin_(v, DPP_U(v, 0x121));
    return umin_(umin_((unsigned)__builtin_amdgcn_readlane((int)v, 0), (unsigned)__builtin_amdgcn_readlane((int)v, 16)), umin_((unsigned)__builtin_amdgcn_readlane((int)v, 32), (unsigned)__builtin_amdgcn_readlane((int)v, 48))); }
DI unsigned wave_maxu(unsigned v) { v = umax_(v, DPP_U(v, 0x128)); v = umax_(v, DPP_U(v, 0x124)); v = umax_(v, DPP_U(v, 0x122)); v = umax_(v, DPP_U(v, 0x121));
    return umax_(umax_((unsigned)__builtin_amdgcn_readlane((int)v, 0), (unsigned)__builtin_amdgcn_readlane((int)v, 16)), umax_((unsigned)__builtin_amdgcn_readlane((int)v, 32), (unsigned)__builtin_amdgcn_readlane((int)v, 48))); }
template <int NE>
DI void dsa_select(const unsigned (&ek)[NE], const int (&ei)[NE], unsigned& Tprev, LAS unsigned* selk, LAS int* selw, LAS unsigned* dmy, int& nsel, int lane, int nvalid) {
    unsigned L = Tprev, Kmax;
    { unsigned gm = 0u;
      if constexpr (NE == 36) {
          unsigned g4[4];
#pragma unroll
          for (int q = 0; q < 4; ++q) { unsigned g = ek[9 * q];
#pragma unroll
              for (int i = 1; i < 9; ++i) g = umax_(g, ek[9 * q + i]);
              g4[q] = g; }
          gm = umax_(umax_(g4[0], g4[1]), umax_(g4[2], g4[3]));
          const unsigned L2 = wave_minu(umin_(umin_(g4[0], g4[1]), umin_(g4[2], g4[3])));
          if (L2 > L) L = L2;
      } else {
#pragma unroll
          for (int i = 0; i < NE; ++i) gm = umax_(gm, ek[i]);
      }
      Kmax = wave_maxu(gm); }
    unsigned Tv = 0u; bool exact = false;
    int cHi = 0, cLo = nvalid, cBase = 0; bool compact = false; unsigned a0 = 0u, a1 = 0u, a2 = 0u, a3 = 0u;
    for (int bit = (nvalid > 256) ? 31 : -1; bit >= 0; --bit) {
        const unsigned cand = Tv | (1u << bit);
        if (cand <= L) { Tv = cand; continue; }
        if (cand > Kmax) continue;
        if constexpr (NE == 10) {
            if (bit >= 1) {
                const unsigned c1 = Tv | (1u << (bit - 1)), c3 = cand | (1u << (bit - 1));
                int l1 = 0, l2 = 0, l3 = 0, tmp; unsigned v1 = c1, v2 = cand, v3 = c3;
#define DSA_LT3(x) asm volatile("v_sub_co_u32_e32 %3, vcc, %4, %5\n\tv_addc_co_u32_e32 %0, vcc, 0, %0, vcc\n\tv_sub_co_u32_e32 %3, vcc, %4, %6\n\tv_addc_co_u32_e32 %1, vcc, 0, %1, vcc\n\t" \
                                "v_sub_co_u32_e32 %3, vcc, %4, %7\n\tv_addc_co_u32_e32 %2, vcc, 0, %2, vcc" : "+v"(l1), "+v"(l2), "+v"(l3), "=&v"(tmp) : "v"(x), "v"(v1), "v"(v2), "v"(v3) : "vcc");
#pragma unroll
                for (int i = 0; i < NE; ++i) { DSA_LT3(ek[i]) }
#undef DSA_LT3
                const int pk = wave_sum_i(l1 | (l2 << 10) | (l3 << 20));
                const int n1 = 64 * NE - (pk & 1023), n2 = 64 * NE - ((pk >> 10) & 1023), n3 = 64 * NE - (pk >> 20);
                int nsel_ = 0;
                if (n3 >= 256) { Tv = c3; nsel_ = n3; } else if (n2 >= 256) { Tv = cand; nsel_ = n2; } else if (n1 >= 256) { Tv = c1; nsel_ = n1; }
                --bit;
                if (nsel_ == 256) { exact = true; break; }
                continue;
            }
        }
        int tot;
        if (compact) {
            tot = cBase + __builtin_popcountll(__ballot(a0 >= cand)) + __builtin_popcountll(__ballot(a1 >= cand)) + __builtin_popcountll(__ballot(a2 >= cand)) + __builtin_popcountll(__ballot(a3 >= cand));
        } else {
            int lt0 = 0, lt1 = 0, tmp; unsigned cv = cand;
#define DSA_LT(acc, x) asm volatile("v_sub_co_u32_e32 %1, vcc, %2, %3\n\tv_addc_co_u32_e32 %0, vcc, 0, %0, vcc" : "+v"(acc), "=&v"(tmp) : "v"(x), "v"(cv) : "vcc");
#pragma unroll
            for (int i = 0; i < NE; i += 2) { DSA_LT(lt0, ek[i]) DSA_LT(lt1, ek[i + 1]) }
#undef DSA_LT
            tot = 64 * NE - wave_sum_i(lt0 + lt1);
        }
        if (tot >= 256) { Tv = cand; cLo = tot; if (tot == 256) { exact = true; break; } }
        else cHi = tot;
        if constexpr (NE == 36) {
            if (!compact && bit > 0 && cLo - cHi <= 256) {
                LAS unsigned* tk = selk + 256; const unsigned lo1 = Tv ? Tv : 1u, span = Tv + (1u << bit) - lo1; int ns = 0;
#pragma unroll
                for (int i = 0; i < NE; ++i) { const bool s_ = (ek[i] - lo1) < span; const unsigned long long mk_ = __ballot(s_);
                    const int pos_ = (int)__builtin_amdgcn_mbcnt_hi((unsigned)(mk_ >> 32), __builtin_amdgcn_mbcnt_lo((unsigned)mk_, (unsigned)ns));
                    *(s_ ? tk + pos_ : dmy) = ek[i]; ns += __builtin_popcountll(mk_); }
                { const unsigned r0 = tk[lane], r1 = tk[64 + lane], r2 = tk[128 + lane], r3 = tk[192 + lane];
                  a0 = (lane < ns) ? r0 : 0u; a1 = (64 + lane < ns) ? r1 : 0u; a2 = (128 + lane < ns) ? r2 : 0u; a3 = (192 + lane < ns) ? r3 : 0u; }
                compact = true; cBase = cHi;
            }
        }
    }
    int Xi = 0x7fffffff;
    if (!exact) {
        if (Tv == 0u) Tv = 1u;
        else {
            int cg = 0, ce = 0;
#pragma unroll
            for (int i = 0; i < NE; ++i) { cg += (ek[i] > Tv) ? 1 : 0; ce += (ek[i] == Tv) ? 1 : 0; }
            const int tg = wave_sum_i(cg), te = wave_sum_i(ce), need = 256 - tg;
            if (te != need) {
                int X = 0;
                for (int bit = 12; bit >= 0; --bit) {
                    const int cand = X | (1 << bit);
                    int cnt = 0;
#pragma unroll
                    for (int i = 0; i < NE; ++i) cnt += (ek[i] == Tv && ei[i] < cand) ? 1 : 0;
                    if (wave_sum_i(cnt) < need) X = cand;
                }
                Xi = X;
            }
        }
    }
    int run = 0;
#pragma unroll
    for (int i = 0; i < NE; ++i) { const bool s_ = (ek[i] > Tv) || (ek[i] == Tv && ei[i] <= Xi); const unsigned long long mk_ = __ballot(s_);
        const int pos_ = (int)__builtin_amdgcn_mbcnt_hi((unsigned)(mk_ >> 32), __builtin_amdgcn_mbcnt_lo((unsigned)mk_, (unsigned)run));
        const bool w_ = s_ && pos_ < 256;
        *(w_ ? selk + pos_ : dmy) = ek[i]; *(w_ ? selw + pos_ : (LAS int*)dmy) = ei[i]; run += __builtin_popcountll(mk_); }
    nsel = run > 256 ? 256 : run;
    Tprev = (run >= 256) ? Tv : 0u;
}
DI void dsa_item(int item, const bf16* z, bf16* O, LAS unsigned char* lds, int tid) {
    const int lane = tid & 63, w = __builtin_amdgcn_readfirstlane(tid >> 6);
    const int b = item & 1, tq0 = (item >> 1) * 8, tmax = tq0 + 7, tq = tq0 + w;
    const bf16* zb = z + (size_t)b * T * ZLD;
    const char* zbb = (const char*)zb;
    LAS unsigned* S = (LAS unsigned*)(lds + DS_S);
    LAS int* selw = (LAS int*)(lds + DS_SEL) + w * 256;
    LAS unsigned* selk = (LAS unsigned*)(lds + DS_P) + w * 1024;
    LAS float* pl = (LAS float*)(lds + DS_P) + w * 1024;
    LAS unsigned* dmy = (LAS unsigned*)(lds + DS_DMY) + w * 64 + lane;
    const int qq = lane >> 4, kq = lane >> 4, l15 = lane & 15;
    const int nchunk = (tmax >> 11) + 1;
    unsigned cs0 = 0u, cs1 = 0u, cs2 = 0u, cs3 = 0u; int ci0 = 0, ci1 = 0, ci2 = 0, ci3 = 0; int nsel = 0;
    unsigned Tprev = 0u;
    __syncthreads();
    bf16x8 af0, af1, ag0, ag1;
    { const int qa = l15 >> 2, ha = l15 & 3; const bf16* p = zb + (size_t)(tq0 + qa) * ZLD + Z_IQ + ha * 64 + 8 * kq;
      af0 = *(const bf16x8*)p; af1 = *(const bf16x8*)(p + 32); ag0 = *(const bf16x8*)(p + 4 * ZLD); ag1 = *(const bf16x8*)(p + 4 * ZLD + 32); }
#define DSA_KLOAD(b0, b1, c_, bt_) do { _Pragma("unroll") for (int i = 0; i < 8; ++i) { const int kl_ = (w + 8 * (8 * (bt_) + i)) * 16 + l15; \
        const unsigned ko_ = ((unsigned)((c_) * 2048 + kl_) * (unsigned)ZLD + (unsigned)(Z_IK + 8 * kq)) * 2u; b0[i] = *(const bf16x8*)(zbb + ko_); b1[i] = *(const bf16x8*)(zbb + ko_ + 64u); } } while (0)
#define DSA_KSCORE(b0, b1, c_, bt_) do { _Pragma("unroll") for (int i = 0; i < 8; ++i) { const int kl_ = (w + 8 * (8 * (bt_) + i)) * 16 + l15; \
        f32x4 cl = {0.f, 0.f, 0.f, 0.f}, ch = {0.f, 0.f, 0.f, 0.f}; \
        cl = MFMA16(af0, b0[i], cl); cl = MFMA16(af1, b1[i], cl); ch = MFMA16(ag0, b0[i], ch); ch = MFMA16(ag1, b1[i], ch); \
        const float sl = iwl0 * relu_i(cl[0]) + iwl1 * relu_i(cl[1]) + iwl2 * relu_i(cl[2]) + iwl3 * relu_i(cl[3]); \
        const float sh = iwh0 * relu_i(ch[0]) + iwh1 * relu_i(ch[1]) + iwh2 * relu_i(ch[2]) + iwh3 * relu_i(ch[3]); \
        S[qq * 2048 + kl_] = orderkey(sl); S[(4 + qq) * 2048 + kl_] = orderkey(sh); } } while (0)
    bf16x8 pb0[8], pb1[8];
    DSA_KLOAD(pb0, pb1, 0, 0);
#pragma unroll 1
    for (int c = 0; c < nchunk; ++c) {
        {
            float iwl0, iwl1, iwl2, iwl3, iwh0, iwh1, iwh2, iwh3;
            { const u32x2 a = *(const u32x2*)(zb + (size_t)(tq0 + qq) * ZLD + Z_IW), cc = *(const u32x2*)(zb + (size_t)(tq0 + 4 + qq) * ZLD + Z_IW);
              iwl0 = bflo(a.x); iwl1 = bfhi(a.x); iwl2 = bflo(a.y); iwl3 = bfhi(a.y); iwh0 = bflo(cc.x); iwh1 = bfhi(cc.x); iwh2 = bflo(cc.y); iwh3 = bfhi(cc.y); }
            bf16x8 qb0[8], qb1[8];
            const bool second = c * 2048 + 1024 <= tmax;
            if (second) { DSA_KLOAD(qb0, qb1, c, 1); DSA_KSCORE(pb0, pb1, c, 0); DSA_KSCORE(qb0, qb1, c, 1); }
            else DSA_KSCORE(pb0, pb1, c, 0);
        }
        if (c + 1 < nchunk) DSA_KLOAD(pb0, pb1, c + 1, 0);
        __syncthreads();
        unsigned sc[32];
        const int kbase = c * 2048 + lane * 4;
#pragma unroll
        for (int j = 0; j < 8; ++j) { const u32x4 v = *(const LAS u32x4*)(S + w * 2048 + j * 256 + lane * 4); const int key = kbase + j * 256;
            sc[j * 4 + 0] = (key + 0 <= tq) ? v.x : 0u; sc[j * 4 + 1] = (key + 1 <= tq) ? v.y : 0u;
            sc[j * 4 + 2] = (key + 2 <= tq) ? v.z : 0u; sc[j * 4 + 3] = (key + 3 <= tq) ? v.w : 0u; }
        __syncthreads();
        if (c * 2048 <= tq) {
            bool done = false;
            if (Tprev != 0u) {
                LAS unsigned* tk = selk + 256; LAS int* ti = (LAS int*)(selk + 640);
                int ns = 0;
#pragma unroll
                for (int i = 0; i < 32; ++i) { const bool s_ = sc[i] >= Tprev; const unsigned long long mk_ = __ballot(s_);
                    const int pos_ = (int)__builtin_amdgcn_mbcnt_hi((unsigned)(mk_ >> 32), __builtin_amdgcn_mbcnt_lo((unsigned)mk_, (unsigned)ns));
                    const bool w_ = s_ && pos_ < 384;
                    *(w_ ? tk + pos_ : dmy) = sc[i]; *(w_ ? ti + pos_ : (LAS int*)dmy) = kbase + (i >> 2) * 256 + (i & 3); ns += __builtin_popcountll(mk_); }
                if (ns <= 384) {
                    unsigned ek[10]; int ei[10];
                    ek[0] = cs0; ek[1] = cs1; ek[2] = cs2; ek[3] = cs3; ei[0] = ci0; ei[1] = ci1; ei[2] = ci2; ei[3] = ci3;
#pragma unroll
                    for (int j = 0; j < 6; ++j) { const int p_ = j * 64 + lane; const unsigned rk_ = tk[p_]; const int ri_ = ti[p_]; ek[4 + j] = (p_ < ns) ? rk_ : 0u; ei[4 + j] = (p_ < ns) ? ri_ : 0; }
                    dsa_select<10>(ek, ei, Tprev, selk, selw, dmy, nsel, lane, 640);
                    done = true;
                }
            }
            if (!done) {
                unsigned ek[36]; int ei[36];
                ek[0] = cs0; ek[1] = cs1; ek[2] = cs2; ek[3] = cs3; ei[0] = ci0; ei[1] = ci1; ei[2] = ci2; ei[3] = ci3;
#pragma unroll
                for (int i = 0; i < 32; ++i) { ek[4 + i] = sc[i]; ei[4 + i] = kbase + (i >> 2) * 256 + (i & 3); }
                dsa_select<36>(ek, ei, Tprev, selk, selw, dmy, nsel, lane, (c == 0) ? ((tq < 2047 ? tq : 2047) + 1) : 2304);
            }
            { const unsigned r0 = selk[lane], r1 = selk[64 + lane], r2 = selk[128 + lane], r3 = selk[192 + lane];
              cs0 = (lane < nsel) ? r0 : 0u; cs1 = (64 + lane < nsel) ? r1 : 0u; cs2 = (128 + lane < nsel) ? r2 : 0u; cs3 = (192 + lane < nsel) ? r3 : 0u; }
            ci0 = selw[lane]; ci1 = selw[64 + lane]; ci2 = selw[128 + lane]; ci3 = selw[192 + lane];
        }
    }
    {
        const float cs = 0.125f * LOG2E;
        bf16x8 qa0 = {0, 0, 0, 0, 0, 0, 0, 0}, qa1 = {0, 0, 0, 0, 0, 0, 0, 0};
        if (l15 < 4) { const bf16* p = zb + (size_t)tq * ZLD + Z_AQ + l15 * 64 + 8 * kq; qa0 = *(const bf16x8*)p; qa1 = *(const bf16x8*)(p + 32); }
        float mx0 = NEG_INF, mx1 = NEG_INF, mx2 = NEG_INF, mx3 = NEG_INF;
        const int kg = lane & 7, dc = lane >> 3;
#define DSA_AKLOAD(k0, k1, tg_) do { _Pragma("unroll") for (int t4 = 0; t4 < 4; ++t4) { const int jl_ = ((tg_) * 4 + t4) * 16 + l15; const int kraw_ = selw[jl_]; const int kidx_ = (jl_ < nsel) ? kraw_ : 0; \
        const unsigned ko_ = ((unsigned)kidx_ * (unsigned)ZLD + (unsigned)(Z_AK + 8 * kq)) * 2u; k0[t4] = *(const bf16x8*)(zbb + ko_); k1[t4] = *(const bf16x8*)(zbb + ko_ + 64u); } } while (0)
#define DSA_AKSCORE(k0, k1, tg_) do { _Pragma("unroll") for (int t4 = 0; t4 < 4; ++t4) { f32x4 c_ = {0.f, 0.f, 0.f, 0.f}; c_ = MFMA16(qa0, k0[t4], c_); c_ = MFMA16(qa1, k1[t4], c_); \
        const int jl_ = ((tg_) * 4 + t4) * 16 + l15; const bool valid_ = jl_ < nsel; \
        f32x4 sv_; sv_.x = valid_ ? c_[0] * cs : NEG_INF; sv_.y = valid_ ? c_[1] * cs : NEG_INF; sv_.z = valid_ ? c_[2] * cs : NEG_INF; sv_.w = valid_ ? c_[3] * cs : NEG_INF; \
        if (lane < 16) { *(LAS f32x4*)(pl + jl_ * 4) = sv_; mx0 = fmaxf(mx0, sv_.x); mx1 = fmaxf(mx1, sv_.y); mx2 = fmaxf(mx2, sv_.z); mx3 = fmaxf(mx3, sv_.w); } } } while (0)
#define DSA_VLOAD(vv, j0_) do { _Pragma("unroll") for (int i = 0; i < 8; ++i) { const int jl_ = (j0_) + 8 * i + kg; const int kraw_ = selw[jl_]; const int kidx_ = (jl_ < nsel) ? kraw_ : 0; \
        vv[i] = *(const u32x4*)(zbb + ((unsigned)kidx_ * (unsigned)ZLD + (unsigned)(Z_AV + 8 * dc)) * 2u); } } while (0)
        u32x4 va[8], vb[8];
        {
            bf16x8 ka0[4], ka1[4], kb0[4], kb1[4];
            DSA_AKLOAD(ka0, ka1, 0);
            if (64 < nsel) DSA_AKLOAD(kb0, kb1, 1);
            DSA_AKSCORE(ka0, ka1, 0);
            if (128 < nsel) DSA_AKLOAD(ka0, ka1, 2);
            if (64 < nsel) DSA_AKSCORE(kb0, kb1, 1);
            if (192 < nsel) DSA_AKLOAD(kb0, kb1, 3);
            DSA_VLOAD(va, 0);
            if (128 < nsel) DSA_AKSCORE(ka0, ka1, 2);
            if (64 < nsel) DSA_VLOAD(vb, 64);
            if (192 < nsel) DSA_AKSCORE(kb0, kb1, 3);
        }
        float mh[4], lh[4];
        mh[0] = fmaxf(__builtin_bit_cast(float, __builtin_amdgcn_readlane(__builtin_bit_cast(int, row16_max(mx0)), 0)), -1e30f);
        mh[1] = fmaxf(__builtin_bit_cast(float, __builtin_amdgcn_readlane(__builtin_bit_cast(int, row16_max(mx1)), 0)), -1e30f);
        mh[2] = fmaxf(__builtin_bit_cast(float, __builtin_amdgcn_readlane(__builtin_bit_cast(int, row16_max(mx2)), 0)), -1e30f);
        mh[3] = fmaxf(__builtin_bit_cast(float, __builtin_amdgcn_readlane(__builtin_bit_cast(int, row16_max(mx3)), 0)), -1e30f);
        LAS unsigned char* vtile = lds + DS_S + w * 8192;
        LAS unsigned short* pbl = (LAS unsigned short*)(vtile + 32 * VROWB);
        { float l0 = 0.f, l1 = 0.f, l2 = 0.f, l3 = 0.f;
#pragma unroll
          for (int rr = 0; rr < 4; ++rr) { const int jl = rr * 64 + lane; f32x4 sv = {0.f, 0.f, 0.f, 0.f};
              if (jl < nsel) { sv = *(const LAS f32x4*)(pl + jl * 4);
                  sv.x = ex2(sv.x - mh[0]); sv.y = ex2(sv.y - mh[1]); sv.z = ex2(sv.z - mh[2]); sv.w = ex2(sv.w - mh[3]);
                  l0 += sv.x; l1 += sv.y; l2 += sv.z; l3 += sv.w; }
              const unsigned p01 = pk2(sv.x, sv.y), p23 = pk2(sv.z, sv.w);
              pbl[jl] = (unsigned short)p01; pbl[256 + jl] = (unsigned short)(p01 >> 16); pbl[512 + jl] = (unsigned short)p23; pbl[768 + jl] = (unsigned short)(p23 >> 16); }
          l0 = row16_sumf(l0); l1 = row16_sumf(l1); l2 = row16_sumf(l2); l3 = row16_sumf(l3);
#define RL4(v) (__builtin_bit_cast(float, __builtin_amdgcn_readlane(__builtin_bit_cast(int, v), 0)) + __builtin_bit_cast(float, __builtin_amdgcn_readlane(__builtin_bit_cast(int, v), 16)) + \
                __builtin_bit_cast(float, __builtin_amdgcn_readlane(__builtin_bit_cast(int, v), 32)) + __builtin_bit_cast(float, __builtin_amdgcn_readlane(__builtin_bit_cast(int, v), 48)))
          lh[0] = RL4(l0); lh[1] = RL4(l1); lh[2] = RL4(l2); lh[3] = RL4(l3);
#undef RL4
        }
        f32x4 oacc[4];
#pragma unroll
        for (int dt = 0; dt < 4; ++dt) oacc[dt] = (f32x4){0.f, 0.f, 0.f, 0.f};
        const int pn = l15 < 4 ? l15 : 3, qd = l15 >> 2, pd = lane & 3;
#define DSA_PVHALF(vv, i0_, jb_) do { \
        _Pragma("unroll") for (int i = 0; i < 4; ++i) *(LAS u32x4*)(vtile + (8 * i + kg) * VROWB + dc * 16) = vv[(i0_) + i]; \
        u32x2 plo_ = *(const LAS u32x2*)(pbl + pn * 256 + (jb_) + 4 * kq), phi_ = *(const LAS u32x2*)(pbl + pn * 256 + (jb_) + 16 + 4 * kq); \
        u32x4 pw_; pw_.x = l15 < 4 ? plo_.x : 0u; pw_.y = l15 < 4 ? plo_.y : 0u; pw_.z = l15 < 4 ? phi_.x : 0u; pw_.w = l15 < 4 ? phi_.y : 0u; \
        const bf16x8 pf_ = __builtin_bit_cast(bf16x8, pw_); \
        _Pragma("unroll") for (int dt = 0; dt < 4; ++dt) { \
            const s16x4 lo_ = vtr(vtile + (4 * kq + qd) * VROWB + (16 * dt + 4 * pd) * 2), hi_ = vtr(vtile + (16 + 4 * kq + qd) * VROWB + (16 * dt + 4 * pd) * 2); \
            const bf16x8 vf_ = __builtin_shufflevector(lo_, hi_, 0, 1, 2, 3, 4, 5, 6, 7); \
            oacc[dt] = MFMA16(vf_, pf_, oacc[dt]); } } while (0)
#define DSA_VACC(vv, j0_) do { DSA_PVHALF(vv, 0, (j0_)); DSA_PVHALF(vv, 4, (j0_) + 32); } while (0)
        DSA_VACC(va, 0);
        if (128 < nsel) DSA_VLOAD(va, 128);
        if (64 < nsel) DSA_VACC(vb, 64);
        if (192 < nsel) DSA_VLOAD(vb, 192);
        if (128 < nsel) DSA_VACC(va, 128);
        if (192 < nsel) DSA_VACC(vb, 192);
        if (l15 < 4) {
            const float lsum = l15 == 0 ? lh[0] : l15 == 1 ? lh[1] : l15 == 2 ? lh[2] : lh[3];
            const float f = lsum > 0.f ? 1.f / lsum : 0.f;
            int l15o = l15; asm volatile("" : "+v"(l15o));
            bf16* op = O + ((size_t)b * T + tq) * 256 + l15o * 64 + 4 * kq;
#pragma unroll
            for (int dt = 0; dt < 4; ++dt) { u32x2 o; o.x = pk2(oacc[dt][0] * f, oacc[dt][1] * f); o.y = pk2(oacc[dt][2] * f, oacc[dt][3] * f); *(u32x2*)(op + 16 * dt) = o; }
        }
    }
    __syncthreads();
}


#ifndef N_LAUNCH_SPLIT
#define N_LAUNCH_SPLIT 0
#endif
constexpr int PH_PER_LAYER = 10, PH_TOTAL = DEPTH * PH_PER_LAYER + 1;

__global__ void __launch_bounds__(NWAVES * 64, 2) fwd_kernel(Args args) {
    extern __shared__ __attribute__((aligned(16))) unsigned char lds_raw[];
    LAS unsigned char* lds = (LAS unsigned char*)lds_raw;
    volatile LAS unsigned* MISC = (volatile LAS unsigned*)(lds + MISC_OFF);
#define G ((int)gridDim.x)
#define bx ((int)blockIdx.x)
#define gw ((int)blockIdx.x * NWAVES + wave)
#define NGW ((int)gridDim.x * NWAVES)
    for (int u = threadIdx.x; u < (LDS_BYTES - LDSCTL_OFF) / 4; u += NWAVES * 64) ((LAS unsigned*)(lds + LDSCTL_OFF))[u] = 0u;
    __syncthreads();
    XcdBarrier bar; bar.bar = (unsigned*)(args.ws + WS_CTL) + CW_BAR; bar.x = 0; bar.st = nullptr;
    if (!N_LAUNCH_SPLIT) bar = xcd_barrier_post((unsigned*)(args.ws + WS_CTL) + CW_BAR, MISC + 8);

#define x_in (args.in[0])
#define out (args.out)
#define cosT ((float*)(args.ws + WS_COS))
#define sinT ((float*)(args.ws + WS_SIN))
#define kmean ((float*)(args.ws + WS_KMEAN))
#define kcmp ((bf16*)(args.ws + WS_KCMP))
#define vcmp ((bf16*)(args.ws + WS_VCMP))
#define bias1p ((float*)(args.ws + WS_BIAS1))
#define Wb ((bf16*)(args.ws + WS_W))
#define H ((bf16*)(args.ws + WS_H))
#define Z ((bf16*)(args.ws + WS_Z))
#define HID ((bf16*)(args.ws + WS_HID))
#define GB ((bf16*)(args.ws + WS_GB))
#define MF ((float*)(args.ws + WS_MF))
#define XB ((bf16*)(args.ws + WS_XB))
#define SS ((float*)(args.ws + WS_SS))
#define RLP ((G == 256) ? (const LAS float*)(lds + LDSCTL_OFF + 2048) : (const LAS float*)nullptr)
#define RINV_FILL() do { if (G == 256) { LAS float* RL_ = (LAS float*)(lds + LDSCTL_OFF + 2048); const int rb_ = (bx & 7) * 2048; \
        for (int rr_ = tid; rr_ < 2048; rr_ += NWAVES * 64) { const f32x4* p_ = (const f32x4*)(SS + (size_t)(rb_ + rr_) * 16); const f32x4 s4_ = (p_[0] + p_[1]) + (p_[2] + p_[3]); \
            RL_[rr_] = __builtin_amdgcn_rsqf(((s4_[0] + s4_[1]) + (s4_[2] + s4_[3])) * (1.f / D) + NORM_EPS); } \
        __syncthreads(); } } while (0)
#define CQN ((bf16*)(args.ws + WS_CQN))
#define OA ((bf16*)(args.ws + WS_O))
#define OB ((bf16*)(args.ws + WS_O) + (size_t)M * 256)
#define OC ((bf16*)(args.ws + WS_O) + (size_t)M * 512)
    const int lo = args.ph_lo, hi = args.ph_hi;
    int seq = 0;
#define PH_ON (seq >= lo && seq < hi)
#define PH_END do { if (PH_ON && seq + 1 < hi) xcd_barrier(bar); ++seq; } while (0)

    if (lo == 0) rope_table(cosT, sinT, bx * (NWAVES * 64) + (int)threadIdx.x, G * NWAVES * 64);
#pragma unroll 1
    for (int l = 0; l < DEPTH; ++l) {
#pragma unroll 1
        for (int f = 0; f < 2; ++f) {
            if (f == 0) {
                if (PH_ON) { int tid = threadIdx.x; asm volatile("" : "+v"(tid)); const int lane = tid & 63, wave = __builtin_amdgcn_readfirstlane(tid >> 6); (void)lane; (void)wave;
                    convert_weights(args, l, Wb, bias1p, lds, gw, NGW, wave, lane, tid);
                    if (l == 0) { int m = gw; for (; m + 3 * NGW < M; m += 4 * NGW) xb_init_rows4(x_in, XB, SS, (size_t)m, (size_t)NGW, lane); for (; m < M; m += NGW) xb_init_rows4(x_in, XB, SS, (size_t)m, 0, lane); }
                }
                PH_END;
            }
            if (PH_ON) { int tid = threadIdx.x; asm volatile("" : "+v"(tid)); const int lane = tid & 63, wave = __builtin_amdgcn_readfirstlane(tid >> 6); (void)lane; (void)wave;
                pg8::Gemm g{XB, Wb + (f ? W_UP2 : W_UP1), M, 2 * DFF, D}; pg8::StaticOrder S; S.init(M, 2 * DFF, G, bx);
                RINV_FILL();
                pg8::EpiSwiGLU E{HID, DFF, SS, RLP};
                pg8::gemm_phase<pg8::EpiSwiGLU, pg8::StaticOrder, true, true>(lds, g, S, E);
            }
            PH_END;
            if (PH_ON) { int tid = threadIdx.x; asm volatile("" : "+v"(tid)); const int lane = tid & 63, wave = __builtin_amdgcn_readfirstlane(tid >> 6); (void)lane; (void)wave;
                pg8::Gemm g{HID, Wb + (f ? W_DN2 : W_DN1), M, D, DFF}; pg8::StaticOrder S; S.init(M, D, G, bx);
                pg8::EpiResid E{XB, XB, 0.5f, SS};
                pg8::gemm_phase<pg8::EpiResid, pg8::StaticOrder, true, true>(lds, g, S, E);
            }
            PH_END;
            if (f == 0) {
                if (PH_ON) { int tid = threadIdx.x; asm volatile("" : "+v"(tid)); const int lane = tid & 63, wave = __builtin_amdgcn_readfirstlane(tid >> 6); (void)lane; (void)wave;
                    pg8::Gemm g{XB, Wb + W_IN, M, ZLD, D}; pg8::StaticOrder S; S.init(M, ZLD, G, bx);
                    RINV_FILL();
                    pg8::EpiZin E{Z, CQN, cosT, sinT, SS, RLP};
                    pg8::gemm_phase<pg8::EpiZin, pg8::StaticOrder, true, true>(lds, g, S, E);
                }
                PH_END;
                if (PH_ON) { int tid = threadIdx.x; asm volatile("" : "+v"(tid)); const int lane = tid & 63, wave = __builtin_amdgcn_readfirstlane(tid >> 6); (void)lane; (void)wave;
                    constexpr int N_CMP = 128, N_KM = 64, N_DSA = M / 8, N_IT = N_CMP + N_KM + N_DSA;
                    {
                        const bool perx = (G == 256);
                        unsigned* qctr = (unsigned*)(args.ws + WS_CTL) + 8192 + (l * 8 + (perx ? (bx & 7) : 0)) * 16;
                        const int qlim = perx ? N_IT / 8 : N_IT;
                        for (;;) {
                            __syncthreads();
                            if (tid == 0) MISC[16] = atomicAdd(qctr, 1u);
                            __syncthreads();
                            const int U = (int)MISC[16];
                            if (U >= qlim) break;
                            const int x = perx ? (bx & 7) : U / (N_IT / 8), uu = perx ? U : U % (N_IT / 8);
                            const int it = (uu < (N_CMP + N_KM) / 8) ? x + 8 * uu : N_CMP + N_KM + x + 8 * (N_DSA / 8 - 1 - (uu - (N_CMP + N_KM) / 8));
                            if (it < N_CMP) compress_item(it, Z, Wb, bias1p, kcmp, vcmp, lds, tid);
                            else if (it < N_CMP + N_KM) kmean_item(it - N_CMP, Z, kmean, lds, tid);
                            else dsa_item(it - N_CMP - N_KM, Z, OA, lds, tid);
                        }
                    }
                }
                PH_END;
                if (PH_ON) { int tid = threadIdx.x; asm volatile("" : "+v"(tid)); const int lane = tid & 63, wave = __builtin_amdgcn_readfirstlane(tid >> 6); (void)lane; (void)wave;
                    LAS unsigned char* wl = lds + wave * NSA_WLDS;
                    {
                        const bool perx = (G == 256);
                        unsigned* qctr = (unsigned*)(args.ws + WS_CTL) + 9216 + (l * 8 + (perx ? (bx & 7) : 0)) * 16;
                        const int qlim = perx ? 96 : 768;
                        for (;;) {
                            __syncthreads();
                            if (tid == 0) MISC[16] = atomicAdd(qctr, 1u);
                            __syncthreads();
                            const int U = (int)MISC[16];
                            if (U >= qlim) break;
                            const int x = perx ? (bx & 7) : U / 96, uu = perx ? U : U % 96;
                            if (uu < 64) { const int par = x >> 2, bg = x & 3;
                                const int tile = (uu < 32) ? 127 - par - 2 * uu : 62 + par - 2 * (uu - 32);
                                nsa_block_unit(bg >> 1, bg & 1, 64 * tile, Z, CQN, kcmp, vcmp, OC, lds, tid); }
                            else { const int own = 31 - (uu - 64);
                                moba_block_item(x >> 2, x & 3, own, own * 8 + x, Z, kmean, OB, (float*)(args.ws + WS_PART), lds, tid); }
                        }
                    }
                }
                PH_END;
                for (int c = 0; c < 6; ++c) {
                    if (PH_ON) { int tid = threadIdx.x; asm volatile("" : "+v"(tid)); (void)tid;
                        if (c == 0) RINV_FILL();
                        const int i = c >> 1;
                        pg8::Gemm g; g.M = M; g.N = D;
                        if ((c & 1) == 0) { g.A = XB; g.Bt = Wb + W_G + (size_t)i * D * D; g.K = D; }
                        else if (i == 0) { g.A = OA; g.Bt = Wb + W_A; g.K = 256; }
                        else if (i == 1) { g.A = OB; g.Bt = Wb + W_B; g.K = 256; }
                        else { g.A = OC; g.Bt = Wb + W_C; g.K = 512; }
                        pg8::StaticOrder S; S.init(M, D, G, bx);
                        if ((c & 1) == 0) { pg8::EpiMerge<0> E{GB, MF, SS, RLP}; pg8::gemm_phase<pg8::EpiMerge<0>, pg8::StaticOrder, true, true>(lds, g, S, E); }
                        else if (i == 0) { pg8::EpiMerge<1> E{GB, MF, SS, RLP}; pg8::gemm_phase<pg8::EpiMerge<1>, pg8::StaticOrder, true, true>(lds, g, S, E); }
                        else if (i == 1) { pg8::EpiMerge<2> E{GB, MF, SS, RLP}; pg8::gemm_phase<pg8::EpiMerge<2>, pg8::StaticOrder, true, true>(lds, g, S, E); }
                        else { pg8::EpiMerge<3> E{GB, MF, SS, RLP}; pg8::gemm_phase<pg8::EpiMerge<3>, pg8::StaticOrder, true, true>(lds, g, S, E); }
                        VM_WAIT(); __syncthreads();
                    }
                }
                PH_END;
                if (PH_ON) { int tid = threadIdx.x; asm volatile("" : "+v"(tid)); const int lane = tid & 63, wave = __builtin_amdgcn_readfirstlane(tid >> 6); (void)lane; (void)wave;
                    pg8::Gemm g{GB, Wb + W_O, M, D, D}; pg8::StaticOrder S; S.init(M, D, G, bx);
                    pg8::EpiResid E{XB, XB, 1.0f, SS};
                    pg8::gemm_phase<pg8::EpiResid, pg8::StaticOrder, true, true>(lds, g, S, E);
                }
                PH_END;
            }
        }
    }
    if (PH_ON) { int tid = threadIdx.x; asm volatile("" : "+v"(tid)); const int lane = tid & 63, wave = __builtin_amdgcn_readfirstlane(tid >> 6); (void)lane; (void)wave; for (int m = gw; m < M; m += NGW) rms_row_b2f(XB + (size_t)m * D, args.in[21], out + (size_t)m * D, lane); }
#undef PH_ON
#undef PH_END
#undef x_in
#undef out
#undef cosT
#undef sinT
#undef kmean
#undef kcmp
#undef vcmp
#undef bias1p
#undef Wb
#undef H
#undef Z
#undef HID
#undef GB
#undef MF
#undef CQN
#undef OA
#undef OB
#undef OC
#undef gw
#undef NGW
#undef G
#undef bx
}

extern "C" void kernel_launch(void* const* d_in, const int* in_sizes, int n_in, void* d_out, int out_size, void* d_ws, size_t ws_size, hipStream_t stream) {
    static int grid = 0;
    if (grid == 0) {
        if (n_in != 22 || out_size != M * D || ws_size < WS_END) { fprintf(stderr, "kernel_launch: unexpected shapes (n_in %d, out %d, ws %zu, need %zu)\n", n_in, out_size, ws_size, (size_t)WS_END); grid = -1; return; }
        int dev = 0, cus = 0, per_cu = 0;
        if (hipGetDevice(&dev) != hipSuccess || hipDeviceGetAttribute(&cus, hipDeviceAttributeMultiprocessorCount, dev) != hipSuccess) { grid = -1; return; }
        if (hipFuncSetAttribute((const void*)fwd_kernel, hipFuncAttributeMaxDynamicSharedMemorySize, LDS_BYTES) != hipSuccess) { fprintf(stderr, "kernel_launch: hipFuncSetAttribute failed\n"); grid = -1; return; }
        if (hipOccupancyMaxActiveBlocksPerMultiprocessor(&per_cu, (const void*)fwd_kernel, NWAVES * 64, LDS_BYTES) != hipSuccess || per_cu < 1)
            fprintf(stderr, "kernel_launch: occupancy query reports %d workgroups per CU\n", per_cu);
        (void)hipGetLastError();
        grid = cus;
    }
    if (grid < 0) return;
    if (hipMemsetAsync((char*)d_ws + WS_CTL, 0, CTL_ZERO_BYTES, stream) != hipSuccess) return;
    Args a{};
    for (int i = 0; i < 22; ++i) a.in[i] = (const float*)d_in[i];
    a.out = (float*)d_out; a.ws = (unsigned char*)d_ws;
#if N_LAUNCH_SPLIT
    for (int p = 0; p < PH_TOTAL; ++p) { a.ph_lo = p; a.ph_hi = p + 1; hipLaunchKernelGGL(fwd_kernel, dim3(grid), dim3(NWAVES * 64), LDS_BYTES, stream, a); }
#else
    a.ph_lo = 0; a.ph_hi = PH_TOTAL;
    hipLaunchKernelGGL(fwd_kernel, dim3(grid), dim3(NWAVES * 64), LDS_BYTES, stream, a);
#endif
}
```
